# Optimizing an MI355X kernel written in HIP

```python
import math
import jax
import jax.numpy as jnp
from jax import lax
import numpy as np

D_MODEL = 1024
BATCH = 4
SEQ = 4096
DEPTH = 2

GRID_W = 64
CTX_LEN = 256
CHUNK = 64
CONV_K = 3
EPS = 1e-6

BRANCH_DIM = D_MODEL // 2
N_BRANCH = 4
SSM_HEAD_DIM = 64
SSM_HEADS = BRANCH_DIM // SSM_HEAD_DIM
SSM_GROUPS = 2
SSM_STATE = 64
GLA_HEADS = 4
GLA_DV = BRANCH_DIM // GLA_HEADS
GLA_DK = GLA_DV // 2
GLA_GATE_RANK = 16
GLA_TAU = 16.0
RWKV_HEAD = 64
RWKV_HEADS = BRANCH_DIM // RWKV_HEAD
RWKV_DECAY_RANK = 64
RWKV_ICLR_RANK = 64
RWKV_GATE_RANK = 128
RWKV_LN_EPS = 64e-5
GDN_HEAD = 128
GDN_HEADS = BRANCH_DIM // GDN_HEAD
N_EXPERTS = 16
N_GROUPS = 4
EXPERTS_PER_GROUP = N_EXPERTS // N_GROUPS
TOP_K = 2
EXPERT_FF = D_MODEL // 2

SSM_COLS = (BRANCH_DIM, BRANCH_DIM + 2 * SSM_GROUPS * SSM_STATE, 2 * SSM_HEADS)
GLA_COLS = (GLA_HEADS * GLA_DK, GLA_HEADS * GLA_DK, BRANCH_DIM, BRANCH_DIM, 2 * GLA_GATE_RANK)
RWKV_COLS = (3 * BRANCH_DIM, 2 * RWKV_DECAY_RANK, 2 * RWKV_ICLR_RANK, RWKV_GATE_RANK)
GDN_COLS = (3 * BRANCH_DIM, BRANCH_DIM, 2 * GDN_HEADS, 2 * GDN_HEADS)
MIXER_COLS = (sum(SSM_COLS), sum(GLA_COLS), sum(RWKV_COLS), sum(GDN_COLS))
N_IN = sum(MIXER_COLS)

kernel_name = 'hybrid_ssd_gla_rwkv7_gdn_moe_diffusion'


def rms_norm(x, w):
    xf = x.astype(jnp.float32)
    y = xf * lax.rsqrt(jnp.mean(xf * xf, -1, keepdims=True) + EPS)
    return (y * w).astype(x.dtype)


def l2_normalize(x):
    xf = x.astype(jnp.float32)
    return (xf * lax.rsqrt(jnp.sum(xf * xf, -1, keepdims=True) + EPS)).astype(x.dtype)


def modulate(h, shift, scale):
    return h * (1 + scale) + shift


def split(x, sizes):
    return jnp.split(x, np.cumsum(sizes)[:-1].tolist(), axis=-1)


def to_heads(t, n):
    b, s, _ = t.shape
    return t.reshape(b, s, n, -1).transpose(0, 2, 1, 3)


def from_heads(t):
    b, n, s, d = t.shape
    return t.transpose(0, 2, 1, 3).reshape(b, s, n * d)


def centred_conv(x, w):
    pad = w.shape[0] // 2
    return lax.conv_general_dilated(x, w[:, None, :], window_strides=(1,), padding=[(pad, pad)],
                                    dimension_numbers=('NWC', 'WIO', 'NWC'), feature_group_count=x.shape[-1])


def centred_shift(x):
    xp = jnp.pad(x, ((0, 0), (1, 1), (0, 0)))
    return 0.5 * (xp[:, :-2] + xp[:, 2:])


def to_scan_order(t, layer):
    if layer % 2 == 0:
        return t
    b, n, d = t.shape
    rows = n // GRID_W
    return t.reshape(b, rows, GRID_W, d).transpose(0, 2, 1, 3).reshape(b, n, d)


def from_scan_order(t, layer):
    if layer % 2 == 0:
        return t
    b, n, d = t.shape
    rows = n // GRID_W
    return t.reshape(b, GRID_W, rows, d).transpose(0, 2, 1, 3).reshape(b, n, d)


def chunk_linear_attention(q, k, v, log_a, s0):
    f32 = jnp.float32
    q, k, v, log_a = (t.astype(f32) for t in (q, k, v, log_a))
    b, h, t, dk = q.shape
    dv = v.shape[-1]
    n, c = t // CHUNK, CHUNK
    q = q.reshape(b, h, n, c, dk)
    k = k.reshape(b, h, n, c, dk)
    v = v.reshape(b, h, n, c, dv)
    g = jnp.cumsum(log_a.reshape(b, h, n, c, -1), axis=3)
    tri = jnp.tril(jnp.ones((c, c), bool))
    if g.shape[-1] == 1:
        gs = g[..., 0]
        decay = jnp.exp(jnp.where(tri, gs[..., :, None] - gs[..., None, :], -jnp.inf))
        scores = jnp.einsum('bhnik,bhnjk->bhnij', q, k) * decay
    else:
        scores = jnp.einsum('bhnik,bhnjk->bhnij', q * jnp.exp(g), k * jnp.exp(-g))
        scores = jnp.where(tri, scores, 0.0)
    intra = jnp.einsum('bhnij,bhnjv->bhniv', scores, v)
    g_last = g[..., -1:, :]
    chunk_state = jnp.einsum('bhnck,bhncv->bhnkv', k * jnp.exp(g_last - g), v)
    chunk_decay = jnp.exp(g_last[..., 0, :])

    def step(s, inp):
        st, dec = inp
        return s * dec[..., None] + st, s

    s_fin, s_in = lax.scan(step, s0, (jnp.moveaxis(chunk_state, 2, 0), jnp.moveaxis(chunk_decay, 2, 0)))
    inter = jnp.einsum('bhnck,nbhkv->bhncv', q * jnp.exp(g), s_in)
    return (intra + inter).reshape(b, h, t, dv), s_fin


def gated_delta_chunked(q, k, v, g, beta, s0):
    f32 = jnp.float32
    q, k, v, g, beta = (t.astype(f32) for t in (q, k, v, g, beta))
    b, h, t, dk = q.shape
    dv = v.shape[-1]
    n, c = t // CHUNK, CHUNK
    q = q.reshape(b, h, n, c, dk)
    k = k.reshape(b, h, n, c, dk)
    v = v.reshape(b, h, n, c, dv)
    beta = beta.reshape(b, h, n, c)
    g = jnp.cumsum(g.reshape(b, h, n, c), -1)
    tri = jnp.tril(jnp.ones((c, c), bool))
    strict = jnp.tril(jnp.ones((c, c), bool), -1)
    decay = jnp.exp(jnp.where(tri, g[..., :, None] - g[..., None, :], -jnp.inf))
    lower = jnp.where(strict, jnp.einsum('bhnik,bhnjk->bhnij', k, k) * decay * beta[..., None], 0.0)
    rhs = jnp.concatenate([v * beta[..., None], k * (beta * jnp.exp(g))[..., None]], -1)
    sol = lax.linalg.triangular_solve(lower + jnp.eye(c, dtype=f32), rhs, left_side=True, lower=True,
                                      unit_diagonal=True)
    u, w = sol[..., :dv], sol[..., dv:]
    attn = jnp.einsum('bhnik,bhnjk->bhnij', q, k) * decay
    g_last = g[..., -1:]
    q_dec = q * jnp.exp(g)[..., None]
    k_dec = k * jnp.exp(g_last - g)[..., None]

    def step(s, inp):
        q_i, k_i, u_i, w_i, a_i, gl = inp
        v_new = u_i - jnp.einsum('bhck,bhkv->bhcv', w_i, s)
        o = jnp.einsum('bhck,bhkv->bhcv', q_i, s) + jnp.einsum('bhcs,bhsv->bhcv', a_i, v_new)
        s = s * gl[..., None] + jnp.einsum('bhck,bhcv->bhkv', k_i, v_new)
        return s, o

    xs = tuple(jnp.moveaxis(a, 2, 0) for a in (q_dec, k_dec, u, w, attn, jnp.exp(g_last)))
    s_fin, o = lax.scan(step, s0, xs)
    return jnp.moveaxis(o, 0, 2).reshape(b, h, t, dv), s_fin


def rwkv7_scan(r, w, k, v, kk, a, s0):
    f32 = jnp.float32

    def step(s, inp):
        r_t, w_t, k_t, v_t, kk_t, a_t = inp
        sa = jnp.einsum('bhvk,bhk->bhv', s, kk_t)
        s = (s * w_t[:, :, None, :] - sa[..., None] * (kk_t * a_t)[:, :, None, :]
             + v_t[..., None] * k_t[:, :, None, :])
        return s, jnp.einsum('bhvk,bhk->bhv', s, r_t)

    xs = tuple(jnp.moveaxis(t.astype(f32), 2, 0) for t in (r, w, k, v, kk, a))
    s_fin, o = lax.scan(step, s0, xs)
    return jnp.moveaxis(o, 0, 2), s_fin


def bidir(scan_fn, s0, ctx_fwd, ctx_bwd, lat_fwd, lat_bwd):
    rev = lambda args: [jnp.flip(a, axis=2) for a in args]
    oc_f, sc_f = scan_fn(*ctx_fwd, s0)
    ol_f, _ = scan_fn(*lat_fwd, sc_f)
    oc_b, sc_b = scan_fn(*rev(ctx_bwd), s0)
    ol_b, _ = scan_fn(*rev(lat_bwd), sc_b)
    return oc_f + jnp.flip(oc_b, 2), ol_f + jnp.flip(ol_b, 2)


def ssm_mixer(p_ctx, p_lat, lp, need_ctx):
    rep = SSM_HEADS // SSM_GROUPS

    def prep(p):
        b, t, _ = p.shape
        z, xbc, dt = split(p, SSM_COLS)
        xbc = jax.nn.silu(centred_conv(xbc, lp['ssm_conv_w']) + lp['ssm_conv_b'])
        xs, bs, cs = split(xbc, (BRANCH_DIM, SSM_GROUPS * SSM_STATE, SSM_GROUPS * SSM_STATE))
        xh = to_heads(xs, SSM_HEADS)
        bh = jnp.repeat(to_heads(bs, SSM_GROUPS), rep, axis=1)
        ch = jnp.repeat(to_heads(cs, SSM_GROUPS), rep, axis=1)
        dt = jax.nn.softplus(dt.reshape(b, t, 2, SSM_HEADS) + lp['ssm_dt_bias']).transpose(2, 0, 3, 1)
        log_a = (dt * -jnp.exp(lp['ssm_a_log'])[:, None, :, None])[..., None]
        kd = bh[None] * dt[..., None]
        return z, xh, (ch, kd[0], xh, log_a[0]), (ch, kd[1], xh, log_a[1])

    z_c, x_c, fc, bc = prep(p_ctx)
    z_l, x_l, fl, bl = prep(p_lat)
    s0 = jnp.zeros((p_ctx.shape[0], SSM_HEADS, SSM_STATE, SSM_HEAD_DIM), jnp.float32)
    y_c, y_l = bidir(chunk_linear_attention, s0, fc, bc, fl, bl)

    def post(y, xh, z):
        y = y.astype(z.dtype) + lp['ssm_d'][:, None, None] * xh
        y = from_heads(y) * jax.nn.silu(z)
        b, t, _ = y.shape
        return rms_norm(y.reshape(b, t, SSM_GROUPS, -1), lp['ssm_norm'].reshape(SSM_GROUPS, -1)).reshape(b, t, -1)

    return (post(y_c, x_c, z_c) if need_ctx else None), post(y_l, x_l, z_l)


def gla_mixer(p_ctx, p_lat, lp, need_ctx):
    def prep(p):
        b, t, _ = p.shape
        q, k, v, r, glr = split(p, GLA_COLS)
        q = to_heads(q, GLA_HEADS) * GLA_DK ** -0.5
        k = to_heads(k, GLA_HEADS)
        v = to_heads(v, GLA_HEADS)
        glr = glr.reshape(b, t, 2, GLA_GATE_RANK)
        logit = jnp.einsum('bter,erk->ebtk', glr, lp['gla_w2']) + lp['gla_b'][:, None, None, :]
        log_a = jax.nn.log_sigmoid(logit) / GLA_TAU
        return r, (q, k, v, to_heads(log_a[0], GLA_HEADS)), (q, k, v, to_heads(log_a[1], GLA_HEADS))

    r_c, fc, bc = prep(p_ctx)
    r_l, fl, bl = prep(p_lat)
    s0 = jnp.zeros((p_ctx.shape[0], GLA_HEADS, GLA_DK, GLA_DV), jnp.float32)
    y_c, y_l = bidir(chunk_linear_attention, s0, fc, bc, fl, bl)

    def post(y, r):
        return from_heads(rms_norm(y, lp['gla_norm'])).astype(r.dtype) * jax.nn.silu(r)

    return (post(y_c, r_c) if need_ctx else None), post(y_l, r_l)


def head_group_norm(y, w, b):
    yf = y.astype(jnp.float32)
    mu = jnp.mean(yf, -1, keepdims=True)
    var = jnp.mean(jnp.square(yf - mu), -1, keepdims=True)
    return from_heads((yf - mu) * lax.rsqrt(var + RWKV_LN_EPS)) * w + b


def rwkv_mixer(p_ctx, p_lat, lp, need_ctx):
    def prep(p):
        b, t, _ = p.shape
        p = p + lp['rwkv_mu'] * (centred_shift(p) - p)
        rkv, wlr, alr, glr = split(p, RWKV_COLS)
        r, k, v = split(rkv, (BRANCH_DIM,) * 3)
        wlr = wlr.reshape(b, t, 2, RWKV_DECAY_RANK)
        alr = alr.reshape(b, t, 2, RWKV_ICLR_RANK)
        w_raw = lp['rwkv_w0'][:, None, None, :] + jnp.einsum('bter,erc->ebtc', jnp.tanh(wlr), lp['rwkv_w2'])
        w = jnp.exp(-jnp.exp(-jax.nn.softplus(-w_raw) - 0.5))
        a = jax.nn.sigmoid(lp['rwkv_a0'][:, None, None, :] + jnp.einsum('bter,erc->ebtc', alr, lp['rwkv_a2']))
        g = jax.nn.sigmoid(glr) @ lp['rwkv_g2']
        kk = l2_normalize(to_heads(k * lp['rwkv_k_k'], RWKV_HEADS))
        k_dir = k[None] * (1 + (a - 1) * lp['rwkv_k_a'])
        rh = to_heads(r, RWKV_HEADS)
        vh = to_heads(v, RWKV_HEADS)
        kd = [to_heads(k_dir[i], RWKV_HEADS) for i in range(2)]
        wd = [to_heads(w[i], RWKV_HEADS) for i in range(2)]
        ad = [to_heads(a[i], RWKV_HEADS) for i in range(2)]
        r_k = lp['rwkv_r_k'][:, None, :]
        bonus = (jnp.sum(rh * kd[0] * r_k, -1, keepdims=True) + jnp.sum(rh * kd[1] * r_k, -1, keepdims=True)) * vh
        return g, from_heads(bonus), (rh, wd[0], kd[0], vh, kk, ad[0]), (rh, wd[1], kd[1], vh, kk, ad[1])

    g_c, bo_c, fc, bc = prep(p_ctx)
    g_l, bo_l, fl, bl = prep(p_lat)
    s0 = jnp.zeros((p_ctx.shape[0], RWKV_HEADS, RWKV_HEAD, RWKV_HEAD), jnp.float32)
    y_c, y_l = bidir(rwkv7_scan, s0, fc, bc, fl, bl)

    def post(y, bonus, g):
        y = head_group_norm(y, lp['rwkv_ln_w'], lp['rwkv_ln_b']).astype(g.dtype)
        return (y + bonus) * g

    return (post(y_c, bo_c, g_c) if need_ctx else None), post(y_l, bo_l, g_l)


def gdn_mixer(p_ctx, p_lat, lp, need_ctx):
    def prep(p):
        b, t, _ = p.shape
        qkv, z, a_raw, b_raw = split(p, GDN_COLS)
        qkv = jax.nn.silu(centred_conv(qkv, lp['gdn_conv_w']))
        q, k, v = split(qkv, (BRANCH_DIM,) * 3)
        q = l2_normalize(to_heads(q, GDN_HEADS)) * GDN_HEAD ** -0.5
        k = l2_normalize(to_heads(k, GDN_HEADS))
        v = to_heads(v, GDN_HEADS)
        a_raw = a_raw.reshape(b, t, 2, GDN_HEADS)
        b_raw = b_raw.reshape(b, t, 2, GDN_HEADS)
        g = (-jnp.exp(lp['gdn_a_log']) * jax.nn.softplus(a_raw + lp['gdn_dt_bias'])).transpose(2, 0, 3, 1)
        beta = jax.nn.sigmoid(b_raw).transpose(2, 0, 3, 1)
        return z, (q, k, v, g[0], beta[0]), (q, k, v, g[1], beta[1])

    z_c, fc, bc = prep(p_ctx)
    z_l, fl, bl = prep(p_lat)
    s0 = jnp.zeros((p_ctx.shape[0], GDN_HEADS, GDN_HEAD, GDN_HEAD), jnp.float32)
    y_c, y_l = bidir(gated_delta_chunked, s0, fc, bc, fl, bl)

    def post(y, z):
        return from_heads(rms_norm(y, lp['gdn_norm'])).astype(z.dtype) * jax.nn.silu(z)

    return (post(y_c, z_c) if need_ctx else None), post(y_l, z_l)


def mixer_block(h_ctx, h_lat, lp, need_ctx):
    pc = split(h_ctx @ lp['w_in'], MIXER_COLS)
    pl = split(h_lat @ lp['w_in'], MIXER_COLS)
    mixers = (ssm_mixer, gla_mixer, rwkv_mixer, gdn_mixer)
    outs = [m(p_c, p_l, lp, need_ctx) for m, p_c, p_l in zip(mixers, pc, pl)]

    def merge(h, ys):
        acc = None
        for i, y in enumerate(ys):
            term = jax.nn.sigmoid(h @ lp['w_gate'][i]) * (y @ lp['w_branch'][i])
            acc = term if acc is None else acc + term
        return acc @ lp['w_out']

    y_lat = merge(h_lat, [o[1] for o in outs])
    y_ctx = merge(h_ctx, [o[0] for o in outs]) if need_ctx else None
    return y_ctx, y_lat


def moe_ffn(h, router_w, router_b, w_gate, w_up, w_down):
    scores = jax.nn.sigmoid((h @ router_w).astype(jnp.float32))
    sel = scores + router_b.astype(jnp.float32)
    grouped = sel.reshape(*sel.shape[:-1], N_GROUPS, EXPERTS_PER_GROUP)
    group = jnp.argmax(jnp.sum(lax.top_k(grouped, TOP_K)[0], -1), -1)
    in_group = (jnp.arange(N_EXPERTS) // EXPERTS_PER_GROUP) == group[..., None]
    _, idx = lax.top_k(jnp.where(in_group, sel, -jnp.inf), TOP_K)
    wts = jnp.take_along_axis(scores, idx, -1)
    wts = wts / jnp.sum(wts, -1, keepdims=True)
    gate = jnp.sum(jax.nn.one_hot(idx, N_EXPERTS, dtype=wts.dtype) * wts[..., None], -2).astype(h.dtype)
    out = None
    for e in range(N_EXPERTS):
        y = (jax.nn.silu(h @ w_gate[e]) * (h @ w_up[e])) @ w_down[e]
        term = gate[..., e:e + 1] * y
        out = term if out is None else out + term
    return out


def setup_inputs(seed: int = 0) -> dict:
    key = jax.random.key(seed)
    ks = iter(jax.random.split(key, 64))
    D, L = D_MODEL, DEPTH

    def nrm(shape, scale):
        return jax.random.normal(next(ks), shape, jnp.float32) * scale

    def gain(shape):
        return 1.0 + nrm(shape, 0.02)

    def a_log(shape):
        return jnp.log(jax.random.uniform(next(ks), shape, jnp.float32, 1.0, 16.0))

    def dt_bias(shape):
        dt = jnp.exp(jax.random.uniform(next(ks), shape, jnp.float32, math.log(1e-3), math.log(1e-1)))
        return dt + jnp.log(-jnp.expm1(-dt))

    return {
        'x': nrm((BATCH, SEQ, D), 1.0),
        'c': nrm((BATCH, D), 1.0),
        'ctx': nrm((BATCH, CTX_LEN, D), 1.0),
        'c_ctx': nrm((D,), 1.0),
        'ada_w': nrm((L, D, 6 * D), 0.5 * D ** -0.5),
        'ada_b': nrm((L, 6 * D), 0.01),
        'norm_mix': gain((L, D)),
        'norm_ffn': gain((L, D)),
        'w_in': nrm((L, D, N_IN), D ** -0.5),
        'w_gate': nrm((L, N_BRANCH, D, D), D ** -0.5),
        'w_branch': nrm((L, N_BRANCH, BRANCH_DIM, D), BRANCH_DIM ** -0.5),
        'w_out': nrm((L, D, D), D ** -0.5),
        'ssm_conv_w': nrm((L, CONV_K, SSM_COLS[1]), CONV_K ** -0.5),
        'ssm_conv_b': nrm((L, SSM_COLS[1]), 0.02),
        'ssm_a_log': a_log((L, 2, SSM_HEADS)),
        'ssm_dt_bias': dt_bias((L, 2, SSM_HEADS)),
        'ssm_d': 1.0 + nrm((L, SSM_HEADS), 0.1),
        'ssm_norm': gain((L, BRANCH_DIM)),
        'gla_w2': nrm((L, 2, GLA_GATE_RANK, GLA_HEADS * GLA_DK), GLA_GATE_RANK ** -0.5),
        'gla_b': nrm((L, 2, GLA_HEADS * GLA_DK), 0.1),
        'gla_norm': gain((L, GLA_DV)),
        'rwkv_mu': jax.random.uniform(next(ks), (L, MIXER_COLS[2]), jnp.float32),
        'rwkv_w0': jax.random.uniform(next(ks), (L, 2, BRANCH_DIM), jnp.float32, -6.5, -1.5),
        'rwkv_w2': nrm((L, 2, RWKV_DECAY_RANK, BRANCH_DIM), 0.5 * RWKV_DECAY_RANK ** -0.5),
        'rwkv_a0': nrm((L, 2, BRANCH_DIM), 0.1),
        'rwkv_a2': nrm((L, 2, RWKV_ICLR_RANK, BRANCH_DIM), RWKV_ICLR_RANK ** -0.5),
        'rwkv_g2': nrm((L, RWKV_GATE_RANK, BRANCH_DIM), RWKV_GATE_RANK ** -0.5),
        'rwkv_k_k': 0.85 + nrm((L, BRANCH_DIM), 0.02),
        'rwkv_k_a': 1.0 + nrm((L, BRANCH_DIM), 0.02),
        'rwkv_r_k': nrm((L, RWKV_HEADS, RWKV_HEAD), 0.1),
        'rwkv_ln_w': gain((L, BRANCH_DIM)),
        'rwkv_ln_b': nrm((L, BRANCH_DIM), 0.01),
        'gdn_conv_w': nrm((L, CONV_K, 3 * BRANCH_DIM), CONV_K ** -0.5),
        'gdn_a_log': a_log((L, 2, GDN_HEADS)),
        'gdn_dt_bias': dt_bias((L, 2, GDN_HEADS)),
        'gdn_norm': gain((L, GDN_HEAD)),
        'router_w': nrm((D, N_EXPERTS), D ** -0.5),
        'router_b': nrm((N_EXPERTS,), 0.01),
        'moe_w_gate': nrm((L, N_EXPERTS, D, EXPERT_FF), D ** -0.5),
        'moe_w_up': nrm((L, N_EXPERTS, D, EXPERT_FF), D ** -0.5),
        'moe_w_down': nrm((L, N_EXPERTS, EXPERT_FF, D), EXPERT_FF ** -0.5),
        'final_norm': gain((D,)),
    }


def reference(x, c, ctx, c_ctx, ada_w, ada_b, norm_mix, norm_ffn, w_in, w_gate, w_branch, w_out,
              ssm_conv_w, ssm_conv_b, ssm_a_log, ssm_dt_bias, ssm_d, ssm_norm,
              gla_w2, gla_b, gla_norm,
              rwkv_mu, rwkv_w0, rwkv_w2, rwkv_a0, rwkv_a2, rwkv_g2, rwkv_k_k, rwkv_k_a, rwkv_r_k,
              rwkv_ln_w, rwkv_ln_b,
              gdn_conv_w, gdn_a_log, gdn_dt_bias, gdn_norm,
              router_w, router_b, moe_w_gate, moe_w_up, moe_w_down, final_norm):
    xc = ctx
    silu_c = jax.nn.silu(c)
    silu_cc = jax.nn.silu(c_ctx)
    for l in range(DEPTH):
        last = l == DEPTH - 1
        lp = dict(w_in=w_in[l], w_gate=w_gate[l], w_branch=w_branch[l], w_out=w_out[l],
                  ssm_conv_w=ssm_conv_w[l], ssm_conv_b=ssm_conv_b[l], ssm_a_log=ssm_a_log[l],
                  ssm_dt_bias=ssm_dt_bias[l], ssm_d=ssm_d[l], ssm_norm=ssm_norm[l],
                  gla_w2=gla_w2[l], gla_b=gla_b[l], gla_norm=gla_norm[l],
                  rwkv_mu=rwkv_mu[l], rwkv_w0=rwkv_w0[l], rwkv_w2=rwkv_w2[l], rwkv_a0=rwkv_a0[l],
                  rwkv_a2=rwkv_a2[l], rwkv_g2=rwkv_g2[l], rwkv_k_k=rwkv_k_k[l], rwkv_k_a=rwkv_k_a[l],
                  rwkv_r_k=rwkv_r_k[l], rwkv_ln_w=rwkv_ln_w[l], rwkv_ln_b=rwkv_ln_b[l],
                  gdn_conv_w=gdn_conv_w[l], gdn_a_log=gdn_a_log[l], gdn_dt_bias=gdn_dt_bias[l],
                  gdn_norm=gdn_norm[l])
        mod = jnp.split((silu_c @ ada_w[l] + ada_b[l])[:, None, :], 6, axis=-1)
        mod_c = jnp.split(silu_cc @ ada_w[l] + ada_b[l], 6, axis=-1)
        h = to_scan_order(modulate(rms_norm(x, norm_mix[l]), mod[0], mod[1]), l)
        hc = modulate(rms_norm(xc, norm_mix[l]), mod_c[0], mod_c[1])
        y_ctx, y_lat = mixer_block(hc, h, lp, not last)
        x = x + mod[2] * from_scan_order(y_lat, l)
        moe_w = (router_w, router_b, moe_w_gate[l], moe_w_up[l], moe_w_down[l])
        x = x + mod[5] * moe_ffn(modulate(rms_norm(x, norm_ffn[l]), mod[3], mod[4]), *moe_w)
        if not last:
            xc = xc + mod_c[2] * y_ctx
            xc = xc + mod_c[5] * moe_ffn(modulate(rms_norm(xc, norm_ffn[l]), mod_c[3], mod_c[4]), *moe_w)
    return rms_norm(x, final_norm)
```

```cpp
#include <hip/hip_runtime.h>
#include <stdint.h>
#include <cstdio>

#ifndef MK_SINGLE
#define MK_SINGLE 1
#endif

namespace {

typedef unsigned short bfr;
typedef short bf16x8 __attribute__((ext_vector_type(8)));
typedef float f32x4 __attribute__((ext_vector_type(4)));
typedef float f32x2 __attribute__((ext_vector_type(2)));
typedef __bf16 bf16x2v __attribute__((ext_vector_type(2)));
#define DEVINL __device__ __forceinline__
#define LAS __attribute__((address_space(3)))

constexpr int D = 1024, NB = 4, SEQ = 4096, CTXL = 256;
constexpr int TL = NB * SEQ, TC = NB * CTXL, T = TL + TC;
constexpr int NIN = 6848, NINP = 6912, OLD = 4096;
constexpr int C_SSM = 0, C_GLA = 1296, C_RWKV = 2864, C_GDN = 4784;
constexpr int NTHR = 512;
constexpr int LDS_BYTES = 155648;
constexpr float EPS = 1e-6f;

struct Params {
  const float *x, *c, *ctx, *c_ctx, *ada_w, *ada_b, *norm_mix, *norm_ffn, *w_in, *w_gate, *w_branch, *w_out;
  const float *ssm_conv_w, *ssm_conv_b, *ssm_a_log, *ssm_dt_bias, *ssm_d, *ssm_norm;
  const float *gla_w2, *gla_b, *gla_norm;
  const float *rwkv_mu, *rwkv_w0, *rwkv_w2, *rwkv_a0, *rwkv_a2, *rwkv_g2, *rwkv_k_k, *rwkv_k_a, *rwkv_r_k, *rwkv_ln_w, *rwkv_ln_b;
  const float *gdn_conv_w, *gdn_a_log, *gdn_dt_bias, *gdn_norm;
  const float *router_w, *router_b, *moe_w_gate, *moe_w_up, *moe_w_down, *final_norm;
  float* out;
  float* xc;
  float* mod;
  bfr* O;
  bfr* P;
  bfr *WinT, *WgT, *WbT, *WoT;
  float* bon;
  int* cnt;
  int* list;
  float* gatew;
  bfr *ACC, *GATES, *HF, *HB, *YS, *WmguT, *WmdT;
  bfr *Gb, *g2T;
};

DEVINL float bf2f(bfr v) { return __uint_as_float(((unsigned)v) << 16); }
DEVINL bfr f2bf(float f) { return __builtin_bit_cast(bfr, (__bf16)f); }
DEVINL unsigned pack2(float a, float b) { f32x2 v = {a, b}; return __builtin_bit_cast(unsigned, __builtin_convertvector(v, bf16x2v)); }
DEVINL float sigm(float x) { return __builtin_amdgcn_rcpf(1.f + __expf(-x)); }
DEVINL float silu(float x) { return x * __builtin_amdgcn_rcpf(1.f + __expf(-x)); }
DEVINL float softplus(float x) { return fmaxf(x, 0.f) + __logf(1.f + __expf(-fabsf(x))); }
DEVINL float dpp_sum16(float v) {
  v += __int_as_float(__builtin_amdgcn_update_dpp(0, __float_as_int(v), 0xB1, 0xF, 0xF, true));
  v += __int_as_float(__builtin_amdgcn_update_dpp(0, __float_as_int(v), 0x4E, 0xF, 0xF, true));
  v += __int_as_float(__builtin_amdgcn_update_dpp(0, __float_as_int(v), 0x141, 0xF, 0xF, true));
  v += __int_as_float(__builtin_amdgcn_update_dpp(0, __float_as_int(v), 0x140, 0xF, 0xF, true));
  return v;
}
DEVINL float dpp_sum8(float v) {
  v += __int_as_float(__builtin_amdgcn_update_dpp(0, __float_as_int(v), 0xB1, 0xF, 0xF, true));
  v += __int_as_float(__builtin_amdgcn_update_dpp(0, __float_as_int(v), 0x4E, 0xF, 0xF, true));
  v += __int_as_float(__builtin_amdgcn_update_dpp(0, __float_as_int(v), 0x141, 0xF, 0xF, true));
  return v;
}
DEVINL float wave_sum(float v) { v = dpp_sum16(v); v += __shfl_xor(v, 16); v += __shfl_xor(v, 32); return v; }
template <int W> DEVINL float group_sum(float v) {
#pragma unroll
  for (int o = W / 2; o > 0; o >>= 1) v += __shfl_xor(v, o);
  return v;
}

#define XB_TMO      128
#define XB_XCNT(j)  (256  + 64 * (j))
#define XB_XSUB(j)  (1280 + 64 * (j))
#define XB_XGEN(j)  (2304 + 64 * (j))
#define XB_TOP      3328
#define XB_TOPGEN   3392
#define XCD_BAR_WORDS 3456
#define XB_SPIN_CAP (1u << 18)

DEVINL unsigned xb_ld(unsigned* p)              { return __hip_atomic_load(p, __ATOMIC_RELAXED, __HIP_MEMORY_SCOPE_AGENT); }
DEVINL unsigned xb_add(unsigned* p, unsigned v) { return __hip_atomic_fetch_add(p, v, __ATOMIC_RELAXED, __HIP_MEMORY_SCOPE_AGENT); }
DEVINL unsigned xb_xcc_id() { return (unsigned)__builtin_amdgcn_s_getreg((3 << 11) | 20) & 0xFu; }
#define XB_SPIN(cond, bar) do { unsigned _sp = 0; while (cond) { __builtin_amdgcn_s_sleep(1); \
    if ((++_sp & 255u) == 0u) { if (xb_ld(&(bar)[XB_TMO])) break; if (_sp > XB_SPIN_CAP) { atomicAdd(&(bar)[XB_TMO], 1u); break; } } } } while (0)

struct XcdBarrier { unsigned* bar; unsigned x; volatile LAS unsigned* st; };

DEVINL XcdBarrier xcd_barrier_post(unsigned* bar, volatile LAS unsigned* st) {
    XcdBarrier b; b.bar = bar; b.x = xb_xcc_id(); b.st = st;
    if (threadIdx.x == 0) (void)xb_add(&bar[XB_XCNT(b.x)], 1u);
    return b;
}
DEVINL void xcd_barrier_complete(unsigned* bar, unsigned x, unsigned& nloc, unsigned& nx) {
    const unsigned G = gridDim.x * gridDim.y * gridDim.z;
    unsigned sum, cnt, mine, sp = 0u;
    for (;;) {
        sum = 0u; cnt = 0u; mine = 0u;
#pragma unroll
        for (unsigned j = 0; j < 16; ++j) { const unsigned c = xb_ld(&bar[XB_XCNT(j)]); sum += c; cnt += (c > 0u) ? 1u : 0u; mine = (j == x) ? c : mine; }
        if (sum == G) break;
        __builtin_amdgcn_s_sleep(1);
        if ((++sp & 255u) == 0u) { if (xb_ld(&bar[XB_TMO])) break; if (sp > XB_SPIN_CAP) { atomicAdd(&bar[XB_TMO], 1u); break; } }
    }
    nloc = mine > 0u ? mine : 1u; nx = cnt > 0u ? cnt : 1u;
}
DEVINL void xcd_barrier(const XcdBarrier& b) {
    asm volatile("s_waitcnt vmcnt(0)" ::: "memory");
    __syncthreads();
    if (threadIdx.x == 0) {
        unsigned* bar = b.bar;
        __builtin_amdgcn_s_waitcnt(0);
        unsigned nloc = b.st[0], nx = b.st[1];
        if (nloc == 0u) { xcd_barrier_complete(bar, b.x, nloc, nx); b.st[0] = nloc; b.st[1] = nx; }
        const unsigned old = xb_add(&bar[XB_XSUB(b.x)], 1u);
        const unsigned gen = old / nloc;
        if (old + 1u == (gen + 1u) * nloc) {
            __builtin_amdgcn_fence(__ATOMIC_RELEASE, "agent");
            asm volatile("s_waitcnt vmcnt(0)" ::: "memory");
            const unsigned og = xb_add(&bar[XB_TOP], 1u);
            const unsigned tg = og / nx;
            if (og + 1u == (tg + 1u) * nx) xb_add(&bar[XB_TOPGEN], 1u);
            else XB_SPIN(xb_ld(&bar[XB_TOPGEN]) == tg, bar);
            __builtin_amdgcn_fence(__ATOMIC_ACQUIRE, "agent");
            xb_add(&bar[XB_XGEN(b.x)], 1u);
            asm volatile("s_waitcnt vmcnt(0)" ::: "memory");
        } else {
            XB_SPIN(xb_ld(&bar[XB_XGEN(b.x)]) == gen, bar);
            __builtin_amdgcn_fence(__ATOMIC_ACQUIRE, "agent");
            asm volatile("s_waitcnt vmcnt(0)" ::: "memory");
        }
    }
    __syncthreads();
}

namespace g8 {
constexpr int BM = 256, BK = 64, HALF = 128, HTB = HALF * BK * 2, NXCD = 8, WGM = 8;
DEVINL int lds_byte(int r, int c) { const int st = (r >> 4) * 2 + (c >> 5), rr = r & 15, cc = c & 31, ob = rr * 64 + cc * 2; return st * 1024 + (ob ^ (((ob >> 9) & 1) << 5)); }
DEVINL void stage_rc(int b, int& R, int& C) { const int st = b / 1024, sb = b % 1024, swz = sb ^ (((sb >> 9) & 1) << 5); R = (st >> 1) * 16 + swz / 64; C = (st & 1) * 32 + (swz % 64) / 2; }
DEVINL int perm32(int rho) { const int n = rho >> 4, i = rho & 15; return 8 * (i >> 2) + 4 * n + (i & 3); }
struct Unit { int pm, pn, e; };
typedef f32x4 Acc[2][2][4][2];

struct TileSched {
  int nM, nN, nwg, G, c;
  DEVINL void init(int nM_, int nN_) { nM = nM_; nN = nN_; nwg = nM * nN; G = gridDim.x; c = blockIdx.x; }
  DEVINL bool next(int i, Unit& u) const {
    const long L = (long)i * G + c; if (L >= nwg) return false;
    int wgid = (int)L; { const int q = nwg / NXCD, r = nwg % NXCD, xcd = wgid % NXCD, off = wgid / NXCD; wgid = (xcd < r ? xcd * (q + 1) : r * (q + 1) + (xcd - r) * q) + off; }
    const int nig = WGM * nN, gid = wgid / nig, fm = gid * WGM, gsz = (nM - fm) < WGM ? (nM - fm) : WGM;
    u.pm = fm + ((wgid % nig) % gsz); u.pn = (wgid % nig) / gsz; u.e = 0; return true;
  }
};
struct MergeSched {
  int nM, G, c;
  DEVINL void init(int nM_) { nM = nM_; G = gridDim.x; c = blockIdx.x; }
  DEVINL bool next(int i, Unit& u) const { const int tile = (i >> 2) * G + c; if (tile >= nM * 4) return false; u.pm = tile % nM; u.pn = tile / nM; u.e = i & 3; return true; }
};
struct MoeSched {
  const int* cnt; int npn, G, c, skip;
  DEVINL bool next(int i, Unit& u) const {
    int g = i * G + c - skip; if (g < 0) return false;
    int base = 0;
#pragma unroll 1
    for (int e = 0; e < 16; ++e) { const int n = ((cnt[e] + 255) >> 8) * npn; if (g < base + n) { const int r = g - base; u.e = e; u.pm = r / npn; u.pn = r % npn; return true; } base += n; }
    return false;
  }
};
struct RowAddr {
  int ld; int sel; unsigned estride;
  DEVINL unsigned operator()(const Unit& u, int r) const { return (unsigned)(((sel ? u.pn : u.pm) * 256 + r) * ld) * 2u + (unsigned)u.e * estride; }
};
struct GatherAddr {
  const int* list; const int* cnt; int rowbytes; int shift;
  DEVINL unsigned operator()(const Unit& u, int r) const {
    const int ce = cnt[u.e]; int ei = u.pm * 256 + r; ei = ei < ce ? ei : ce - 1;
    return (unsigned)(list[(size_t)u.e * T + ei] >> shift) * (unsigned)rowbytes;
  }
};

template <class Epi, class Sched, class AA, class AB>
DEVINL void gemm8(LAS unsigned char* lds, const char* Abase, const char* Bbase, int K, const Sched& S, const Epi& E, const AA& aA, const AB& aB) {
  const int tid = threadIdx.x, wid = __builtin_amdgcn_readfirstlane(tid >> 6), lane = tid & 63, wr = wid >> 2, wc = wid & 3, fr = lane & 15, fq = lane >> 4;
  const int nt = K / BK;
  int Rr[2], Cc[2], Rb[2];
#pragma unroll
  for (int i = 0; i < 2; ++i) { stage_rc(tid * 16 + i * 8192, Rr[i], Cc[i]); Rb[i] = Epi::PERM ? ((Rr[i] & ~31) + perm32(Rr[i] & 31)) : Rr[i]; }
  const unsigned ldsw = (unsigned)wid * 1024u;
  const int aoff = lds_byte(wr * 64 + fr, fq * 8), boff = lds_byte(wc * 32 + fr, fq * 8);
#define G8_SA(b, h) (((b) * 2 + (h)) * HTB)
#define G8_SB(b, h) ((4 + (b) * 2 + (h)) * HTB)
#define G8_STAGE(bufoff, base, kb, o) do { \
    __builtin_amdgcn_global_load_lds((const unsigned*)((base) + (o)[0] + (kb)), (LAS unsigned*)(lds + (bufoff) + ldsw), 16, 0, 0); \
    __builtin_amdgcn_global_load_lds((const unsigned*)((base) + (o)[1] + (kb)), (LAS unsigned*)(lds + (bufoff) + ldsw + 8192), 16, 0, 0); } while (0)
#define G8_LDA(dst, b, h) do { _Pragma("unroll") for (int m = 0; m < 4; ++m) _Pragma("unroll") for (int k = 0; k < 2; ++k) dst[m][k] = *(const LAS bf16x8*)(lds + G8_SA(b, h) + aoff + m * 2048 + k * 1024); } while (0)
#define G8_LDB(dst, b, h) do { _Pragma("unroll") for (int n = 0; n < 2; ++n) _Pragma("unroll") for (int k = 0; k < 2; ++k) dst[n][k] = *(const LAS bf16x8*)(lds + G8_SB(b, h) + boff + n * 2048 + k * 1024); } while (0)
#define G8_MMA(ai, bj, At, Bt) do { __builtin_amdgcn_s_setprio(1); _Pragma("unroll") for (int m = 0; m < 4; ++m) _Pragma("unroll") for (int n = 0; n < 2; ++n) _Pragma("unroll") for (int k = 0; k < 2; ++k) \
    acc[ai][bj][m][n] = __builtin_amdgcn_mfma_f32_16x16x32_bf16(Bt[n][k], At[m][k], acc[ai][bj][m][n], 0, 0, 0); __builtin_amdgcn_s_setprio(0); } while (0)
#define G8_WAIT_V(n) asm volatile("s_waitcnt vmcnt(" #n ")" ::: "memory")
#define G8_WAIT_L(n) asm volatile("s_waitcnt lgkmcnt(" #n ")" ::: "memory")
#define G8_BAR __builtin_amdgcn_s_barrier()
#define G8_SCHED __builtin_amdgcn_sched_barrier(0)
  Unit cur, nxt; int ui = 0;
  if (!S.next(0, cur)) return;
  Acc acc;
#pragma unroll
  for (int a = 0; a < 2; ++a)
#pragma unroll
    for (int b = 0; b < 2; ++b)
#pragma unroll
      for (int m = 0; m < 4; ++m)
#pragma unroll
        for (int n = 0; n < 2; ++n) acc[a][b][m][n] = f32x4{0.f, 0.f, 0.f, 0.f};
  bf16x8 At[4][2], B0[2][2], B1[2][2];
  unsigned oAc[2][2], oBc[2][2], oAn[2][2], oBn[2][2];
#pragma unroll
  for (int h = 0; h < 2; ++h)
#pragma unroll
    for (int i = 0; i < 2; ++i) { oAc[h][i] = aA(cur, h * 128 + Rr[i]) + Cc[i] * 2; oBc[h][i] = aB(cur, h * 128 + Rb[i]) + Cc[i] * 2; oAn[h][i] = oAc[h][i]; oBn[h][i] = oBc[h][i]; }
  G8_STAGE(G8_SB(0, 0), Bbase, 0, oBc[0]); G8_STAGE(G8_SA(0, 0), Abase, 0, oAc[0]); G8_STAGE(G8_SB(0, 1), Bbase, 0, oBc[1]); G8_STAGE(G8_SA(0, 1), Abase, 0, oAc[1]);
  if (wr == 1) G8_BAR;
  G8_WAIT_V(4); G8_BAR;
  G8_STAGE(G8_SB(1, 0), Bbase, 128, oBc[0]); G8_STAGE(G8_SA(1, 0), Abase, 128, oAc[0]); G8_STAGE(G8_SB(1, 1), Bbase, 128, oBc[1]);
  G8_WAIT_V(6); G8_BAR;
  for (;;) {
    const bool has_next = S.next(ui + 1, nxt);
    if (has_next) {
#pragma unroll
      for (int h = 0; h < 2; ++h)
#pragma unroll
        for (int i = 0; i < 2; ++i) { oAn[h][i] = aA(nxt, h * 128 + Rr[i]) + Cc[i] * 2; oBn[h][i] = aB(nxt, h * 128 + Rb[i]) + Cc[i] * 2; }
    } else {
#pragma unroll
      for (int h = 0; h < 2; ++h)
#pragma unroll
        for (int i = 0; i < 2; ++i) { oAn[h][i] = oAc[h][i]; oBn[h][i] = oBc[h][i]; }
    }
    for (int t = 0; t < nt; t += 2) {
      const bool last = (t == nt - 2);
      const int k1 = (t + 1) * 128, k2 = last ? 0 : (t + 2) * 128, k3 = k2 + 128;
      unsigned a2[2][2], b2[2][2];
#pragma unroll
      for (int h = 0; h < 2; ++h)
#pragma unroll
        for (int i = 0; i < 2; ++i) { a2[h][i] = last ? oAn[h][i] : oAc[h][i]; b2[h][i] = last ? oBn[h][i] : oBc[h][i]; }
      G8_LDB(B0, 0, 0); G8_SCHED; G8_LDA(At, 0, 0); G8_STAGE(G8_SA(1, 1), Abase, k1, oAc[1]);
      G8_WAIT_L(8); G8_BAR; G8_WAIT_L(0); G8_MMA(0, 0, At, B0); G8_BAR; G8_SCHED;
      G8_LDB(B1, 0, 1); G8_STAGE(G8_SB(0, 0), Bbase, k2, b2[0]);
      G8_BAR; G8_WAIT_L(0); G8_MMA(0, 1, At, B1); G8_BAR;
      G8_LDA(At, 0, 1); G8_STAGE(G8_SA(0, 0), Abase, k2, a2[0]);
      G8_BAR; G8_WAIT_L(0); G8_MMA(1, 0, At, B0); G8_BAR; G8_SCHED;
      G8_STAGE(G8_SB(0, 1), Bbase, k2, b2[1]);
      G8_WAIT_V(6); G8_BAR; G8_MMA(1, 1, At, B1); G8_BAR;
      G8_LDB(B0, 1, 0); G8_SCHED; G8_LDA(At, 1, 0); G8_STAGE(G8_SA(0, 1), Abase, k2, a2[1]);
      G8_WAIT_L(8); G8_BAR; G8_WAIT_L(0); G8_MMA(0, 0, At, B0); G8_BAR; G8_SCHED;
      G8_LDB(B1, 1, 1); G8_STAGE(G8_SB(1, 0), Bbase, k3, b2[0]);
      G8_BAR; G8_WAIT_L(0); G8_MMA(0, 1, At, B1); G8_BAR;
      G8_LDA(At, 1, 1); G8_STAGE(G8_SA(1, 0), Abase, k3, a2[0]);
      G8_BAR; G8_WAIT_L(0); G8_MMA(1, 0, At, B0); G8_BAR; G8_SCHED;
      G8_STAGE(G8_SB(1, 1), Bbase, k3, b2[1]);
      G8_WAIT_V(6); G8_BAR; G8_MMA(1, 1, At, B1); G8_BAR;
    }
    E(acc, cur, wr, wc, fr, fq);
    if (!has_next) break;
#pragma unroll
    for (int a = 0; a < 2; ++a)
#pragma unroll
      for (int b = 0; b < 2; ++b)
#pragma unroll
        for (int m = 0; m < 4; ++m)
#pragma unroll
          for (int n = 0; n < 2; ++n) acc[a][b][m][n] = f32x4{0.f, 0.f, 0.f, 0.f};
    cur = nxt; ++ui;
#pragma unroll
    for (int h = 0; h < 2; ++h)
#pragma unroll
      for (int i = 0; i < 2; ++i) { oAc[h][i] = oAn[h][i]; oBc[h][i] = oBn[h][i]; }
  }
  G8_WAIT_V(0);
  if (wr == 0) G8_BAR;
  G8_BAR;
#undef G8_SA
#undef G8_SB
#undef G8_STAGE
#undef G8_LDA
#undef G8_LDB
#undef G8_MMA
#undef G8_WAIT_V
#undef G8_WAIT_L
#undef G8_BAR
#undef G8_SCHED
}
}

#define CONV_ARGS(x) const float* x##src, bfr* x##dst, int x##N, int x##Kd, int x##kt, int x##nt, int x##drow0
#define CONV_REFS(x) const float*& x##src, bfr*& x##dst, int& x##N, int& x##Kd, int& x##kt, int& x##nt, int& x##drow0
#define CONV_PASS(x) x##src, x##dst, x##N, x##Kd, x##kt, x##nt, x##drow0
DEVINL void conv_load(CONV_ARGS(d_), f32x4& v0, f32x4& v1) {
  const int tid = threadIdx.x, r = tid >> 4, c4 = (tid & 15) * 4;
  (void)d_dst; (void)d_Kd; (void)d_drow0;
  if (d_src) {
    const float* s = d_src + (size_t)(d_kt * 64 + r) * d_N + d_nt * 64 + c4;
    v0 = *(const f32x4*)s; v1 = *(const f32x4*)(s + (size_t)32 * d_N);
  } else { v0 = f32x4{0.f, 0.f, 0.f, 0.f}; v1 = v0; }
}
DEVINL void conv_store(CONV_ARGS(d_), const f32x4& v0, const f32x4& v1, char* sm) {
  float* tile = (float*)sm;
  const int tid = threadIdx.x, r = tid >> 4, c4 = (tid & 15) * 4;
  (void)d_src; (void)d_N; (void)d_nt;
  __syncthreads();
  tile[r * 65 + c4] = v0[0]; tile[r * 65 + c4 + 1] = v0[1]; tile[r * 65 + c4 + 2] = v0[2]; tile[r * 65 + c4 + 3] = v0[3];
  tile[(r + 32) * 65 + c4] = v1[0]; tile[(r + 32) * 65 + c4 + 1] = v1[1]; tile[(r + 32) * 65 + c4 + 2] = v1[2]; tile[(r + 32) * 65 + c4 + 3] = v1[3];
  __syncthreads();
  const int n = tid >> 3, k8 = (tid & 7) * 8;
  float y[8];
#pragma unroll
  for (int j = 0; j < 8; ++j) y[j] = tile[(k8 + j) * 65 + n];
  *(uint4*)(d_dst + (size_t)(d_drow0 + n) * d_Kd + d_kt * 64 + k8) = make_uint4(pack2(y[0], y[1]), pack2(y[2], y[3]), pack2(y[4], y[5]), pack2(y[6], y[7]));
}
constexpr int CONV_L_ITEMS = 1712 + 16 + 1024 + 512 + 256;
DEVINL void conv_layer_desc(const Params& p, int l, int it, CONV_REFS(d_)) {
  if (it < 1712) { d_src = p.w_in + (size_t)l * D * NIN; d_dst = p.WinT; d_N = NIN; d_Kd = D; d_kt = it / 107; d_nt = it % 107; }
  else if (it < 1728) { d_src = nullptr; d_dst = p.WinT; d_N = 0; d_Kd = D; d_kt = it - 1712; d_nt = 107; }
  else if (it < 2752) { const int g = (it - 1728) >> 8, r = (it - 1728) & 255; d_src = p.w_gate + ((size_t)l * 4 + g) * D * D; d_dst = p.WgT + (size_t)g * D * D; d_N = D; d_Kd = D; d_kt = r >> 4; d_nt = r & 15; }
  else if (it < 3264) { const int g = (it - 2752) >> 7, r = (it - 2752) & 127; d_src = p.w_branch + ((size_t)l * 4 + g) * 512 * D; d_dst = p.WbT + (size_t)g * D * 512; d_N = D; d_Kd = 512; d_kt = r >> 4; d_nt = r & 15; }
  else { const int r = it - 3264; d_src = p.w_out + (size_t)l * D * D; d_dst = p.WoT; d_N = D; d_Kd = D; d_kt = r >> 4; d_nt = r & 15; }
  d_drow0 = d_nt * 64;
}
constexpr int CONV_M_ITEMS = 6144;
DEVINL void conv_moe_desc(const Params& p, int l, int it, CONV_REFS(d_)) {
  const int which = it / 2048, r = it % 2048, e = r >> 7, tt = r & 127;
  const size_t eo = ((size_t)l * 16 + e) * (size_t)D * 512;
  if (which < 2) { d_src = (which ? p.moe_w_up : p.moe_w_gate) + eo; d_dst = p.WmguT + (size_t)e * D * D; d_N = 512; d_Kd = D; d_kt = tt >> 3; d_nt = tt & 7; d_drow0 = ((tt & 7) >> 1) * 256 + which * 128 + ((tt & 7) & 1) * 64; }
  else { d_src = p.moe_w_down + eo; d_dst = p.WmdT + (size_t)e * D * 512; d_N = D; d_Kd = 512; d_kt = tt >> 4; d_nt = tt & 15; d_drow0 = (tt & 15) * 64; }
}
template <bool MOE>
DEVINL void convert_range(const Params& p, int l, int start, int end, int stride, char* sm) {
  if (start >= end) return;
  const float* c_src; bfr* c_dst; int c_N, c_Kd, c_kt, c_nt, c_drow0;
  if (MOE) conv_moe_desc(p, l, start, CONV_PASS(c_)); else conv_layer_desc(p, l, start, CONV_PASS(c_));
  f32x4 v0, v1; conv_load(CONV_PASS(c_), v0, v1);
#pragma unroll 1
  for (int it = start; it < end; it += stride) {
    const int itn = (it + stride < end) ? it + stride : it;
    const float* n_src; bfr* n_dst; int n_N, n_Kd, n_kt, n_nt, n_drow0;
    if (MOE) conv_moe_desc(p, l, itn, CONV_PASS(n_)); else conv_layer_desc(p, l, itn, CONV_PASS(n_));
    f32x4 n0, n1; conv_load(CONV_PASS(n_), n0, n1);
    conv_store(CONV_PASS(c_), v0, v1, sm);
    c_src = n_src; c_dst = n_dst; c_N = n_N; c_Kd = n_Kd; c_kt = n_kt; c_nt = n_nt; c_drow0 = n_drow0; v0 = n0; v1 = n1;
  }
}
#undef CONV_ARGS
#undef CONV_REFS
#undef CONV_PASS

DEVINL void adaln_item(const Params& p, int it, char* sm) {
  const int l = it / 96, jb = it % 96, tid = threadIdx.x, c = tid & 63, ks = tid >> 6;
  float* sc = (float*)sm;
  float* red = sc + 5 * 1024;
  __syncthreads();
  for (int i = tid; i < 5 * 1024; i += NTHR) { const int v = i >> 10, k = i & 1023; const float cv = v < 4 ? p.c[v * 1024 + k] : p.c_ctx[k]; sc[i] = silu(cv); }
  __syncthreads();
  const int j = jb * 64 + c;
  float a[5] = {0.f, 0.f, 0.f, 0.f, 0.f};
  const float* w = p.ada_w + (size_t)l * D * 6144 + j;
#pragma unroll 16
  for (int k = ks * 128; k < ks * 128 + 128; ++k) {
    const float wv = w[(size_t)k * 6144];
#pragma unroll
    for (int v = 0; v < 5; ++v) a[v] += sc[v * 1024 + k] * wv;
  }
#pragma unroll
  for (int v = 0; v < 5; ++v) red[(ks * 5 + v) * 64 + c] = a[v];
  __syncthreads();
  if (tid < 320) {
    const int v = tid >> 6;
    float sum = 0.f;
#pragma unroll
    for (int q = 0; q < 8; ++q) sum += red[(q * 5 + v) * 64 + c];
    p.mod[((size_t)l * 5 + v) * 6144 + j] = sum + p.ada_b[l * 6144 + j];
  }
}
DEVINL void phase_prologue(const Params& p, char* sm) {
  if (blockIdx.x < 192) adaln_item(p, blockIdx.x, sm);
  convert_range<false>(p, 0, blockIdx.x, 1728, gridDim.x, sm);
}

DEVINL int canon_row(int L, int R) {
  if (L & 1) { const int b = R >> 12, s = R & 4095; return (b << 12) | ((s & 63) << 6) | (s >> 6); }
  return R;
}
template <int L>
DEVINL void phase_norm1(const Params& p) {
  const int lane = threadIdx.x & 63, wave = threadIdx.x >> 6;
  for (int R = blockIdx.x * 8 + wave; R < T; R += gridDim.x * 8) {
    const bool lat = R < TL;
    const int cr = lat ? canon_row(L, R) : R;
    const int vv = lat ? (R >> 12) : 4;
    float* xp = lat ? p.out + (size_t)cr * D : p.xc + (size_t)(R - TL) * D;
    const float* src = lat ? p.x + (size_t)cr * D : p.ctx + (size_t)(R - TL) * D;
    float4 xq[4]; uint2 y0q[4], y1q[4]; float4 m5q[4];
#pragma unroll
    for (int q = 0; q < 4; ++q) {
      const int j = q * 256 + lane * 4;
      if (L == 0) xq[q] = *(const float4*)(src + j);
      else {
        xq[q] = *(const float4*)(xp + j);
        m5q[q] = *(const float4*)(p.mod + ((size_t)(L - 1) * 5 + vv) * 6144 + 5 * 1024 + j);
        y0q[q] = *(const uint2*)(p.YS + (size_t)cr * D + j); y1q[q] = *(const uint2*)(p.YS + (size_t)T * D + (size_t)cr * D + j);
      }
    }
    float v[16]; float ss = 0.f;
#pragma unroll
    for (int q = 0; q < 4; ++q) {
      const int j = q * 256 + lane * 4;
      float4 xv = xq[q];
      if (L != 0) {
        const float4 m5 = m5q[q]; const uint2 y0 = y0q[q], y1 = y1q[q];
        xv.x += m5.x * (bf2f(y0.x & 0xFFFF) + bf2f(y1.x & 0xFFFF)); xv.y += m5.y * (bf2f(y0.x >> 16) + bf2f(y1.x >> 16));
        xv.z += m5.z * (bf2f(y0.y & 0xFFFF) + bf2f(y1.y & 0xFFFF)); xv.w += m5.w * (bf2f(y0.y >> 16) + bf2f(y1.y >> 16));
      }
      *(float4*)(xp + j) = xv;
      v[q * 4] = xv.x; v[q * 4 + 1] = xv.y; v[q * 4 + 2] = xv.z; v[q * 4 + 3] = xv.w;
      ss += xv.x * xv.x + xv.y * xv.y + xv.z * xv.z + xv.w * xv.w;
    }
    ss = wave_sum(ss);
    const float rs = rsqrtf(ss * (1.f / 1024.f) + EPS);
    const float* md = p.mod + ((size_t)L * 5 + vv) * 6144;
    float4 nwq[4], shq[4], sclq[4];
#pragma unroll
    for (int q = 0; q < 4; ++q) { const int j = q * 256 + lane * 4; nwq[q] = *(const float4*)(p.norm_mix + L * D + j); shq[q] = *(const float4*)(md + j); sclq[q] = *(const float4*)(md + 1024 + j); }
#pragma unroll
    for (int q = 0; q < 4; ++q) {
      const int j = q * 256 + lane * 4;
      const float4 nw = nwq[q], sh = shq[q], scl = sclq[q];
      const float h0 = v[q * 4] * rs * nw.x * (1.f + scl.x) + sh.x, h1 = v[q * 4 + 1] * rs * nw.y * (1.f + scl.y) + sh.y;
      const float h2 = v[q * 4 + 2] * rs * nw.z * (1.f + scl.z) + sh.z, h3 = v[q * 4 + 3] * rs * nw.w * (1.f + scl.w) + sh.w;
      *(uint2*)(p.O + (size_t)R * OLD + 2048 + j) = make_uint2(pack2(h0, h1), pack2(h2, h3));
    }
  }
}

DEVINL void chunk_of_step(int step, int b, int d, int& rb, int& len, int& c) {
  const int seg = step >= 4, cc = seg ? step - 4 : step, nch = seg ? 64 : 4;
  c = d ? nch - 1 - cc : cc; len = seg ? SEQ : CTXL; rb = seg ? b * SEQ : TL + b * CTXL;
}
template <int KS>
DEVINL f32x4 mma16(const bfr* A, int lda, const bfr* Bt, int ldb, f32x4 acc) {
  const int lane = threadIdx.x & 63;
  const bfr* ap = A + (lane & 15) * lda + (lane >> 4) * 8;
  const bfr* bp = Bt + (lane & 15) * ldb + (lane >> 4) * 8;
#pragma unroll
  for (int ks = 0; ks < KS; ++ks) acc = __builtin_amdgcn_mfma_f32_16x16x32_bf16(*(const bf16x8*)(ap + 32 * ks), *(const bf16x8*)(bp + 32 * ks), acc, 0, 0, 0);
  return acc;
}
DEVINL void unpack8(const uint4 v, float (&o)[8]) {
  o[0] = __uint_as_float(v.x << 16); o[1] = __uint_as_float(v.x & 0xFFFF0000u); o[2] = __uint_as_float(v.y << 16); o[3] = __uint_as_float(v.y & 0xFFFF0000u);
  o[4] = __uint_as_float(v.z << 16); o[5] = __uint_as_float(v.z & 0xFFFF0000u); o[6] = __uint_as_float(v.w << 16); o[7] = __uint_as_float(v.w & 0xFFFF0000u);
}
DEVINL void unpack4(const uint2 v, float (&o)[4]) {
  o[0] = __uint_as_float(v.x << 16); o[1] = __uint_as_float(v.x & 0xFFFF0000u); o[2] = __uint_as_float(v.y << 16); o[3] = __uint_as_float(v.y & 0xFFFF0000u);
}


template <int W8>
DEVINL void prep_item(const Params& p, int b, int col0, const float* t0g, const float* t1g, const float* t2g, const float* bg, bool shiftmode, int act, bool norm, float nscale, char* sm) {
  constexpr int W = W8 * 8, RS = 256, NV = (RS + 1) * W8, NPF = (NV + NTHR - 1) / NTHR, G = W8 / 8;
  const int tid = threadIdx.x;
  bfr* RAWP = (bfr*)sm;
  float* PT = (float*)(RAWP + (RS + 2) * W);
  __syncthreads();
  for (int c = tid; c < W; c += NTHR) {
    if (shiftmode) { const float mu = t0g[c]; PT[c] = 0.5f * mu; PT[W + c] = 1.f - mu; PT[2 * W + c] = 0.5f * mu; PT[3 * W + c] = 0.f; }
    else { PT[c] = t0g[c]; PT[W + c] = t1g[c]; PT[2 * W + c] = t2g[c]; PT[3 * W + c] = bg ? bg[c] : 0.f; }
  }
  uint4 pf[NPF];
  auto prefetch = [&](int step) {
    const int seg = step >= 1, cc = seg ? step - 1 : 0, len = seg ? SEQ : CTXL, rb = seg ? b * SEQ : TL + b * CTXL;
#pragma unroll
    for (int q = 0; q < NPF; ++q) {
      const int idx = tid + NTHR * q;
      uint4 v = make_uint4(0, 0, 0, 0);
      if (idx < NV) { const int r = idx / W8, g = idx % W8, t = cc * RS + r; if (t < len) v = *(const uint4*)(p.P + (size_t)(rb + t) * NINP + col0 + g * 8); }
      pf[q] = v;
    }
  };
  prefetch(0);
#pragma unroll 1
  for (int step = 0; step < 17; ++step) {
    const int seg = step >= 1, cc = seg ? step - 1 : 0, rb = seg ? b * SEQ : TL + b * CTXL;
    __syncthreads();
    if (tid < W8) *(uint4*)(RAWP + tid * 8) = (cc == 0) ? make_uint4(0, 0, 0, 0) : *(const uint4*)(RAWP + RS * W + tid * 8);
    __syncthreads();
#pragma unroll
    for (int q = 0; q < NPF; ++q) { const int idx = tid + NTHR * q; if (idx < NV) *(uint4*)(RAWP + (1 + idx / W8) * W + (idx % W8) * 8) = pf[q]; }
    __syncthreads();
    if (step + 1 < 17) prefetch(step + 1);
#pragma unroll 1
    for (int rep = 0; rep < 4; ++rep) {
      const int i = rep * 64 + (tid >> 3);
      float ssq = 0.f; float y[G][8];
#pragma unroll
      for (int gq = 0; gq < G; ++gq) {
        const int cbase = ((tid & 7) * G + gq) * 8;
        float x0[8], x1[8], x2[8];
        unpack8(*(const uint4*)(RAWP + i * W + cbase), x0); unpack8(*(const uint4*)(RAWP + (i + 1) * W + cbase), x1); unpack8(*(const uint4*)(RAWP + (i + 2) * W + cbase), x2);
#pragma unroll
        for (int e = 0; e < 8; ++e) {
          float v = PT[cbase + e] * x0[e] + PT[W + cbase + e] * x1[e] + PT[2 * W + cbase + e] * x2[e] + PT[3 * W + cbase + e];
          if (act == 1) v = silu(v); else if (act == 2) v = 1.f - 2.f * __builtin_amdgcn_rcpf(1.f + __expf(2.f * v)); else if (act == 3) v = sigm(v);
          y[gq][e] = v; ssq += v * v;
        }
      }
      float sc = 1.f;
      if (norm) { ssq = dpp_sum8(ssq); sc = __builtin_amdgcn_rsqf(ssq + EPS) * nscale; }
#pragma unroll
      for (int gq = 0; gq < G; ++gq) {
        const int cbase = ((tid & 7) * G + gq) * 8;
        *(uint4*)(p.P + (size_t)(rb + cc * RS + i) * NINP + col0 + cbase) =
            make_uint4(pack2(y[gq][0] * sc, y[gq][1] * sc), pack2(y[gq][2] * sc, y[gq][3] * sc), pack2(y[gq][4] * sc, y[gq][5] * sc), pack2(y[gq][6] * sc, y[gq][7] * sc));
      }
    }
  }
}
template <int L>
DEVINL void phase_prep(const Params& p, char* sm) {
  const int it = blockIdx.x;
  if (it >= 232) {
    for (int idx = (it - 232) * NTHR + threadIdx.x; idx < 512 * 256; idx += 24 * NTHR) { const int c = idx >> 8, k = idx & 255; p.g2T[idx] = k < 128 ? f2bf(p.rwkv_g2[((size_t)L * 128 + k) * 512 + c]) : (bfr)0; }
    return;
  }
  if (it < 32) {
    const int b = it >> 3, r = it & 7, isk = r >> 2, h = r & 3, ch = isk * 512 + h * 128;
    const float* cw = p.gdn_conv_w + (size_t)L * 3 * 1536 + ch;
    prep_item<16>(p, b, C_GDN + ch, cw, cw + 1536, cw + 3072, nullptr, false, 1, true, isk ? 1.f : 0.08838834764831845f, sm);
    return;
  }
  const int j = it - 32, b = j / 50, r = j % 50;
  if (r < 12) {
    const int ch = r * 64; const float* cw = p.ssm_conv_w + (size_t)L * 3 * 768 + ch;
    prep_item<8>(p, b, C_SSM + 512 + ch, cw, cw + 768, cw + 1536, p.ssm_conv_b + L * 768 + ch, false, 1, false, 1.f, sm);
  } else if (r < 20) {
    const int ch = 1024 + (r - 12) * 64; const float* cw = p.gdn_conv_w + (size_t)L * 3 * 1536 + ch;
    prep_item<8>(p, b, C_GDN + ch, cw, cw + 1536, cw + 3072, nullptr, false, 1, false, 1.f, sm);
  } else {
    const int ch = (r - 20) * 64; const float* mu = p.rwkv_mu + L * 1920 + ch;
    const int act = (ch >= 1536 && ch < 1664) ? 2 : (ch >= 1792 ? 3 : 0);
    prep_item<8>(p, b, C_RWKV + ch, mu, mu, mu, nullptr, true, act, false, 1.f, sm);
  }
}

DEVINL int rwkv_colbase(int g, int h, int d) { return g == 0 ? h * 64 : g == 1 ? 512 + h * 64 : g == 2 ? 1024 + h * 64 : g == 3 ? 1536 + d * 64 : 1664 + d * 64; }
DEVINL f32x4 bmm16(const float* A, int lda, const float* B, int ldb, f32x4 acc) {
  const int lane = threadIdx.x & 63;
#pragma unroll
  for (int s2 = 0; s2 < 4; ++s2) {
    const float a = A[(lane & 15) * lda + 4 * s2 + (lane >> 4)], b = B[(4 * s2 + (lane >> 4)) * ldb + (lane & 15)];
    acc = __builtin_amdgcn_mfma_f32_16x16x4f32(a, b, acc, 0, 0, 0);
  }
  asm volatile("" ::: "memory");
  return acc;
}
DEVINL void chunk32_of_step(int step, int b, int d, int& rb, int& c) {
  const int seg = step >= 8, cc = seg ? step - 8 : step, nch = seg ? 128 : 8;
  c = d ? nch - 1 - cc : cc; rb = seg ? b * SEQ : TL + b * CTXL;
}
DEVINL void rwkv3_prefetch(const Params& p, uint4& pfA, uint4& pfB, uint4 (&fw)[2], int step, int b, int d, int h) {
  int rb, c; chunk32_of_step(step, b, d, rb, c);
  const int tid = threadIdx.x, lane = tid & 63, ti = (tid >> 7) & 1, mat = (tid >> 6) & 1;
  const bfr* base = p.P + (size_t)(rb + c * 32) * NINP + C_RWKV;
  { const int r = tid >> 4, g = tid & 15; pfA = *(const uint4*)(base + (size_t)r * NINP + (g < 8 ? rwkv_colbase(0, h, d) + g * 8 : rwkv_colbase(1, h, d) + (g - 8) * 8)); }
  if (tid < 256) { const int r = tid >> 3, g = tid & 7; pfB = *(const uint4*)(base + (size_t)r * NINP + rwkv_colbase(2, h, d) + g * 8); }
  {
    const int i = ti * 16 + (lane & 15), r = d ? 31 - i : i;
    const bfr* rowp = base + (size_t)r * NINP + (lane >> 4) * 8;
    const int cb = mat ? rwkv_colbase(4, h, d) : rwkv_colbase(3, h, d);
    fw[0] = *(const uint4*)(rowp + cb); fw[1] = *(const uint4*)(rowp + cb + 32);
  }
}
template <int L>
DEVINL void scan_rwkv3(const Params& p, int item, char* sm) {
  const int d = item & 1, h = (item >> 1) & 7, b = item >> 4;
  const int tid = threadIdx.x, lane = tid & 63, wave = __builtin_amdgcn_readfirstlane(tid >> 6);
  constexpr int LK = 72, LJ = 40, LFS = 36, NCH = 136;
  bfr* w2T = (bfr*)sm; bfr* a2T = w2T + 64 * LK; bfr* RK = a2T + 64 * LK; bfr* BR = RK + 32 * 128; bfr* KR = BR + 32 * LK;
  float* Gf = (float*)(KR + 32 * LK); float* LWf = Gf + 2048; float* ARf = LWf + 2048;
  bfr* KH = (bfr*)(ARf + 2048); bfr* RH = KH + 32 * LK; bfr* BC = RH + 32 * LK; bfr* KC = BC + 32 * LK;
  bfr* BTt = KC + 32 * LK; bfr* KTt = BTt + 64 * LJ; bfr* VT0 = KTt + 64 * LJ; bfr* VT1 = VT0 + 64 * LJ;
  float* Lf = (float*)(VT1 + 64 * LJ); float* Tf = Lf + 32 * LFS;
  bfr* Tm = (bfr*)(Tf + 32 * LFS); bfr* Aak = Tm + 32 * LJ; bfr* Arb = Aak + 32 * LJ; bfr* Ark = Arb + 32 * LJ;
  bfr* ZT = Ark + 32 * LJ; bfr* UT = ZT + 64 * LJ; bfr* S0b = UT + 64 * LJ; bfr* OST = S0b + 64 * LK; bfr* VR = OST + 32 * LK;
  float* GC0 = (float*)(VR + 32 * LK); float* GC1 = GC0 + 64; float* TMPX = GC1 + 64; float* BONL = TMPX + 256;
  for (int i = tid; i < 4096; i += NTHR) {
    const int r = i >> 6, c = i & 63;
    w2T[c * LK + r] = f2bf(p.rwkv_w2[((size_t)(L * 2 + d) * 64 + r) * 512 + h * 64 + c]);
    a2T[c * LK + r] = f2bf(p.rwkv_a2[((size_t)(L * 2 + d) * 64 + r) * 512 + h * 64 + c]);
  }
  for (int i = tid; i < 64 * LK; i += NTHR) S0b[i] = 0;
  const int c4 = (tid & 15) * 4;
  const float4 a0v = *(const float4*)(p.rwkv_a0 + (L * 2 + d) * 512 + h * 64 + c4);
  const float4 kkv = *(const float4*)(p.rwkv_k_k + L * 512 + h * 64 + c4), kav = *(const float4*)(p.rwkv_k_a + L * 512 + h * 64 + c4), rkv = *(const float4*)(p.rwkv_r_k + L * 512 + h * 64 + c4);
  const int lr_mat = wave & 1, lr_ti = (wave >> 1) & 1, lr_tj = (wave >> 2) * 2;
  const float w0c0 = p.rwkv_w0[(L * 2 + d) * 512 + h * 64 + lr_tj * 16 + (lane & 15)], w0c1 = p.rwkv_w0[(L * 2 + d) * 512 + h * 64 + lr_tj * 16 + 16 + (lane & 15)];
  f32x4 Sm[4];
#pragma unroll
  for (int u = 0; u < 4; ++u) Sm[u] = f32x4{0.f, 0.f, 0.f, 0.f};
  uint4 pfA, pfB = make_uint4(0, 0, 0, 0), fw[2];
  const int tv = wave & 3;
  f32x4 p1[2], p2[2];
#define RW3_STAGE_LOWRANK() do { \
    { const int r_ = tid >> 4, g_ = tid & 15, i_ = d ? 31 - r_ : r_; *(uint4*)(RK + i_ * 128 + g_ * 8) = pfA; } \
    if (tid < 256) { const int r_ = tid >> 3, g_ = tid & 7, i_ = d ? 31 - r_ : r_; *(uint4*)(VR + i_ * LK + g_ * 8) = pfB; } \
    { const bfr* bm_ = (lr_mat ? a2T : w2T) + (lr_tj * 16 + (lane & 15)) * LK + (lane >> 4) * 8; \
      _Pragma("unroll") for (int q_ = 0; q_ < 2; ++q_) { \
        f32x4 cw_ = f32x4{0.f, 0.f, 0.f, 0.f}; \
        _Pragma("unroll") for (int ks_ = 0; ks_ < 2; ++ks_) \
          cw_ = __builtin_amdgcn_mfma_f32_16x16x32_bf16(__builtin_bit_cast(bf16x8, fw[ks_]), *(const bf16x8*)(bm_ + q_ * 16 * LK + 32 * ks_), cw_, 0, 0, 0); \
        _Pragma("unroll") for (int r_ = 0; r_ < 4; ++r_) { const int i_ = lr_ti * 16 + (lane >> 4) * 4 + r_, cc_ = (lr_tj + q_) * 16 + (lane & 15); \
          if (lr_mat) ARf[i_ * 64 + cc_] = cw_[r_]; else LWf[i_ * 64 + cc_] = -0.6065306597f * sigm(cw_[r_] + (q_ ? w0c1 : w0c0)); } } } } while (0)
#define RW3_VT(VTn, tl) do { const int v_ = (tl) & 63, iq_ = ((tl) >> 6) * 8; unsigned w_[4]; \
    _Pragma("unroll") for (int e_ = 0; e_ < 4; ++e_) w_[e_] = (unsigned)VR[(iq_ + 2 * e_) * LK + v_] | ((unsigned)VR[(iq_ + 2 * e_ + 1) * LK + v_] << 16); \
    *(uint4*)((VTn) + v_ * LJ + iq_) = make_uint4(w_[0], w_[1], w_[2], w_[3]); } while (0)
#define RW3_CUMSUM_TILE(GCn, id_) do { const int ti_ = (id_) >> 2, tj_ = (id_) & 3; \
      f32x4 gacc_ = f32x4{0.f, 0.f, 0.f, 0.f}; \
      _Pragma("unroll") for (int kb_ = 0; kb_ < 2; ++kb_) { if (kb_ <= ti_) { \
        _Pragma("unroll") for (int s4_ = 0; s4_ < 4; ++s4_) { const int kk2_ = 4 * s4_ + (lane >> 4); \
          const float av_ = (kb_ < ti_ || kk2_ <= (lane & 15)) ? 1.f : 0.f; const float bv_ = LWf[(kb_ * 16 + kk2_) * 64 + tj_ * 16 + (lane & 15)]; \
          gacc_ = __builtin_amdgcn_mfma_f32_16x16x4f32(av_, bv_, gacc_, 0, 0, 0); } } } \
      _Pragma("unroll") for (int r_ = 0; r_ < 4; ++r_) Gf[(ti_ * 16 + (lane >> 4) * 4 + r_) * 64 + tj_ * 16 + (lane & 15)] = gacc_[r_]; \
      if (ti_ == 1 && (lane >> 4) == 3) (GCn)[tj_ * 16 + (lane & 15)] = gacc_[3]; } while (0)
  rwkv3_prefetch(p, pfA, pfB, fw, 0, b, d, h);
  __syncthreads();
  RW3_STAGE_LOWRANK();
  rwkv3_prefetch(p, pfA, pfB, fw, 1, b, d, h);
  __syncthreads();
  RW3_CUMSUM_TILE(GC0, wave);
  if (wave >= 4) RW3_VT(VT0, tid - 256);
  __syncthreads();
  {
    int rb0, c0; chunk32_of_step(0, b, d, rb0, c0);
#define EW_I (tid >> 4)
#define EW_GC GC0
#define EW_RB rb0
#define EW_C c0
    {
      const int i = EW_I, t = d ? 31 - i : i;
      float rr[4], kk_[4];
      unpack4(*(const uint2*)(RK + i * 128 + c4), rr); unpack4(*(const uint2*)(RK + i * 128 + 64 + c4), kk_);
      const float4 g4 = *(const float4*)&Gf[i * 64 + c4], l4 = *(const float4*)&LWf[i * 64 + c4], ar4 = *(const float4*)&ARf[i * 64 + c4], gc4 = *(const float4*)&EW_GC[c4];
      const float gA[4] = {g4.x, g4.y, g4.z, g4.w}, lA[4] = {l4.x, l4.y, l4.z, l4.w}, arA[4] = {ar4.x, ar4.y, ar4.z, ar4.w}, gcA[4] = {gc4.x, gc4.y, gc4.z, gc4.w};
      const float a0A[4] = {a0v.x, a0v.y, a0v.z, a0v.w}, kkA[4] = {kkv.x, kkv.y, kkv.z, kkv.w}, kaA[4] = {kav.x, kav.y, kav.z, kav.w}, rkA[4] = {rkv.x, rkv.y, rkv.z, rkv.w};
      float a_[4], kraw[4], kd_[4]; float ss = 0.f;
#pragma unroll
      for (int e = 0; e < 4; ++e) { a_[e] = sigm(arA[e] + a0A[e]); kraw[e] = kk_[e] * kkA[e]; ss += kraw[e] * kraw[e]; kd_[e] = kk_[e] * (1.f + (a_[e] - 1.f) * kaA[e]); }
      ss = dpp_sum16(ss);
      const float rn = __builtin_amdgcn_rsqf(ss + EPS);
      float khv[4], rhv[4], bcv[4], kcv[4], btv[4], ktv[4]; float sb = 0.f;
#pragma unroll
      for (int e = 0; e < 4; ++e) {
        const float kn = kraw[e] * rn, bb = kn * a_[e];
        const float eI = __expf(gA[e]), eIm1 = __expf(gA[e] - lA[e]), eInv = __expf(-gA[e]), eC = __expf(gcA[e] - gA[e]);
        khv[e] = kn * eIm1; rhv[e] = rr[e] * eI; bcv[e] = bb * eInv; kcv[e] = kd_[e] * eInv;
        btv[e] = bb * eC; ktv[e] = kd_[e] * eC;
        sb += rr[e] * kd_[e] * rkA[e];
      }
      sb = dpp_sum16(sb);
      *(uint2*)(KH + i * LK + c4) = make_uint2(pack2(khv[0], khv[1]), pack2(khv[2], khv[3]));
      *(uint2*)(RH + i * LK + c4) = make_uint2(pack2(rhv[0], rhv[1]), pack2(rhv[2], rhv[3]));
      *(uint2*)(BC + i * LK + c4) = make_uint2(pack2(bcv[0], bcv[1]), pack2(bcv[2], bcv[3]));
      *(uint2*)(KC + i * LK + c4) = make_uint2(pack2(kcv[0], kcv[1]), pack2(kcv[2], kcv[3]));
      *(uint2*)(BR + i * LK + c4) = make_uint2(pack2(btv[0], btv[1]), pack2(btv[2], btv[3]));
      *(uint2*)(KR + i * LK + c4) = make_uint2(pack2(ktv[0], ktv[1]), pack2(ktv[2], ktv[3]));
      if ((tid & 15) == 0) p.bon[((size_t)d * T + EW_RB + EW_C * 32 + t) * 8 + h] = sb;
    }
#undef EW_I
#undef EW_GC
#undef EW_RB
#undef EW_C
  }
  __syncthreads();
#pragma unroll 1
  for (int step = 0; step < NCH; ++step) {
    int rb, c; chunk32_of_step(step, b, d, rb, c);
    bfr* VTc = (step & 1) ? VT1 : VT0; bfr* VTn = (step & 1) ? VT0 : VT1;
    float* GCc = (step & 1) ? GC1 : GC0; float* GCn = (step & 1) ? GC0 : GC1;
    const bool more = step + 1 < NCH;
    __builtin_amdgcn_s_waitcnt(0x0F70);
    if (more) RW3_STAGE_LOWRANK();
    if (step > 0 && lr_mat) {
      int rbp, cp; chunk32_of_step(step - 1, b, d, rbp, cp);
      const int tl = (wave >> 1) * 64 + lane, i = tl >> 3, c8 = (tl & 7) * 8, t = d ? 31 - i : i;
      *(uint4*)(p.O + (size_t)(rbp + cp * 32 + t) * OLD + d * 2048 + 2 * 512 + h * 64 + c8) = *(const uint4*)(OST + i * LK + c8);
      if (tl < 32) p.bon[((size_t)d * T + rb + c * 32 + tl) * 8 + h] = BONL[tl];
    }
    if (step + 2 < NCH) rwkv3_prefetch(p, pfA, pfB, fw, step + 2, b, d, h);
    __syncthreads();
    if (wave == 0) {
#pragma unroll
      for (int q = 0; q < 3; ++q) {
        const int ta = q >> 1 | (q & 1), tb = q >> 1;
        const f32x4 a = mma16<2>(KH + ta * 16 * LK, LK, BC + tb * 16 * LK, LK, f32x4{0.f, 0.f, 0.f, 0.f});
#pragma unroll
        for (int r = 0; r < 4; ++r) { const int t = ta * 16 + (lane >> 4) * 4 + r, j = tb * 16 + (lane & 15); Lf[t * LFS + j] = (j < t) ? a[r] : 0.f; }
      }
      asm volatile("s_waitcnt lgkmcnt(0)" ::: "memory");
      if (lane < 32) {
        const int blk = lane >> 4, cc = lane & 15;
        float x[16];
#pragma unroll
        for (int i = 0; i < 16; ++i) x[i] = (i == cc) ? 1.f : 0.f;
#pragma unroll
        for (int i = 1; i < 16; ++i) {
          const float* lr = Lf + (16 * blk + i) * LFS + 16 * blk;
#pragma unroll
          for (int j4 = 0; j4 < (i + 3) / 4; ++j4) {
            const float4 l4 = *(const float4*)(lr + 4 * j4);
            const float la[4] = {l4.x, l4.y, l4.z, l4.w};
#pragma unroll
            for (int e = 0; e < 4; ++e) if (4 * j4 + e < i) x[i] -= la[e] * x[4 * j4 + e];
          }
          asm volatile("" ::: "memory");
        }
#pragma unroll
        for (int i = 0; i < 16; ++i) Tf[(16 * blk + i) * LFS + 16 * blk + cc] = x[i];
      }
      asm volatile("s_waitcnt lgkmcnt(0)" ::: "memory");
      {
        const f32x4 xa = bmm16(Lf + 16 * LFS, LFS, Tf, LFS, f32x4{0.f, 0.f, 0.f, 0.f});
#pragma unroll
        for (int r = 0; r < 4; ++r) TMPX[((lane >> 4) * 4 + r) * 16 + (lane & 15)] = xa[r];
        asm volatile("s_waitcnt lgkmcnt(0)" ::: "memory");
        const f32x4 ta2 = bmm16(Tf + 16 * LFS + 16, LFS, TMPX, 16, f32x4{0.f, 0.f, 0.f, 0.f});
#pragma unroll
        for (int r = 0; r < 4; ++r) Tf[(16 + (lane >> 4) * 4 + r) * LFS + (lane & 15)] = -ta2[r];
      }
      asm volatile("s_waitcnt lgkmcnt(0)" ::: "memory");
#pragma unroll
      for (int q = 0; q < 4; ++q) {
        const int idx = lane + 64 * q, i = idx >> 3, j4 = (idx & 7) * 4;
        float tvv[4];
#pragma unroll
        for (int e = 0; e < 4; ++e) tvv[e] = ((j4 >> 4) <= (i >> 4)) ? Tf[i * LFS + j4 + e] : 0.f;
        *(uint2*)(Tm + i * LJ + j4) = make_uint2(pack2(tvv[0], tvv[1]), pack2(tvv[2], tvv[3]));
      }
    } else if (wave < 4) {
#pragma unroll
      for (int u = 0; u < 4; ++u) {
        const int id = (wave - 1) * 4 + u, prod = 1 + (id >> 2), ta = (id >> 1) & 1, tb = id & 1;
        f32x4 a = f32x4{0.f, 0.f, 0.f, 0.f};
        const bfr* Aop = (prod == 2) ? BC : KC; const bfr* Bop = (prod == 1) ? KH : RH;
        if (tb <= ta) a = mma16<2>(Aop + tb * 16 * LK, LK, Bop + ta * 16 * LK, LK, a);
        const int t = ta * 16 + (lane & 15), j0 = tb * 16 + (lane >> 4) * 4;
        float v4[4];
#pragma unroll
        for (int r = 0; r < 4; ++r) { const int j = j0 + r; v4[r] = ((prod == 1) ? (j < t) : (j <= t)) ? a[r] : 0.f; }
        bfr* Dst = (prod == 1) ? Aak : (prod == 2 ? Arb : Ark);
        *(uint2*)(Dst + t * LJ + j0) = make_uint2(pack2(v4[0], v4[1]), pack2(v4[2], v4[3]));
      }
    } else {
      {
        const int tl = tid - 256, k = tl & 63, iq = (tl >> 6) * 8;
        unsigned bw[4], kw[4];
#pragma unroll
        for (int e = 0; e < 4; ++e) {
          bw[e] = (unsigned)BR[(iq + 2 * e) * LK + k] | ((unsigned)BR[(iq + 2 * e + 1) * LK + k] << 16);
          kw[e] = (unsigned)KR[(iq + 2 * e) * LK + k] | ((unsigned)KR[(iq + 2 * e + 1) * LK + k] << 16);
        }
        *(uint4*)(BTt + k * LJ + iq) = make_uint4(bw[0], bw[1], bw[2], bw[3]);
        *(uint4*)(KTt + k * LJ + iq) = make_uint4(kw[0], kw[1], kw[2], kw[3]);
      }
#pragma unroll
      for (int ti = 0; ti < 2; ++ti) {
        p1[ti] = mma16<2>(KH + ti * 16 * LK, LK, S0b + tv * 16 * LK, LK, f32x4{0.f, 0.f, 0.f, 0.f});
        p2[ti] = mma16<2>(RH + ti * 16 * LK, LK, S0b + tv * 16 * LK, LK, f32x4{0.f, 0.f, 0.f, 0.f});
      }
    }
    if (more) {
      if (wave >= 1 && wave < 4) { RW3_CUMSUM_TILE(GCn, wave - 1); RW3_CUMSUM_TILE(GCn, wave + 2); if (wave < 3) RW3_CUMSUM_TILE(GCn, wave + 5); }
      if (wave >= 4) RW3_VT(VTn, tid - 256);
    }
    __syncthreads();
    if (wave >= 4) {
      const int vrow = (tv * 16 + (lane & 15)) * LJ + (lane >> 4) * 4;
#pragma unroll
      for (int ti = 0; ti < 2; ++ti) {
        const f32x4 z = mma16<1>(Aak + ti * 16 * LJ, LJ, VTc + tv * 16 * LJ, LJ, p1[ti]);
        *(uint2*)(ZT + vrow + ti * 16) = make_uint2(pack2(-z[0], -z[1]), pack2(-z[2], -z[3]));
      }
#pragma unroll
      for (int ti = 0; ti < 2; ++ti) {
        const f32x4 uu = mma16<1>(Tm + ti * 16 * LJ, LJ, ZT + tv * 16 * LJ, LJ, f32x4{0.f, 0.f, 0.f, 0.f});
        *(uint2*)(UT + vrow + ti * 16) = make_uint2(pack2(uu[0], uu[1]), pack2(uu[2], uu[3]));
      }
#pragma unroll
      for (int ti = 0; ti < 2; ++ti) {
        f32x4 o = mma16<1>(Arb + ti * 16 * LJ, LJ, UT + tv * 16 * LJ, LJ, p2[ti]);
        o = mma16<1>(Ark + ti * 16 * LJ, LJ, VTc + tv * 16 * LJ, LJ, o);
#pragma unroll
        for (int r = 0; r < 4; ++r) OST[(ti * 16 + (lane >> 4) * 4 + r) * LK + tv * 16 + (lane & 15)] = f2bf(o[r]);
      }
#pragma unroll
      for (int sk = 0; sk < 4; ++sk) {
        const float gcx = __expf(GCc[sk * 16 + (lane & 15)]);
        f32x4 sn = Sm[sk] * gcx;
        sn = mma16<1>(UT + tv * 16 * LJ, LJ, BTt + sk * 16 * LJ, LJ, sn);
        sn = mma16<1>(VTc + tv * 16 * LJ, LJ, KTt + sk * 16 * LJ, LJ, sn);
        Sm[sk] = sn;
#pragma unroll
        for (int r = 0; r < 4; ++r) S0b[(tv * 16 + (lane >> 4) * 4 + r) * LK + sk * 16 + (lane & 15)] = f2bf(sn[r]);
      }
    }
    if (wave < 4 && more) {
      int rbn, cn; chunk32_of_step(step + 1, b, d, rbn, cn);
#pragma unroll 1
      for (int pass = 0; pass < 2; ++pass) {
#define EW_I ((tid >> 4) + 16 * pass)
#define EW_GC GCn
#define EW_RB rbn
#define EW_C cn
    {
      const int i = EW_I, t = d ? 31 - i : i;
      float rr[4], kk_[4];
      unpack4(*(const uint2*)(RK + i * 128 + c4), rr); unpack4(*(const uint2*)(RK + i * 128 + 64 + c4), kk_);
      const float4 g4 = *(const float4*)&Gf[i * 64 + c4], l4 = *(const float4*)&LWf[i * 64 + c4], ar4 = *(const float4*)&ARf[i * 64 + c4], gc4 = *(const float4*)&EW_GC[c4];
      const float gA[4] = {g4.x, g4.y, g4.z, g4.w}, lA[4] = {l4.x, l4.y, l4.z, l4.w}, arA[4] = {ar4.x, ar4.y, ar4.z, ar4.w}, gcA[4] = {gc4.x, gc4.y, gc4.z, gc4.w};
      const float a0A[4] = {a0v.x, a0v.y, a0v.z, a0v.w}, kkA[4] = {kkv.x, kkv.y, kkv.z, kkv.w}, kaA[4] = {kav.x, kav.y, kav.z, kav.w}, rkA[4] = {rkv.x, rkv.y, rkv.z, rkv.w};
      float a_[4], kraw[4], kd_[4]; float ss = 0.f;
#pragma unroll
      for (int e = 0; e < 4; ++e) { a_[e] = sigm(arA[e] + a0A[e]); kraw[e] = kk_[e] * kkA[e]; ss += kraw[e] * kraw[e]; kd_[e] = kk_[e] * (1.f + (a_[e] - 1.f) * kaA[e]); }
      ss = dpp_sum16(ss);
      const float rn = __builtin_amdgcn_rsqf(ss + EPS);
      float khv[4], rhv[4], bcv[4], kcv[4], btv[4], ktv[4]; float sb = 0.f;
#pragma unroll
      for (int e = 0; e < 4; ++e) {
        const float kn = kraw[e] * rn, bb = kn * a_[e];
        const float eI = __expf(gA[e]), eIm1 = __expf(gA[e] - lA[e]), eInv = __expf(-gA[e]), eC = __expf(gcA[e] - gA[e]);
        khv[e] = kn * eIm1; rhv[e] = rr[e] * eI; bcv[e] = bb * eInv; kcv[e] = kd_[e] * eInv;
        btv[e] = bb * eC; ktv[e] = kd_[e] * eC;
        sb += rr[e] * kd_[e] * rkA[e];
      }
      sb = dpp_sum16(sb);
      *(uint2*)(KH + i * LK + c4) = make_uint2(pack2(khv[0], khv[1]), pack2(khv[2], khv[3]));
      *(uint2*)(RH + i * LK + c4) = make_uint2(pack2(rhv[0], rhv[1]), pack2(rhv[2], rhv[3]));
      *(uint2*)(BC + i * LK + c4) = make_uint2(pack2(bcv[0], bcv[1]), pack2(bcv[2], bcv[3]));
      *(uint2*)(KC + i * LK + c4) = make_uint2(pack2(kcv[0], kcv[1]), pack2(kcv[2], kcv[3]));
      *(uint2*)(BR + i * LK + c4) = make_uint2(pack2(btv[0], btv[1]), pack2(btv[2], btv[3]));
      *(uint2*)(KR + i * LK + c4) = make_uint2(pack2(ktv[0], ktv[1]), pack2(ktv[2], ktv[3]));
      if ((tid & 15) == 0) BONL[t] = sb;
    }
#undef EW_I
#undef EW_GC
#undef EW_RB
#undef EW_C
      }
    }
    __syncthreads();
  }
  if (tid < 256) {
    int rb, c; chunk32_of_step(NCH - 1, b, d, rb, c);
    const int i = tid >> 3, c8 = (tid & 7) * 8, t = d ? 31 - i : i;
    *(uint4*)(p.O + (size_t)(rb + c * 32 + t) * OLD + d * 2048 + 2 * 512 + h * 64 + c8) = *(const uint4*)(OST + i * LK + c8);
  }
#undef RW3_STAGE_LOWRANK
#undef RW3_CUMSUM_TILE
#undef RW3_VT
}

DEVINL void ssm_prefetch(const Params& p, uint4& pf0, uint4& pf1, uint4& pf2, float& dtraw, int step, int b, int d, int h) {
  int rb, len, c; chunk_of_step(step, b, d, rb, len, c);
  const int tid = threadIdx.x, r = tid >> 3, g8 = (tid & 7) * 8, gq = h >> 2;
  const bfr* base = p.P + (size_t)(rb + c * 64 + r) * NINP + C_SSM + 512 + g8;
  pf0 = *(const uint4*)(base + h * 64); pf1 = *(const uint4*)(base + 512 + gq * 64); pf2 = *(const uint4*)(base + 640 + gq * 64);
  if (tid < 64) { const int t = c * 64 + (d ? 63 - tid : tid); dtraw = bf2f(p.P[(size_t)(rb + t) * NINP + C_SSM + 1280 + d * 8 + h]); }
}
template <int L>
DEVINL void scan_ssm2(const Params& p, int item, char* sm) {
  const int d = item & 1, h = (item >> 1) & 7, b = item >> 4;
  const int tid = threadIdx.x, lane = tid & 63, wave = tid >> 6;
  constexpr int LB = 72;
  bfr* Qm = (bfr*)sm; bfr* Qg = Qm + 64 * LB; bfr* Km = Qg + 64 * LB; bfr* K2T = Km + 64 * LB; bfr* VT = K2T + 64 * LB; bfr* SCm = VT + 64 * LB; bfr* ST = SCm + 64 * LB; bfr* OST = ST + 64 * LB;
  float* gsv = (float*)(OST + 64 * LB); float* dtv = gsv + 64;
  for (int i = tid; i < 64 * LB; i += NTHR) ST[i] = 0;
  const float dtb = p.ssm_dt_bias[L * 16 + d * 8 + h], Aneg = -__expf(p.ssm_a_log[L * 16 + d * 8 + h]);
  f32x4 Sm[2] = {f32x4{0.f, 0.f, 0.f, 0.f}, f32x4{0.f, 0.f, 0.f, 0.f}};
  uint4 pf0, pf1, pf2; float dtraw = 0.f;
  ssm_prefetch(p, pf0, pf1, pf2, dtraw, 0, b, d, h);
#pragma unroll 1
  for (int step = 0; step < 68; ++step) {
    int rb, len, c; chunk_of_step(step, b, d, rb, len, c);
    __syncthreads();
    if (tid < 64) {
      const float dt = softplus(dtraw + dtb);
      float la = dt * Aneg;
#pragma unroll
      for (int o = 1; o < 64; o <<= 1) { const float n = __shfl_up(la, o); if (tid >= o) la += n; }
      gsv[tid] = la; dtv[tid] = dt;
    }
    __syncthreads();
    const float g63 = gsv[63];
    {
      const int r = tid >> 3, g = tid & 7, i = d ? 63 - r : r;
      float y[8];
      unpack8(pf0, y);
#pragma unroll
      for (int e = 0; e < 8; ++e) VT[(g * 8 + e) * LB + i] = f2bf(y[e]);
      unpack8(pf1, y);
      const float dt = dtv[i], e2 = __expf(g63 - gsv[i]);
#pragma unroll
      for (int e = 0; e < 8; ++e) y[e] *= dt;
      *(uint4*)(Km + i * LB + g * 8) = make_uint4(pack2(y[0], y[1]), pack2(y[2], y[3]), pack2(y[4], y[5]), pack2(y[6], y[7]));
#pragma unroll
      for (int e = 0; e < 8; ++e) K2T[(g * 8 + e) * LB + i] = f2bf(y[e] * e2);
      unpack8(pf2, y);
      const float eg = __expf(gsv[i]);
      *(uint4*)(Qm + i * LB + g * 8) = pf2;
      *(uint4*)(Qg + i * LB + g * 8) = make_uint4(pack2(y[0] * eg, y[1] * eg), pack2(y[2] * eg, y[3] * eg), pack2(y[4] * eg, y[5] * eg), pack2(y[6] * eg, y[7] * eg));
    }
    __syncthreads();
    if (step + 1 < 68) ssm_prefetch(p, pf0, pf1, pf2, dtraw, step + 1, b, d, h);
#pragma unroll
    for (int u = 0; u < 2; ++u) {
      const int id = 2 * wave + u, ti = id >> 2, tj = id & 3;
      f32x4 a = f32x4{0.f, 0.f, 0.f, 0.f};
      if (tj <= ti) a = mma16<2>(Qm + ti * 16 * LB, LB, Km + tj * 16 * LB, LB, a);
#pragma unroll
      for (int r = 0; r < 4; ++r) {
        const int i = ti * 16 + (lane >> 4) * 4 + r, j = tj * 16 + (lane & 15);
        SCm[i * LB + j] = (j <= i) ? f2bf(a[r] * __expf(gsv[i] - gsv[j])) : (bfr)0;
      }
    }
    __syncthreads();
    const float sd = __expf(g63);
#pragma unroll
    for (int u = 0; u < 2; ++u) {
      const int id = 2 * wave + u, ti = id >> 2, tp = id & 3;
      f32x4 o = mma16<2>(SCm + ti * 16 * LB, LB, VT + tp * 16 * LB, LB, f32x4{0.f, 0.f, 0.f, 0.f});
      o = mma16<2>(Qg + ti * 16 * LB, LB, ST + tp * 16 * LB, LB, o);
#pragma unroll
      for (int r = 0; r < 4; ++r) OST[(ti * 16 + (lane >> 4) * 4 + r) * LB + tp * 16 + (lane & 15)] = f2bf(o[r]);
      Sm[u] = mma16<2>(K2T + ti * 16 * LB, LB, VT + tp * 16 * LB, LB, Sm[u] * sd);
    }
    __syncthreads();
#pragma unroll
    for (int u = 0; u < 2; ++u) {
      const int id = 2 * wave + u, tn = id >> 2, tp = id & 3;
      *(uint2*)(ST + (tp * 16 + (lane & 15)) * LB + tn * 16 + (lane >> 4) * 4) = make_uint2(pack2(Sm[u][0], Sm[u][1]), pack2(Sm[u][2], Sm[u][3]));
    }
    {
      const int i = tid >> 3, c8 = (tid & 7) * 8, t = d ? 63 - i : i;
      *(uint4*)(p.O + (size_t)(rb + c * 64 + t) * OLD + d * 2048 + 0 * 512 + h * 64 + c8) = *(const uint4*)(OST + i * LB + c8);
    }
  }
}

DEVINL void gla_prefetch(const Params& p, uint4 (&pf)[5], int step, int b, int d, int h) {
  int rb, len, c; chunk_of_step(step, b, d, rb, len, c);
#pragma unroll
  for (int q = 0; q < 5; ++q) {
    const int idx = threadIdx.x + NTHR * q;
    uint4 v = make_uint4(0, 0, 0, 0);
    if (idx < 64 * 34) {
      const int r = idx / 34, qq = idx % 34;
      const int col = qq < 8 ? h * 64 + qq * 8 : (qq < 16 ? 256 + h * 64 + (qq - 8) * 8 : (qq < 32 ? 512 + h * 128 + (qq - 16) * 8 : 1536 + d * 16 + (qq - 32) * 8));
      v = *(const uint4*)(p.P + (size_t)(rb + c * 64 + r) * NINP + C_GLA + col);
    }
    pf[q] = v;
  }
}
template <int L>
DEVINL void scan_gla2(const Params& p, int item, char* sm) {
  const int d = item & 1, h = (item >> 1) & 3, b = item >> 3;
  const int tid = threadIdx.x, lane = tid & 63, wave = tid >> 6;
  constexpr int LB = 72, LO = 136, LR = 272;
  bfr* Qg = (bfr*)sm; bfr* Kn = Qg + 64 * LB; bfr* K2T = Kn + 64 * LB; bfr* SCm = K2T + 64 * LB; bfr* VT = SCm + 64 * LB; bfr* ST = VT + 128 * LB; bfr* OST = ST + 128 * LB;
  bfr* RAWG = OST + 64 * LO;
  float* SEG = (float*)(RAWG + 64 * LR);
  float* sdec = SEG + 512;
  for (int i = tid; i < 128 * LB; i += NTHR) ST[i] = 0;
  float w2r[16];
  const int kch = tid & 63;
#pragma unroll
  for (int r = 0; r < 16; ++r) w2r[r] = p.gla_w2[((size_t)(L * 2 + d) * 16 + r) * 256 + h * 64 + kch];
  const float bk = p.gla_b[(L * 2 + d) * 256 + h * 64 + kch];
  f32x4 Sm[4];
#pragma unroll
  for (int u = 0; u < 4; ++u) Sm[u] = f32x4{0.f, 0.f, 0.f, 0.f};
  uint4 pf[5];
  gla_prefetch(p, pf, 0, b, d, h);
#pragma unroll 1
  for (int step = 0; step < 68; ++step) {
    int rb, len, c; chunk_of_step(step, b, d, rb, len, c);
    __syncthreads();
#pragma unroll
    for (int q = 0; q < 5; ++q) { const int idx = tid + NTHR * q; if (idx < 64 * 34) *(uint4*)(RAWG + (idx / 34) * LR + (idx % 34) * 8) = pf[q]; }
    __syncthreads();
    if (step + 1 < 68) gla_prefetch(p, pf, step + 1, b, d, h);
    float gl[8];
    {
      float run = 0.f;
#pragma unroll
      for (int q = 0; q < 8; ++q) {
        const int i = 8 * wave + q, t = d ? 63 - i : i;
        float gr[8]; float lg = bk;
        unpack8(*(const uint4*)(RAWG + t * LR + 256), gr);
#pragma unroll
        for (int r = 0; r < 8; ++r) lg += gr[r] * w2r[r];
        unpack8(*(const uint4*)(RAWG + t * LR + 264), gr);
#pragma unroll
        for (int r = 0; r < 8; ++r) lg += gr[r] * w2r[8 + r];
        run += -softplus(-lg) * (1.f / 16.f);
        gl[q] = run;
      }
      SEG[wave * 64 + kch] = run;
    }
    __syncthreads();
    {
      float pre = 0.f, tot = 0.f;
#pragma unroll
      for (int w = 0; w < 8; ++w) { const float sv = SEG[w * 64 + kch]; tot += sv; if (w < wave) pre += sv; }
      float k2v[8];
#pragma unroll
      for (int q = 0; q < 8; ++q) {
        const int i = 8 * wave + q, t = d ? 63 - i : i;
        const float gg = gl[q] + pre;
        const float qv = bf2f(RAWG[t * LR + kch]), kv = bf2f(RAWG[t * LR + 64 + kch]);
        Qg[i * LB + kch] = f2bf(qv * 0.125f * __expf(gg)); Kn[i * LB + kch] = f2bf(kv * __expf(-gg)); k2v[q] = kv * __expf(tot - gg);
      }
      *(uint4*)(K2T + kch * LB + 8 * wave) = make_uint4(pack2(k2v[0], k2v[1]), pack2(k2v[2], k2v[3]), pack2(k2v[4], k2v[5]), pack2(k2v[6], k2v[7]));
      if (wave == 0) sdec[kch] = __expf(tot);
      const int pp = tid & 127, i0 = (tid >> 7) * 16;
      float vv[16];
#pragma unroll
      for (int q = 0; q < 16; ++q) { const int i = i0 + q, t = d ? 63 - i : i; vv[q] = bf2f(RAWG[t * LR + 128 + pp]); }
      *(uint4*)(VT + pp * LB + i0) = make_uint4(pack2(vv[0], vv[1]), pack2(vv[2], vv[3]), pack2(vv[4], vv[5]), pack2(vv[6], vv[7]));
      *(uint4*)(VT + pp * LB + i0 + 8) = make_uint4(pack2(vv[8], vv[9]), pack2(vv[10], vv[11]), pack2(vv[12], vv[13]), pack2(vv[14], vv[15]));
    }
    __syncthreads();
#pragma unroll
    for (int u = 0; u < 2; ++u) {
      const int id = 2 * wave + u, ti = id >> 2, tj = id & 3;
      f32x4 a = f32x4{0.f, 0.f, 0.f, 0.f};
      if (tj <= ti) a = mma16<2>(Qg + ti * 16 * LB, LB, Kn + tj * 16 * LB, LB, a);
#pragma unroll
      for (int r = 0; r < 4; ++r) {
        const int i = ti * 16 + (lane >> 4) * 4 + r, j = tj * 16 + (lane & 15);
        SCm[i * LB + j] = (j <= i) ? f2bf(a[r]) : (bfr)0;
      }
    }
    __syncthreads();
#pragma unroll
    for (int u = 0; u < 4; ++u) {
      const int id = 4 * wave + u, ti = id >> 3, tp = id & 7;
      f32x4 o = mma16<2>(SCm + ti * 16 * LB, LB, VT + tp * 16 * LB, LB, f32x4{0.f, 0.f, 0.f, 0.f});
      o = mma16<2>(Qg + ti * 16 * LB, LB, ST + tp * 16 * LB, LB, o);
#pragma unroll
      for (int r = 0; r < 4; ++r) OST[(ti * 16 + (lane >> 4) * 4 + r) * LO + tp * 16 + (lane & 15)] = f2bf(o[r]);
      f32x4 sdv;
#pragma unroll
      for (int r = 0; r < 4; ++r) sdv[r] = sdec[ti * 16 + (lane >> 4) * 4 + r];
      Sm[u] = mma16<2>(K2T + ti * 16 * LB, LB, VT + tp * 16 * LB, LB, Sm[u] * sdv);
    }
    __syncthreads();
#pragma unroll
    for (int u = 0; u < 4; ++u) {
      const int id = 4 * wave + u, tk = id >> 3, tp = id & 7;
      *(uint2*)(ST + (tp * 16 + (lane & 15)) * LB + tk * 16 + (lane >> 4) * 4) = make_uint2(pack2(Sm[u][0], Sm[u][1]), pack2(Sm[u][2], Sm[u][3]));
    }
    {
      const int i = tid >> 3, t = d ? 63 - i : i;
#pragma unroll
      for (int q = 0; q < 2; ++q) {
        const int c8 = (tid & 7) * 8 + q * 64;
        *(uint4*)(p.O + (size_t)(rb + c * 64 + t) * OLD + d * 2048 + 1 * 512 + h * 128 + c8) = *(const uint4*)(OST + i * LO + c8);
      }
    }
  }
}


DEVINL void gdn_prefetch(const Params& p, uint4& pf0, uint4& pf1, uint4& pf2, uint4& pf3, uint4& pf4, bfr& araw, bfr& braw, int step, int b, int d, int h, int vh) {
  int rb, len, c; chunk_of_step(step, b, d, rb, len, c);
  const int tid = threadIdx.x;
  const bfr* base = p.P + (size_t)(rb + c * 64) * NINP + C_GDN;
  { const int r = tid >> 4, g = tid & 15;
    pf0 = *(const uint4*)(base + (size_t)r * NINP + h * 128 + g * 8); pf1 = *(const uint4*)(base + (size_t)(r + 32) * NINP + h * 128 + g * 8);
    pf2 = *(const uint4*)(base + (size_t)r * NINP + 512 + h * 128 + g * 8); pf3 = *(const uint4*)(base + (size_t)(r + 32) * NINP + 512 + h * 128 + g * 8); }
  { const int r = tid >> 3, g = tid & 7; pf4 = *(const uint4*)(base + (size_t)r * NINP + 1024 + h * 128 + vh * 64 + g * 8); }
  if (tid >= 64 && tid < 128) {
    const int tl = tid - 64, t = c * 64 + (d ? 63 - tl : tl);
    const bfr* pr = p.P + (size_t)(rb + t) * NINP + C_GDN;
    araw = pr[2048 + d * 4 + h]; braw = pr[2056 + d * 4 + h];
  }
}
template <int L>
DEVINL void scan_gdn2(const Params& p, int item, char* sm) {
  const int vh = item & 1, d = (item >> 1) & 1, h = (item >> 2) & 3, b = item >> 4;
  const int tid = threadIdx.x, lane = tid & 63, wave = __builtin_amdgcn_readfirstlane(tid >> 6);
  constexpr int LQ = 136, LB = 72, LF = 68;
  bfr* QN = (bfr*)sm; bfr* KN = QN + 64 * LQ; bfr* U0 = KN + 64 * LQ; bfr* KdT = U0 + 64 * LB; bfr* Tm = KdT + 128 * LB; bfr* ATm = Tm + 64 * LB; bfr* ST = ATm + 64 * LB;
  float* SMALL = (float*)(ST + 64 * LQ);
  float* TMPX = SMALL + 512;
  bfr* ZT = (bfr*)(TMPX + 6 * 256);
  char* REG = (char*)(ZT + 64 * LB);
  float* Lf = (float*)REG; float* Tf = Lf + 64 * LF;
  bfr* VnT = (bfr*)REG; bfr* OST = VnT + 64 * LB;
  for (int i = tid; i < 64 * LQ; i += NTHR) ST[i] = 0;
  const float Aneg = -__expf(p.gdn_a_log[L * 8 + d * 4 + h]), dtb = p.gdn_dt_bias[L * 8 + d * 4 + h];
  f32x4 Sm[4];
#pragma unroll
  for (int u = 0; u < 4; ++u) Sm[u] = f32x4{0.f, 0.f, 0.f, 0.f};
  uint4 pf0, pf1, pf2, pf3, pf4; bfr araw = 0, braw = 0;
  gdn_prefetch(p, pf0, pf1, pf2, pf3, pf4, araw, braw, 0, b, d, h, vh);
#define GDN_GBETA(DST) do { \
    float g_ = Aneg * softplus(bf2f(araw) + dtb); const float beta_ = sigm(bf2f(braw)); \
    _Pragma("unroll") for (int o_ = 1; o_ < 64; o_ <<= 1) { const float n_ = __shfl_up(g_, o_); if (lane >= o_) g_ += n_; } \
    const float g63_ = __shfl(g_, 63); \
    (DST)[lane] = g_; (DST)[64 + lane] = beta_; (DST)[128 + lane] = __expf(g63_ - g_); (DST)[192 + lane] = __expf(g_); } while (0)
  if (wave == 1) GDN_GBETA(SMALL);
  __syncthreads();
#pragma unroll 1
  for (int step = 0; step < 68; ++step) {
    int rb, len, c; chunk_of_step(step, b, d, rb, len, c);
    float* Gs = SMALL + (step & 1) * 256; float* Bts = Gs + 64; float* EK = Bts + 64; float* EG = EK + 64;
    float* SMn = SMALL + ((step + 1) & 1) * 256;
    __builtin_amdgcn_s_waitcnt(0x0F70);
    {
      const int r = tid >> 4, g = tid & 15, i0 = d ? 63 - r : r, i1 = d ? 31 - r : r + 32;
      *(uint4*)(QN + i0 * LQ + g * 8) = pf0; *(uint4*)(QN + i1 * LQ + g * 8) = pf1;
      *(uint4*)(KN + i0 * LQ + g * 8) = pf2; *(uint4*)(KN + i1 * LQ + g * 8) = pf3;
    }
    {
      const int r = tid >> 3, g = tid & 7, i = d ? 63 - r : r;
      float y[8]; unpack8(pf4, y);
      const float bt = Bts[i];
      *(uint4*)(U0 + i * LB + g * 8) = make_uint4(pack2(y[0] * bt, y[1] * bt), pack2(y[2] * bt, y[3] * bt), pack2(y[4] * bt, y[5] * bt), pack2(y[6] * bt, y[7] * bt));
    }
    if (step > 0) {
      int rbp, lenp, cp; chunk_of_step(step - 1, b, d, rbp, lenp, cp);
      const int i = tid >> 3, c8 = (tid & 7) * 8, t = d ? 63 - i : i;
      *(uint4*)(p.O + (size_t)(rbp + cp * 64 + t) * OLD + d * 2048 + 3 * 512 + h * 128 + vh * 64 + c8) = *(const uint4*)(OST + i * LB + c8);
    }
    if (step + 1 < 68) gdn_prefetch(p, pf0, pf1, pf2, pf3, pf4, araw, braw, step + 1, b, d, h, vh);
    __syncthreads();
    {
      const int k = tid & 127, jq = (tid >> 7) * 16;
      float v[16];
#pragma unroll
      for (int q = 0; q < 16; ++q) v[q] = bf2f(KN[(jq + q) * LQ + k]) * EK[jq + q];
      *(uint4*)(KdT + k * LB + jq) = make_uint4(pack2(v[0], v[1]), pack2(v[2], v[3]), pack2(v[4], v[5]), pack2(v[6], v[7]));
      *(uint4*)(KdT + k * LB + jq + 8) = make_uint4(pack2(v[8], v[9]), pack2(v[10], v[11]), pack2(v[12], v[13]), pack2(v[14], v[15]));
    }
#pragma unroll 1
    for (int u = 0; u < 4; ++u) {
      const int id = 4 * wave + u;
      if (id < 16) {
        const int ti = id >> 2, tj = id & 3;
        if (tj <= ti) {
          const f32x4 a = mma16<4>(KN + ti * 16 * LQ, LQ, KN + tj * 16 * LQ, LQ, f32x4{0.f, 0.f, 0.f, 0.f});
#pragma unroll
          for (int r = 0; r < 4; ++r) {
            const int i = ti * 16 + (lane >> 4) * 4 + r, j = tj * 16 + (lane & 15);
            Lf[i * LF + j] = (j < i) ? a[r] * __expf(Gs[i] - Gs[j]) * Bts[i] : 0.f;
          }
        }
      } else {
        const int ti = (id - 16) >> 2, tj = (id - 16) & 3;
        f32x4 a = f32x4{0.f, 0.f, 0.f, 0.f};
        if (tj <= ti) a = mma16<4>(KN + tj * 16 * LQ, LQ, QN + ti * 16 * LQ, LQ, a);
        const int i = ti * 16 + (lane & 15), j0 = tj * 16 + (lane >> 4) * 4;
        float v4[4];
#pragma unroll
        for (int r = 0; r < 4; ++r) { const int j = j0 + r; v4[r] = (j <= i) ? a[r] * __expf(Gs[i] - Gs[j]) : 0.f; }
        *(uint2*)(ATm + i * LB + j0) = make_uint2(pack2(v4[0], v4[1]), pack2(v4[2], v4[3]));
      }
    }
    __syncthreads();
    f32x4 o1[4];
    if (wave == 1) { if (step + 1 < 68) GDN_GBETA(SMn); }
    else if (wave >= 4) {
#pragma unroll
      for (int u = 0; u < 4; ++u) {
        const int id = 4 * (wave - 4) + u, ti = id >> 2, tv = id & 3;
        const f32x4 y = mma16<4>(KN + ti * 16 * LQ, LQ, ST + tv * 16 * LQ, LQ, f32x4{0.f, 0.f, 0.f, 0.f});
        f32x4 q1 = mma16<4>(QN + ti * 16 * LQ, LQ, ST + tv * 16 * LQ, LQ, f32x4{0.f, 0.f, 0.f, 0.f});
        const int i0 = ti * 16 + (lane >> 4) * 4, v = tv * 16 + (lane & 15);
        float z[4];
#pragma unroll
        for (int r = 0; r < 4; ++r) { const int i = i0 + r; const float eg = EG[i]; z[r] = bf2f(U0[i * LB + v]) - Bts[i] * eg * y[r]; q1[r] *= eg; }
        o1[u] = q1;
        *(uint2*)(ZT + v * LB + i0) = make_uint2(pack2(z[0], z[1]), pack2(z[2], z[3]));
        asm volatile("" ::: "memory");
      }
    }
    if (wave == 0) {
      const int blk = lane >> 4, cc = lane & 15;
      float x[16];
#pragma unroll
      for (int i = 0; i < 16; ++i) x[i] = (i == cc) ? 1.f : 0.f;
#pragma unroll
      for (int i = 1; i < 16; ++i) {
        const float* lr = Lf + (16 * blk + i) * LF + 16 * blk;
#pragma unroll
        for (int j4 = 0; j4 < (i + 3) / 4; ++j4) {
          const float4 l4 = *(const float4*)(lr + 4 * j4);
          const float la[4] = {l4.x, l4.y, l4.z, l4.w};
#pragma unroll
          for (int e = 0; e < 4; ++e) if (4 * j4 + e < i) x[i] -= la[e] * x[4 * j4 + e];
        }
        asm volatile("" ::: "memory");
      }
#pragma unroll
      for (int i = 0; i < 16; ++i) Tf[(16 * blk + i) * LF + 16 * blk + cc] = x[i];
    }
    __syncthreads();
    if (wave < 3) {
      const int bi = wave + 1, bj = wave;
      f32x4 xa = bmm16(Lf + 16 * bi * LF + 16 * bj, LF, Tf + 16 * bj * LF + 16 * bj, LF, f32x4{0.f, 0.f, 0.f, 0.f});
      float* X = TMPX + wave * 256;
#pragma unroll
      for (int r = 0; r < 4; ++r) X[((lane >> 4) * 4 + r) * 16 + (lane & 15)] = xa[r];
      asm volatile("s_waitcnt lgkmcnt(0)" ::: "memory");
      const f32x4 ta = bmm16(Tf + 16 * bi * LF + 16 * bi, LF, X, 16, f32x4{0.f, 0.f, 0.f, 0.f});
#pragma unroll
      for (int r = 0; r < 4; ++r) Tf[(16 * bi + (lane >> 4) * 4 + r) * LF + 16 * bj + (lane & 15)] = -ta[r];
    }
    __syncthreads();
    if (wave < 2) {
      const int bi = wave + 2, bj = wave;
      f32x4 xa = bmm16(Lf + 16 * bi * LF + 16 * bj, LF, Tf + 16 * bj * LF + 16 * bj, LF, f32x4{0.f, 0.f, 0.f, 0.f});
      xa = bmm16(Lf + 16 * bi * LF + 16 * (bj + 1), LF, Tf + 16 * (bj + 1) * LF + 16 * bj, LF, xa);
      float* X = TMPX + (3 + wave) * 256;
#pragma unroll
      for (int r = 0; r < 4; ++r) X[((lane >> 4) * 4 + r) * 16 + (lane & 15)] = xa[r];
      asm volatile("s_waitcnt lgkmcnt(0)" ::: "memory");
      const f32x4 ta = bmm16(Tf + 16 * bi * LF + 16 * bi, LF, X, 16, f32x4{0.f, 0.f, 0.f, 0.f});
#pragma unroll
      for (int r = 0; r < 4; ++r) Tf[(16 * bi + (lane >> 4) * 4 + r) * LF + 16 * bj + (lane & 15)] = -ta[r];
    }
    __syncthreads();
    if (wave == 0) {
      f32x4 xa = bmm16(Lf + 48 * LF, LF, Tf, LF, f32x4{0.f, 0.f, 0.f, 0.f});
      xa = bmm16(Lf + 48 * LF + 16, LF, Tf + 16 * LF, LF, xa);
      xa = bmm16(Lf + 48 * LF + 32, LF, Tf + 32 * LF, LF, xa);
      float* X = TMPX + 5 * 256;
#pragma unroll
      for (int r = 0; r < 4; ++r) X[((lane >> 4) * 4 + r) * 16 + (lane & 15)] = xa[r];
      asm volatile("s_waitcnt lgkmcnt(0)" ::: "memory");
      const f32x4 ta = bmm16(Tf + 48 * LF + 48, LF, X, 16, f32x4{0.f, 0.f, 0.f, 0.f});
#pragma unroll
      for (int r = 0; r < 4; ++r) Tf[(48 + (lane >> 4) * 4 + r) * LF + (lane & 15)] = -ta[r];
    }
    __syncthreads();
    for (int idx = tid; idx < 64 * 16; idx += NTHR) {
      const int i = idx >> 4, j4 = (idx & 15) * 4;
      float tv[4];
#pragma unroll
      for (int e = 0; e < 4; ++e) tv[e] = ((j4 >> 4) <= (i >> 4)) ? Tf[i * LF + j4 + e] : 0.f;
      *(uint2*)(Tm + i * LB + j4) = make_uint2(pack2(tv[0], tv[1]), pack2(tv[2], tv[3]));
    }
    __syncthreads();
#pragma unroll
    for (int u = 0; u < 2; ++u) {
      const int id = 2 * wave + u, ti = id >> 2, tv = id & 3;
      const f32x4 vn = mma16<2>(Tm + ti * 16 * LB, LB, ZT + tv * 16 * LB, LB, f32x4{0.f, 0.f, 0.f, 0.f});
      *(uint2*)(VnT + (tv * 16 + (lane & 15)) * LB + ti * 16 + (lane >> 4) * 4) = make_uint2(pack2(vn[0], vn[1]), pack2(vn[2], vn[3]));
    }
    __syncthreads();
    {
      const float gl = __expf(Gs[63]);
      if (wave >= 4) {
#pragma unroll
        for (int u = 0; u < 4; ++u) {
          const int id = 4 * (wave - 4) + u, ti = id >> 2, tv = id & 3;
          const f32x4 o = mma16<2>(ATm + ti * 16 * LB, LB, VnT + tv * 16 * LB, LB, o1[u]);
#pragma unroll
          for (int r = 0; r < 4; ++r) OST[(ti * 16 + (lane >> 4) * 4 + r) * LB + tv * 16 + (lane & 15)] = f2bf(o[r]);
        }
      }
#pragma unroll
      for (int u = 0; u < 4; ++u) {
        const int id = 4 * wave + u, tk = id >> 2, tv = id & 3;
        Sm[u] = mma16<2>(KdT + tk * 16 * LB, LB, VnT + tv * 16 * LB, LB, Sm[u] * gl);
        *(uint2*)(ST + (tv * 16 + (lane & 15)) * LQ + tk * 16 + (lane >> 4) * 4) = make_uint2(pack2(Sm[u][0], Sm[u][1]), pack2(Sm[u][2], Sm[u][3]));
        asm volatile("" ::: "memory");
      }
    }
    __syncthreads();
  }
  {
    int rb, len, c; chunk_of_step(67, b, d, rb, len, c);
    const int i = tid >> 3, c8 = (tid & 7) * 8, t = d ? 63 - i : i;
    *(uint4*)(p.O + (size_t)(rb + c * 64 + t) * OLD + d * 2048 + 3 * 512 + h * 128 + vh * 64 + c8) = *(const uint4*)(OST + i * LB + c8);
  }
#undef GDN_GBETA
}

template <int L> DEVINL void phase_gproj(const Params& p, char* sm, int c);
template <int L>
DEVINL void phase_scans(const Params& p, char* sm) {
  const int it = blockIdx.x;
  if (it < 64) scan_rwkv3<L>(p, it, sm);
  else if (it < 128) scan_gdn2<L>(p, it - 64, sm);
  else if (it < 192) scan_ssm2<L>(p, it - 128, sm);
  else if (it < 224) scan_gla2<L>(p, it - 192, sm);
  else {
    phase_gproj<L>(p, sm, it - 224);
  }
}

template <int L>
DEVINL void phase_post2(const Params& p) {
  const int lane = threadIdx.x & 63, wave = threadIdx.x >> 6;
  const int nrows = (L == 1) ? TL : T;
  const int c8 = lane * 8;
  float pw_ssm[8], pw_gla[8], pw_lnw[8], pw_lnb[8], pw_gdn[8];
#pragma unroll
  for (int e = 0; e < 8; ++e) {
    pw_ssm[e] = p.ssm_norm[L * 512 + c8 + e]; pw_gla[e] = p.gla_norm[L * 128 + ((c8 + e) & 127)]; pw_lnw[e] = p.rwkv_ln_w[L * 512 + c8 + e];
    pw_lnb[e] = p.rwkv_ln_b[L * 512 + c8 + e]; pw_gdn[e] = p.gdn_norm[L * 128 + ((c8 + e) & 127)];
  }
  const float dssm = p.ssm_d[L * 8 + (lane >> 3)];
  for (int R = blockIdx.x * 8 + wave; R < nrows; R += gridDim.x * 8) {
    const bool lat = R < TL; const int vvb = lat ? (R >> 12) : 4;
    bfr* orow = p.O + (size_t)R * OLD; const bfr* prow = p.P + (size_t)R * NINP;
    uint4 of_[4], ob_[4];
#pragma unroll
    for (int m = 0; m < 4; ++m) { of_[m] = *(const uint4*)(orow + m * 512 + c8); ob_[m] = *(const uint4*)(orow + 2048 + m * 512 + c8); }
    const uint4 pxh = *(const uint4*)(prow + C_SSM + 512 + c8), pz = *(const uint4*)(prow + C_SSM + c8), prg = *(const uint4*)(prow + C_GLA + 1024 + c8);
    const uint4 pv = *(const uint4*)(prow + C_RWKV + 1024 + c8), pzg = *(const uint4*)(prow + C_GDN + 1536 + c8), pgg = *(const uint4*)(p.Gb + (size_t)R * 512 + c8);
    const int cr = lat ? canon_row(L, R) : R;
    const float* xp = lat ? p.out + (size_t)cr * D : p.xc + (size_t)(R - TL) * D;
    float4 xv[4];
#pragma unroll
    for (int q = 0; q < 4; ++q) xv[q] = *(const float4*)(xp + q * 256 + lane * 4);
    const float bsum = p.bon[((size_t)0 * T + R) * 8 + (lane >> 3)] + p.bon[((size_t)1 * T + R) * 8 + (lane >> 3)];
    float a[8], b[8], t1[8], t2[8];
    float y0[8]; float ss0 = 0.f;
    unpack8(of_[0], a); unpack8(ob_[0], b); unpack8(pxh, t1); unpack8(pz, t2);
#pragma unroll
    for (int e = 0; e < 8; ++e) { y0[e] = (a[e] + b[e] + dssm * t1[e]) * silu(t2[e]); ss0 += y0[e] * y0[e]; }
    ss0 = dpp_sum16(ss0); ss0 += __shfl_xor(ss0, 16);
    float y1[8]; float ss1 = 0.f;
    unpack8(of_[1], a); unpack8(ob_[1], b); unpack8(prg, t1);
#pragma unroll
    for (int e = 0; e < 8; ++e) { y1[e] = a[e] + b[e]; ss1 += y1[e] * y1[e]; }
    ss1 = dpp_sum16(ss1);
    const float r1 = __builtin_amdgcn_rsqf(ss1 * (1.f / 128.f) + EPS);
#pragma unroll
    for (int e = 0; e < 8; ++e) y1[e] = y1[e] * r1 * pw_gla[e] * silu(t1[e]);
    float y2[8]; float s2 = 0.f;
    unpack8(of_[2], a); unpack8(ob_[2], b); unpack8(pv, t1); unpack8(pgg, t2);
#pragma unroll
    for (int e = 0; e < 8; ++e) { y2[e] = a[e] + b[e]; s2 += y2[e]; }
    const float mu = dpp_sum8(s2) * (1.f / 64.f);
    float v2 = 0.f;
#pragma unroll
    for (int e = 0; e < 8; ++e) { y2[e] -= mu; v2 += y2[e] * y2[e]; }
    const float r2 = __builtin_amdgcn_rsqf(dpp_sum8(v2) * (1.f / 64.f) + 64e-5f);
#pragma unroll
    for (int e = 0; e < 8; ++e) y2[e] = (y2[e] * r2 * pw_lnw[e] + pw_lnb[e] + bsum * t1[e]) * t2[e];
    float y3[8]; float ss3 = 0.f;
    unpack8(of_[3], a); unpack8(ob_[3], b); unpack8(pzg, t1);
#pragma unroll
    for (int e = 0; e < 8; ++e) { y3[e] = a[e] + b[e]; ss3 += y3[e] * y3[e]; }
    ss3 = dpp_sum16(ss3);
    const float r3 = __builtin_amdgcn_rsqf(ss3 * (1.f / 128.f) + EPS);
#pragma unroll
    for (int e = 0; e < 8; ++e) y3[e] = y3[e] * r3 * pw_gdn[e] * silu(t1[e]);
    const float r0 = __builtin_amdgcn_rsqf(ss0 * (1.f / 256.f) + EPS);
#pragma unroll
    for (int e = 0; e < 8; ++e) y0[e] = y0[e] * r0 * pw_ssm[e];
    float xs = 0.f;
#pragma unroll
    for (int q = 0; q < 4; ++q) xs += xv[q].x * xv[q].x + xv[q].y * xv[q].y + xv[q].z * xv[q].z + xv[q].w * xv[q].w;
    xs = wave_sum(xs);
    const float rs = __builtin_amdgcn_rsqf(xs * (1.f / 1024.f) + EPS);
    const float* md = p.mod + ((size_t)L * 5 + vvb) * 6144;
    *(uint4*)(orow + 0 * 512 + c8) = make_uint4(pack2(y0[0], y0[1]), pack2(y0[2], y0[3]), pack2(y0[4], y0[5]), pack2(y0[6], y0[7]));
    *(uint4*)(orow + 1 * 512 + c8) = make_uint4(pack2(y1[0], y1[1]), pack2(y1[2], y1[3]), pack2(y1[4], y1[5]), pack2(y1[6], y1[7]));
    *(uint4*)(orow + 2 * 512 + c8) = make_uint4(pack2(y2[0], y2[1]), pack2(y2[2], y2[3]), pack2(y2[4], y2[5]), pack2(y2[6], y2[7]));
    *(uint4*)(orow + 3 * 512 + c8) = make_uint4(pack2(y3[0], y3[1]), pack2(y3[2], y3[3]), pack2(y3[4], y3[5]), pack2(y3[6], y3[7]));
#pragma unroll
    for (int q = 0; q < 4; ++q) {
      const int j = q * 256 + lane * 4;
      const float4 nw = *(const float4*)(p.norm_mix + L * D + j), sh = *(const float4*)(md + j), scl = *(const float4*)(md + 1024 + j);
      const float h0 = xv[q].x * rs * nw.x * (1.f + scl.x) + sh.x, h1 = xv[q].y * rs * nw.y * (1.f + scl.y) + sh.y;
      const float h2 = xv[q].z * rs * nw.z * (1.f + scl.z) + sh.z, h3 = xv[q].w * rs * nw.w * (1.f + scl.w) + sh.w;
      *(uint2*)(orow + 2048 + j) = make_uint2(pack2(h0, h1), pack2(h2, h3));
    }
  }
}

template <int L>
DEVINL void phase_route(const Params& p, char* sm) {
  const int tid = threadIdx.x, lane = tid & 63, wave = tid >> 6;
  float* rw = (float*)sm;
  __syncthreads();
  for (int i = tid; i < 1024 * 16; i += NTHR) rw[(i & 15) * 1024 + (i >> 4)] = p.router_w[i];
  __syncthreads();
  const int ntok = (L == 1) ? TL : T;
  for (int tk = blockIdx.x * 8 + wave; tk < ntok; tk += gridDim.x * 8) {
    const bool lat = tk < TL;
    const int vv = lat ? (tk >> 12) : 4;
    const float* xp = lat ? p.out + (size_t)tk * D : p.xc + (size_t)(tk - TL) * D;
    float ss = 0.f;
#pragma unroll
    for (int q = 0; q < 4; ++q) {
      const float4 xv = *(const float4*)(xp + q * 256 + lane * 4);
      ss += xv.x * xv.x + xv.y * xv.y + xv.z * xv.z + xv.w * xv.w;
    }
    ss = wave_sum(ss);
    const float rs = rsqrtf(ss * (1.f / 1024.f) + EPS);
    const float* md = p.mod + ((size_t)L * 5 + vv) * 6144;
    float lg[16];
#pragma unroll
    for (int e = 0; e < 16; ++e) lg[e] = 0.f;
#pragma unroll 1
    for (int q = 0; q < 4; ++q) {
      const int j = q * 256 + lane * 4;
      const float4 xv = *(const float4*)(xp + j);
      const float4 nw = *(const float4*)(p.norm_ffn + L * D + j), sh = *(const float4*)(md + 3 * 1024 + j), scl = *(const float4*)(md + 4 * 1024 + j);
      float hv[4];
      hv[0] = xv.x * rs * nw.x * (1.f + scl.x) + sh.x; hv[1] = xv.y * rs * nw.y * (1.f + scl.y) + sh.y;
      hv[2] = xv.z * rs * nw.z * (1.f + scl.z) + sh.z; hv[3] = xv.w * rs * nw.w * (1.f + scl.w) + sh.w;
      uint2 o; o.x = (unsigned)f2bf(hv[0]) | ((unsigned)f2bf(hv[1]) << 16); o.y = (unsigned)f2bf(hv[2]) | ((unsigned)f2bf(hv[3]) << 16);
      *(uint2*)(p.HF + (size_t)tk * D + j) = o;
#pragma unroll
      for (int e = 0; e < 16; ++e) {
        const float4 r4 = *(const float4*)&rw[e * 1024 + j];
        lg[e] += hv[0] * r4.x + hv[1] * r4.y + hv[2] * r4.z + hv[3] * r4.w;
      }
    }
    {
      float sel = 0.f;
#pragma unroll
      for (int e = 0; e < 16; ++e) { const float rsum = dpp_sum16(lg[e]); sel = ((lane & 15) == e) ? rsum : sel; }
      sel += __shfl_xor(sel, 16); sel += __shfl_xor(sel, 32);
#pragma unroll
      for (int e = 0; e < 16; ++e) lg[e] = __int_as_float(__builtin_amdgcn_readlane(__float_as_int(sel), e));
    }
    if (lane == 0) {
      float sc[16], sel[16];
#pragma unroll
      for (int e = 0; e < 16; ++e) { sc[e] = sigm(lg[e]); sel[e] = sc[e] + p.router_b[e]; }
      int bg = 0; float bgs = -1e30f;
#pragma unroll
      for (int g = 0; g < 4; ++g) {
        float m1 = -1e30f, m2 = -1e30f;
#pragma unroll
        for (int u = 0; u < 4; ++u) { const float s = sel[g * 4 + u]; if (s > m1) { m2 = m1; m1 = s; } else if (s > m2) m2 = s; }
        const float gs = m1 + m2;
        if (gs > bgs) { bgs = gs; bg = g; }
      }
      int i1 = 0, i2 = 0; float m1 = -1e30f, m2 = -1e30f;
#pragma unroll
      for (int u = 0; u < 4; ++u) {
        float s = 0.f, c2 = 0.f;
#pragma unroll
        for (int g = 0; g < 4; ++g) if (g == bg) { s = sel[g * 4 + u]; }
        (void)c2;
        if (s > m1) { m2 = m1; i2 = i1; m1 = s; i1 = u; } else if (s > m2) { m2 = s; i2 = u; }
      }
      const int e1 = bg * 4 + i1, e2 = bg * 4 + i2;
      float s1 = 0.f, s2 = 0.f;
#pragma unroll
      for (int e = 0; e < 16; ++e) { if (e == e1) s1 = sc[e]; if (e == e2) s2 = sc[e]; }
      const float inv = 1.f / (s1 + s2);
      const int p1 = atomicAdd(&p.cnt[L * 16 + e1], 1), p2 = atomicAdd(&p.cnt[L * 16 + e2], 1);
      p.list[(size_t)e1 * T + p1] = tk * 2; p.list[(size_t)e2 * T + p2] = tk * 2 + 1;
      p.gatew[tk * 2] = s1 * inv; p.gatew[tk * 2 + 1] = s2 * inv;
    }
  }
}

namespace g8 {
DEVINL uint4 pack8(const f32x4& a, const f32x4& b) { return make_uint4(pack2(a[0], a[1]), pack2(a[2], a[3]), pack2(b[0], b[1]), pack2(b[2], b[3])); }
struct EpiP {
  static constexpr bool PERM = true;
  bfr* C; int ldc; int act;
  DEVINL void operator()(const Acc& acc, const Unit& u, int wr, int wc, int fr, int fq) const {
    const int row0 = u.pm * 256 + wr * 64 + fr, col0 = u.pn * 256 + wc * 32 + 8 * fq;
#pragma unroll
    for (int ai = 0; ai < 2; ++ai)
#pragma unroll
      for (int m = 0; m < 4; ++m) {
        bfr* rowp = C + (size_t)(row0 + ai * 128 + m * 16) * ldc + col0;
#pragma unroll
        for (int bj = 0; bj < 2; ++bj) {
          f32x4 v0 = acc[ai][bj][m][0], v1 = acc[ai][bj][m][1];
          if (act) {
#pragma unroll
            for (int j = 0; j < 4; ++j) { v0[j] = sigm(v0[j]); v1[j] = sigm(v1[j]); }
          }
          *(uint4*)(rowp + bj * 128) = pack8(v0, v1);
        }
      }
  }
};
struct EpiBranch {
  static constexpr bool PERM = true;
  bfr* ACC; const bfr* GATES;
  DEVINL void operator()(const Acc& acc, const Unit& u, int wr, int wc, int fr, int fq) const {
    const int row0 = u.pm * 256 + wr * 64 + fr, col0 = u.pn * 256 + wc * 32 + 8 * fq;
#pragma unroll
    for (int ai = 0; ai < 2; ++ai) {
      uint4 gq[4][2], pq[4][2];
#pragma unroll
      for (int m = 0; m < 4; ++m)
#pragma unroll
        for (int bj = 0; bj < 2; ++bj) {
          const size_t row = (size_t)(row0 + ai * 128 + m * 16); const int col = col0 + bj * 128;
          gq[m][bj] = *(const uint4*)(GATES + row * 4096 + u.e * 1024 + col);
          pq[m][bj] = u.e ? *(const uint4*)(ACC + row * 1024 + col) : make_uint4(0, 0, 0, 0);
        }
#pragma unroll
      for (int m = 0; m < 4; ++m)
#pragma unroll
        for (int bj = 0; bj < 2; ++bj) {
          const size_t row = (size_t)(row0 + ai * 128 + m * 16); const int col = col0 + bj * 128;
          float gt[8], pv[8];
          unpack8(gq[m][bj], gt); unpack8(pq[m][bj], pv);
          f32x4 v0, v1;
#pragma unroll
          for (int j = 0; j < 4; ++j) { v0[j] = pv[j] + gt[j] * acc[ai][bj][m][0][j]; v1[j] = pv[4 + j] + gt[4 + j] * acc[ai][bj][m][1][j]; }
          *(uint4*)(ACC + row * 1024 + col) = pack8(v0, v1);
        }
    }
  }
};
struct EpiOut {
  static constexpr bool PERM = false;
  float* xlat; float* xctx; const float* mod; int layer;
  DEVINL void operator()(const Acc& acc, const Unit& u, int wr, int wc, int fr, int fq) const {
    const int row0 = u.pm * 256 + wr * 64 + fr, col0 = u.pn * 256 + wc * 32 + 4 * fq;
#pragma unroll
    for (int ai = 0; ai < 2; ++ai) {
      float4 xq[4][2][2];
      float* xpp[4];
      const float* m2p = nullptr;
#pragma unroll
      for (int m = 0; m < 4; ++m) {
        const int R = row0 + ai * 128 + m * 16;
        const bool lat = R < TL;
        xpp[m] = lat ? xlat + (size_t)canon_row(layer, R) * D : xctx + (size_t)(R - TL) * D;
        if (m == 0) m2p = mod + ((size_t)layer * 5 + (lat ? (R >> 12) : 4)) * 6144 + 2 * 1024;
#pragma unroll
        for (int bj = 0; bj < 2; ++bj)
#pragma unroll
          for (int n = 0; n < 2; ++n) xq[m][bj][n] = *(const float4*)(xpp[m] + col0 + bj * 128 + n * 16);
      }
      float4 mq[2][2];
#pragma unroll
      for (int bj = 0; bj < 2; ++bj)
#pragma unroll
        for (int n = 0; n < 2; ++n) mq[bj][n] = *(const float4*)(m2p + col0 + bj * 128 + n * 16);
#pragma unroll
      for (int m = 0; m < 4; ++m)
#pragma unroll
        for (int bj = 0; bj < 2; ++bj)
#pragma unroll
          for (int n = 0; n < 2; ++n) {
            float4 xv = xq[m][bj][n]; const float4 mv = mq[bj][n]; const f32x4 a = acc[ai][bj][m][n];
            xv.x += mv.x * a[0]; xv.y += mv.y * a[1]; xv.z += mv.z * a[2]; xv.w += mv.w * a[3];
            *(float4*)(xpp[m] + col0 + bj * 128 + n * 16) = xv;
          }
    }
  }
};
struct EpiMoeUp {
  static constexpr bool PERM = true;
  bfr* HB; const int* list; const int* cnt;
  DEVINL void operator()(const Acc& acc, const Unit& u, int wr, int wc, int fr, int fq) const {
    const int ce = cnt[u.e];
#pragma unroll
    for (int ai = 0; ai < 2; ++ai) {
      int en[4];
#pragma unroll
      for (int m = 0; m < 4; ++m) { const int ei = u.pm * 256 + ai * 128 + wr * 64 + m * 16 + fr; en[m] = ei < ce ? list[(size_t)u.e * T + ei] : -1; }
#pragma unroll
      for (int m = 0; m < 4; ++m) {
        if (en[m] >= 0) {
          f32x4 v0, v1;
#pragma unroll
          for (int j = 0; j < 4; ++j) { v0[j] = silu(acc[ai][0][m][0][j]) * acc[ai][1][m][0][j]; v1[j] = silu(acc[ai][0][m][1][j]) * acc[ai][1][m][1][j]; }
          *(uint4*)(HB + (size_t)en[m] * 512 + u.pn * 128 + wc * 32 + 8 * fq) = pack8(v0, v1);
        }
      }
    }
  }
};
struct EpiMoeDown {
  static constexpr bool PERM = true;
  bfr* YS; const int* list; const int* cnt; const float* gatew;
  DEVINL void operator()(const Acc& acc, const Unit& u, int wr, int wc, int fr, int fq) const {
    const int ce = cnt[u.e];
#pragma unroll
    for (int ai = 0; ai < 2; ++ai) {
      int en[4]; float gw[4];
#pragma unroll
      for (int m = 0; m < 4; ++m) { const int ei = u.pm * 256 + ai * 128 + wr * 64 + m * 16 + fr; en[m] = ei < ce ? list[(size_t)u.e * T + ei] : -1; }
#pragma unroll
      for (int m = 0; m < 4; ++m) gw[m] = en[m] >= 0 ? gatew[en[m]] : 0.f;
#pragma unroll
      for (int m = 0; m < 4; ++m) {
        if (en[m] >= 0) {
          bfr* yp = YS + (size_t)(en[m] & 1) * T * D + (size_t)(en[m] >> 1) * D + u.pn * 256 + wc * 32 + 8 * fq;
#pragma unroll
          for (int bj = 0; bj < 2; ++bj) *(uint4*)(yp + bj * 128) = pack8(acc[ai][bj][m][0] * gw[m], acc[ai][bj][m][1] * gw[m]);
        }
      }
    }
  }
};
}

template <int L>
DEVINL void phase_gproj(const Params& p, char* sm, int c) {
  g8::TileSched S; S.init(L == 1 ? 64 : 68, 2); S.G = 32; S.c = c;
  g8::EpiP E{p.Gb, 512, 0};
  g8::RowAddr aA{NINP, 0, 0u}, aB{256, 1, 0u};
  g8::gemm8((LAS unsigned char*)sm, (const char*)(p.P + C_RWKV + 1792), (const char*)p.g2T, 256, S, E, aA, aB);
}
template <int L>
DEVINL void phase_gemm_in8(const Params& p, char* sm) {
  g8::TileSched S; S.init(T / 256, NINP / 256);
  g8::EpiP E{p.P, NINP, 0};
  g8::RowAddr aA{OLD, 0, 0u}, aB{D, 1, 0u};
  g8::gemm8(( LAS unsigned char*)sm, (const char*)(p.O + 2048), (const char*)p.WinT, D, S, E, aA, aB);
  if (L == 0 && blockIdx.x >= 44) {
    __syncthreads();
    convert_range<false>(p, 0, 1728 + blockIdx.x - 44, CONV_L_ITEMS, gridDim.x - 44, sm);
  }
}
template <int L>
DEVINL void phase_gates8(const Params& p, char* sm) {
  g8::TileSched S; S.init(L == 1 ? 64 : 68, 16);
  g8::EpiP E{p.GATES, 4096, 1};
  g8::RowAddr aA{OLD, 0, 0u}, aB{D, 1, 0u};
  g8::gemm8((LAS unsigned char*)sm, (const char*)(p.O + 2048), (const char*)p.WgT, D, S, E, aA, aB);
  __syncthreads();
  if (L == 1) convert_range<true>(p, L, blockIdx.x, 2048, gridDim.x, sm);
}
template <int L>
DEVINL void phase_branch8(const Params& p, char* sm) {
  g8::MergeSched S; S.init(L == 1 ? 64 : 68);
  g8::EpiBranch E{p.ACC, p.GATES};
  g8::RowAddr aA{OLD, 0, 512u * 2u}, aB{512, 1, (unsigned)(D * 512 * 2)};
  g8::gemm8((LAS unsigned char*)sm, (const char*)p.O, (const char*)p.WbT, 512, S, E, aA, aB);
  __syncthreads();
  if (L == 1) convert_range<true>(p, L, 2048 + blockIdx.x, 4096, gridDim.x, sm);
  else if (blockIdx.x >= 16) convert_range<true>(p, L, blockIdx.x - 16, CONV_M_ITEMS, gridDim.x - 16, sm);
}
template <int L>
DEVINL void phase_out8(const Params& p, char* sm) {
  g8::TileSched S; S.init(L == 1 ? 64 : 68, 4);
  g8::EpiOut E{p.out, p.xc, p.mod, L};
  g8::RowAddr aA{D, 0, 0u}, aB{D, 1, 0u};
  g8::gemm8((LAS unsigned char*)sm, (const char*)p.ACC, (const char*)p.WoT, D, S, E, aA, aB);
  __syncthreads();
  if (L == 0 && blockIdx.x >= 16) convert_range<false>(p, 1, blockIdx.x - 16, 3264, gridDim.x - 16, sm);
}
template <int L>
DEVINL void phase_moe_up8(const Params& p, char* sm) {
  const int* cnt = p.cnt + L * 16;
  g8::MoeSched S{cnt, 4, (int)gridDim.x, (int)blockIdx.x, 0};
  g8::EpiMoeUp E{p.HB, p.list, cnt};
  g8::GatherAddr aA{p.list, cnt, D * 2, 1};
  g8::RowAddr aB{D, 1, (unsigned)(D * D * 2)};
  g8::gemm8((LAS unsigned char*)sm, (const char*)p.HF, (const char*)p.WmguT, D, S, E, aA, aB);
  {
    int U = 0;
#pragma unroll 1
    for (int e = 0; e < 16; ++e) U += ((cnt[e] + 255) >> 8) * 4;
    const int G = gridDim.x, r = U % G, nl = G - r, c = blockIdx.x;
    const int first = (nl >= 64) ? c - r : c, stride = (nl >= 64) ? nl : G;
    __syncthreads();
    if (first >= 0) {
      if (L == 0) convert_range<false>(p, 1, 3264 + first, CONV_L_ITEMS, stride, sm);
      else convert_range<true>(p, L, 4096 + first, CONV_M_ITEMS, stride, sm);
    }
  }
}
template <int L>
DEVINL void phase_moe_down8(const Params& p, char* sm) {
  const int* cnt = p.cnt + L * 16;
  g8::MoeSched S{cnt, 4, (int)gridDim.x, (int)blockIdx.x, 0};
  g8::EpiMoeDown E{p.YS, p.list, cnt, p.gatew};
  g8::GatherAddr aA{p.list, cnt, 512 * 2, 0};
  g8::RowAddr aB{512, 1, (unsigned)(D * 512 * 2)};
  g8::gemm8((LAS unsigned char*)sm, (const char*)p.HB, (const char*)p.WmdT, 512, S, E, aA, aB);
}

DEVINL void phase_final(const Params& p) {
  const int lane = threadIdx.x & 63, wave = threadIdx.x >> 6;
  for (int tk = blockIdx.x * 8 + wave; tk < TL; tk += gridDim.x * 8) {
    float* xp = p.out + (size_t)tk * D;
    const int vv = tk >> 12;
    float v[16]; float ss = 0.f;
#pragma unroll
    for (int q = 0; q < 4; ++q) {
      const int j = q * 256 + lane * 4;
      float4 xv = *(const float4*)(xp + j);
      const float4 m5 = *(const float4*)(p.mod + ((size_t)1 * 5 + vv) * 6144 + 5 * 1024 + j);
      const uint2 y0 = *(const uint2*)(p.YS + (size_t)tk * D + j), y1 = *(const uint2*)(p.YS + (size_t)T * D + (size_t)tk * D + j);
      xv.x += m5.x * (bf2f(y0.x & 0xFFFF) + bf2f(y1.x & 0xFFFF)); xv.y += m5.y * (bf2f(y0.x >> 16) + bf2f(y1.x >> 16));
      xv.z += m5.z * (bf2f(y0.y & 0xFFFF) + bf2f(y1.y & 0xFFFF)); xv.w += m5.w * (bf2f(y0.y >> 16) + bf2f(y1.y >> 16));
      v[q * 4] = xv.x; v[q * 4 + 1] = xv.y; v[q * 4 + 2] = xv.z; v[q * 4 + 3] = xv.w;
      ss += xv.x * xv.x + xv.y * xv.y + xv.z * xv.z + xv.w * xv.w;
    }
    ss = wave_sum(ss);
    const float rs = rsqrtf(ss * (1.f / 1024.f) + EPS);
#pragma unroll
    for (int q = 0; q < 4; ++q) {
      const int j = q * 256 + lane * 4;
      const float4 fw = *(const float4*)(p.final_norm + j);
      *(float4*)(xp + j) = make_float4(v[q * 4] * rs * fw.x, v[q * 4 + 1] * rs * fw.y, v[q * 4 + 2] * rs * fw.z, v[q * 4 + 3] * rs * fw.w);
    }
  }
}

constexpr int NPHASE = 24;

template <int L>
DEVINL void layer_phases(const Params& p, const XcdBarrier& bar, char* sm, int ph0, int ph1) {
  constexpr int B0 = 1 + 11 * L;
#define PH(id, call) { if (ph0 <= (id) && (id) < ph1) { call; } if (ph0 <= (id) && (id) + 1 < ph1) xcd_barrier(bar); }
  PH(B0 + 0, phase_norm1<L>(p))
  PH(B0 + 1, phase_gemm_in8<L>(p, sm))
  PH(B0 + 2, phase_prep<L>(p, sm))
  PH(B0 + 3, phase_scans<L>(p, sm))
  PH(B0 + 4, phase_post2<L>(p))
  PH(B0 + 5, phase_gates8<L>(p, sm))
  PH(B0 + 6, phase_branch8<L>(p, sm))
  PH(B0 + 7, phase_out8<L>(p, sm))
  PH(B0 + 8, phase_route<L>(p, sm))
  PH(B0 + 9, phase_moe_up8<L>(p, sm))
  PH(B0 + 10, phase_moe_down8<L>(p, sm))
}

__global__ void __launch_bounds__(NTHR, 2) mega(Params p, unsigned* barw, int ph0, int ph1) {
  extern __shared__ __attribute__((aligned(16))) char smem[];
  if (threadIdx.x == 0) *(uint4*)smem = make_uint4(0u, 0u, 0u, 0u);
  __syncthreads();
  XcdBarrier bar = xcd_barrier_post(barw, (volatile LAS unsigned*)smem);
  char* sm = smem + 16;
  PH(0, phase_prologue(p, sm))
  layer_phases<0>(p, bar, sm, ph0, ph1);
  layer_phases<1>(p, bar, sm, ph0, ph1);
  if (ph0 <= 23 && 23 < ph1) phase_final(p);
}

}

extern "C" void kernel_launch(void* const* d_in, const int* in_sizes, int n_in, void* d_out, int out_size, void* d_ws, size_t ws_size, hipStream_t stream) {
  (void)in_sizes; (void)n_in; (void)out_size;
  static int inited = 0;
  if (!inited) {
    if (hipFuncSetAttribute((const void*)mega, hipFuncAttributeMaxDynamicSharedMemorySize, LDS_BYTES) != hipSuccess) fprintf(stderr, "hipFuncSetAttribute failed\n");
    int per_cu = 0;
    if (hipOccupancyMaxActiveBlocksPerMultiprocessor(&per_cu, (const void*)mega, NTHR, LDS_BYTES) != hipSuccess || per_cu < 1) fprintf(stderr, "occupancy query: %d\n", per_cu);
    inited = 1;
  }
  Params p{};
  const float** f = (const float**)&p;
  for (int i = 0; i < 42; ++i) f[i] = (const float*)d_in[i];
  p.out = (float*)d_out;
  char* w = (char*)d_ws;
  size_t off = 0;
  auto take = [&](size_t bytes) { char* r = w + off; off += (bytes + 255) & ~(size_t)255; return r; };
  unsigned* barw = (unsigned*)take(65536);
  p.cnt = (int*)(barw + 4 * XCD_BAR_WORDS);
  p.xc = (float*)take((size_t)TC * D * 4);
  p.mod = (float*)take((size_t)2 * 5 * 6144 * 4);
  p.bon = (float*)take((size_t)2 * T * 8 * 4);
  p.list = (int*)take((size_t)16 * T * 4);
  p.gatew = (float*)take((size_t)2 * T * 4);
  p.WinT = (bfr*)take((size_t)NINP * D * 2);
  p.WgT = (bfr*)take((size_t)4 * D * D * 2);
  p.WbT = (bfr*)take((size_t)4 * D * 512 * 2);
  p.WoT = (bfr*)take((size_t)D * D * 2);
  p.Gb = (bfr*)take((size_t)T * 512 * 2);
  p.g2T = (bfr*)take((size_t)512 * 256 * 2);
  p.O = (bfr*)take((size_t)T * OLD * 2);
  p.P = (bfr*)take((size_t)T * NINP * 2);
  {
    bfr* q = p.P;
    p.ACC = q; q += (size_t)T * D;
    p.GATES = q;
    p.HF = q; q += (size_t)T * D;
    p.HB = q; q += (size_t)2 * T * 512;
    p.YS = q; q += (size_t)2 * T * D;
    p.WmguT = q; q += (size_t)16 * D * D;
    p.WmdT = q; q += (size_t)16 * D * 512;
  }
  if (off > ws_size) { fprintf(stderr, "workspace too small: need %zu have %zu\n", off, ws_size); return; }
  hipMemsetAsync(barw, 0, 65536, stream);
#if MK_SINGLE
  hipLaunchKernelGGL(mega, dim3(256), dim3(NTHR), LDS_BYTES, stream, p, barw, 0, NPHASE);
#else
  for (int ph = 0; ph < NPHASE; ++ph) hipLaunchKernelGGL(mega, dim3(256), dim3(NTHR), LDS_BYTES, stream, p, barw, ph, ph + 1);
#endif
}
```

```cpp
#include <hip/hip_runtime.h>
#include <stdint.h>
#include <cstdio>

#ifndef MK_SINGLE
#define MK_SINGLE 1
#endif

namespace {

typedef unsigned short bfr;
typedef short bf16x8 __attribute__((ext_vector_type(8)));
typedef float f32x4 __attribute__((ext_vector_type(4)));
typedef float f32x2 __attribute__((ext_vector_type(2)));
typedef __bf16 bf16x2v __attribute__((ext_vector_type(2)));
#define DEVINL __device__ __forceinline__
#define LAS __attribute__((address_space(3)))

constexpr int D = 1024, NB = 4, SEQ = 4096, CTXL = 256;
constexpr int TL = NB * SEQ, TC = NB * CTXL, T = TL + TC;
constexpr int NIN = 6848, NINP = 6912, OLD = 4096;
constexpr int C_SSM = 0, C_GLA = 1296, C_RWKV = 2864, C_GDN = 4784;
constexpr int NTHR = 512;
constexpr int LDS_BYTES = 155648;
constexpr float EPS = 1e-6f;

struct Params {
  const float *x, *c, *ctx, *c_ctx, *ada_w, *ada_b, *norm_mix, *norm_ffn, *w_in, *w_gate, *w_branch, *w_out;
  const float *ssm_conv_w, *ssm_conv_b, *ssm_a_log, *ssm_dt_bias, *ssm_d, *ssm_norm;
  const float *gla_w2, *gla_b, *gla_norm;
  const float *rwkv_mu, *rwkv_w0, *rwkv_w2, *rwkv_a0, *rwkv_a2, *rwkv_g2, *rwkv_k_k, *rwkv_k_a, *rwkv_r_k, *rwkv_ln_w, *rwkv_ln_b;
  const float *gdn_conv_w, *gdn_a_log, *gdn_dt_bias, *gdn_norm;
  const float *router_w, *router_b, *moe_w_gate, *moe_w_up, *moe_w_down, *final_norm;
  float* out;
  float* xc;
  float* mod;
  bfr* O;
  bfr* P;
  bfr *WinT, *WgT, *WbT, *WoT;
  float* bon;
  int* cnt;
  int* list;
  float* gatew;
  bfr *ACC, *GATES, *HF, *HB, *YS, *WmguT, *WmdT;
  bfr *Gb, *g2T;
};

DEVINL float bf2f(bfr v) { return __uint_as_float(((unsigned)v) << 16); }
DEVINL bfr f2bf(float f) { return __builtin_bit_cast(bfr, (__bf16)f); }
DEVINL unsigned pack2(float a, float b) { f32x2 v = {a, b}; return __builtin_bit_cast(unsigned, __builtin_convertvector(v, bf16x2v)); }
DEVINL float sigm(float x) { return __builtin_amdgcn_rcpf(1.f + __expf(-x)); }
DEVINL float silu(float x) { return x * __builtin_amdgcn_rcpf(1.f + __expf(-x)); }
DEVINL float softplus(float x) { return fmaxf(x, 0.f) + __logf(1.f + __expf(-fabsf(x))); }
DEVINL float dpp_sum16(float v) {
  v += __int_as_float(__builtin_amdgcn_update_dpp(0, __float_as_int(v), 0xB1, 0xF, 0xF, true));
  v += __int_as_float(__builtin_amdgcn_update_dpp(0, __float_as_int(v), 0x4E, 0xF, 0xF, true));
  v += __int_as_float(__builtin_amdgcn_update_dpp(0, __float_as_int(v), 0x141, 0xF, 0xF, true));
  v += __int_as_float(__builtin_amdgcn_update_dpp(0, __float_as_int(v), 0x140, 0xF, 0xF, true));
  return v;
}
DEVINL float dpp_sum8(float v) {
  v += __int_as_float(__builtin_amdgcn_update_dpp(0, __float_as_int(v), 0xB1, 0xF, 0xF, true));
  v += __int_as_float(__builtin_amdgcn_update_dpp(0, __float_as_int(v), 0x4E, 0xF, 0xF, true));
  v += __int_as_float(__builtin_amdgcn_update_dpp(0, __float_as_int(v), 0x141, 0xF, 0xF, true));
  return v;
}
DEVINL float wave_sum(float v) { v = dpp_sum16(v); v += __shfl_xor(v, 16); v += __shfl_xor(v, 32); return v; }
template <int W> DEVINL float group_sum(float v) {
#pragma unroll
  for (int o = W / 2; o > 0; o >>= 1) v += __shfl_xor(v, o);
  return v;
}

#define XB_TMO      128
#define XB_XCNT(j)  (256  + 64 * (j))
#define XB_XSUB(j)  (1280 + 64 * (j))
#define XB_XGEN(j)  (2304 + 64 * (j))
#define XB_TOP      3328
#define XB_TOPGEN   3392
#define XCD_BAR_WORDS 3456
#define XB_SPIN_CAP (1u << 18)

DEVINL unsigned xb_ld(unsigned* p)              { return __hip_atomic_load(p, __ATOMIC_RELAXED, __HIP_MEMORY_SCOPE_AGENT); }
DEVINL unsigned xb_add(unsigned* p, unsigned v) { return __hip_atomic_fetch_add(p, v, __ATOMIC_RELAXED, __HIP_MEMORY_SCOPE_AGENT); }
DEVINL unsigned xb_xcc_id() { return (unsigned)__builtin_amdgcn_s_getreg((3 << 11) | 20) & 0xFu; }
#define XB_SPIN(cond, bar) do { unsigned _sp = 0; while (cond) { __builtin_amdgcn_s_sleep(1); \
    if ((++_sp & 255u) == 0u) { if (xb_ld(&(bar)[XB_TMO])) break; if (_sp > XB_SPIN_CAP) { atomicAdd(&(bar)[XB_TMO], 1u); break; } } } } while (0)

struct XcdBarrier { unsigned* bar; unsigned x; volatile LAS unsigned* st; };

DEVINL XcdBarrier xcd_barrier_post(unsigned* bar, volatile LAS unsigned* st) {
    XcdBarrier b; b.bar = bar; b.x = xb_xcc_id(); b.st = st;
    if (threadIdx.x == 0) (void)xb_add(&bar[XB_XCNT(b.x)], 1u);
    return b;
}
DEVINL void xcd_barrier_complete(unsigned* bar, unsigned x, unsigned& nloc, unsigned& nx) {
    const unsigned G = gridDim.x * gridDim.y * gridDim.z;
    unsigned sum, cnt, mine, sp = 0u;
    for (;;) {
        sum = 0u; cnt = 0u; mine = 0u;
#pragma unroll
        for (unsigned j = 0; j < 16; ++j) { const unsigned c = xb_ld(&bar[XB_XCNT(j)]); sum += c; cnt += (c > 0u) ? 1u : 0u; mine = (j == x) ? c : mine; }
        if (sum == G) break;
        __builtin_amdgcn_s_sleep(1);
        if ((++sp & 255u) == 0u) { if (xb_ld(&bar[XB_TMO])) break; if (sp > XB_SPIN_CAP) { atomicAdd(&bar[XB_TMO], 1u); break; } }
    }
    nloc = mine > 0u ? mine : 1u; nx = cnt > 0u ? cnt : 1u;
}
DEVINL void xcd_barrier(const XcdBarrier& b) {
    asm volatile("s_waitcnt vmcnt(0)" ::: "memory");
    __syncthreads();
    if (threadIdx.x == 0) {
        unsigned* bar = b.bar;
        __builtin_amdgcn_s_waitcnt(0);
        unsigned nloc = b.st[0], nx = b.st[1];
        if (nloc == 0u) { xcd_barrier_complete(bar, b.x, nloc, nx); b.st[0] = nloc; b.st[1] = nx; }
        const unsigned old = xb_add(&bar[XB_XSUB(b.x)], 1u);
        const unsigned gen = old / nloc;
        if (old + 1u == (gen + 1u) * nloc) {
            __builtin_amdgcn_fence(__ATOMIC_RELEASE, "agent");
            asm volatile("s_waitcnt vmcnt(0)" ::: "memory");
            const unsigned og = xb_add(&bar[XB_TOP], 1u);
            const unsigned tg = og / nx;
            if (og + 1u == (tg + 1u) * nx) xb_add(&bar[XB_TOPGEN], 1u);
            else XB_SPIN(xb_ld(&bar[XB_TOPGEN]) == tg, bar);
            __builtin_amdgcn_fence(__ATOMIC_ACQUIRE, "agent");
            xb_add(&bar[XB_XGEN(b.x)], 1u);
            asm volatile("s_waitcnt vmcnt(0)" ::: "memory");
        } else {
            XB_SPIN(xb_ld(&bar[XB_XGEN(b.x)]) == gen, bar);
            __builtin_amdgcn_fence(__ATOMIC_ACQUIRE, "agent");
            asm volatile("s_waitcnt vmcnt(0)" ::: "memory");
        }
    }
    __syncthreads();
}

namespace g8 {
constexpr int BM = 256, BK = 64, HALF = 128, HTB = HALF * BK * 2, NXCD = 8, WGM = 8;
DEVINL int lds_byte(int r, int c) { const int st = (r >> 4) * 2 + (c >> 5), rr = r & 15, cc = c & 31, ob = rr * 64 + cc * 2; return st * 1024 + (ob ^ (((ob >> 9) & 1) << 5)); }
DEVINL void stage_rc(int b, int& R, int& C) { const int st = b / 1024, sb = b % 1024, swz = sb ^ (((sb >> 9) & 1) << 5); R = (st >> 1) * 16 + swz / 64; C = (st & 1) * 32 + (swz % 64) / 2; }
DEVINL int perm32(int rho) { const int n = rho >> 4, i = rho & 15; return 8 * (i >> 2) + 4 * n + (i & 3); }
struct Unit { int pm, pn, e; };
typedef f32x4 Acc[2][2][4][2];

struct TileSched {
  int nM, nN, nwg, G, c;
  DEVINL void init(int nM_, int nN_) { nM = nM_; nN = nN_; nwg = nM * nN; G = gridDim.x; c = blockIdx.x; }
  DEVINL bool next(int i, Unit& u) const {
    const long L = (long)i * G + c; if (L >= nwg) return false;
    int wgid = (int)L; { const int q = nwg / NXCD, r = nwg % NXCD, xcd = wgid % NXCD, off = wgid / NXCD; wgid = (xcd < r ? xcd * (q + 1) : r * (q + 1) + (xcd - r) * q) + off; }
    const int nig = WGM * nN, gid = wgid / nig, fm = gid * WGM, gsz = (nM - fm) < WGM ? (nM - fm) : WGM;
    u.pm = fm + ((wgid % nig) % gsz); u.pn = (wgid % nig) / gsz; u.e = 0; return true;
  }
};
struct MergeSched {
  int nM, G, c;
  DEVINL void init(int nM_) { nM = nM_; G = gridDim.x; c = blockIdx.x; }
  DEVINL bool next(int i, Unit& u) const {
    const int tile = (i >> 2) * G + c; if (tile >= nM * 4) return false;
    const int hi = tile >> 8, x = tile & 7, idx = (tile & 255) >> 3;
    u.pm = hi ? 64 + (x >> 1) : x * 8 + (idx >> 2); u.pn = hi ? (x & 1) * 2 + idx : (idx & 3); u.e = i & 3; return true;
  }
};
struct MoeSched {
  const int* cnt; int npn, G, c, skip;
  DEVINL bool next(int i, Unit& u) const {
    int g = i * G + c - skip; if (g < 0) return false;
    int base = 0;
#pragma unroll 1
    for (int e = 0; e < 16; ++e) { const int n = ((cnt[e] + 255) >> 8) * npn; if (g < base + n) { const int r = g - base; u.e = e; u.pm = r / npn; u.pn = r % npn; return true; } base += n; }
    return false;
  }
};
struct RowAddr {
  int ld; int sel; unsigned estride;
  DEVINL unsigned operator()(const Unit& u, int r) const { return (unsigned)(((sel ? u.pn : u.pm) * 256 + r) * ld) * 2u + (unsigned)u.e * estride; }
};
struct GatherAddr {
  const int* list; const int* cnt; int rowbytes; int shift;
  DEVINL unsigned operator()(const Unit& u, int r) const {
    const int ce = cnt[u.e]; int ei = u.pm * 256 + r; ei = ei < ce ? ei : ce - 1;
    return (unsigned)(list[(size_t)u.e * T + ei] >> shift) * (unsigned)rowbytes;
  }
};

template <class Epi, class Sched, class AA, class AB>
DEVINL void gemm8(LAS unsigned char* lds, const char* Abase, const char* Bbase, int K, const Sched& S, const Epi& E, const AA& aA, const AB& aB) {
  const int tid = threadIdx.x, wid = __builtin_amdgcn_readfirstlane(tid >> 6), lane = tid & 63, wr = wid >> 2, wc = wid & 3, fr = lane & 15, fq = lane >> 4;
  const int nt = K / BK;
  int Rr[2], Cc[2], Rb[2];
#pragma unroll
  for (int i = 0; i < 2; ++i) { stage_rc(tid * 16 + i * 8192, Rr[i], Cc[i]); Rb[i] = Epi::PERM ? ((Rr[i] & ~31) + perm32(Rr[i] & 31)) : Rr[i]; }
  const unsigned ldsw = (unsigned)wid * 1024u;
  const int aoff = lds_byte(wr * 64 + fr, fq * 8), boff = lds_byte(wc * 32 + fr, fq * 8);
#define G8_SA(b, h) (((b) * 2 + (h)) * HTB)
#define G8_SB(b, h) ((4 + (b) * 2 + (h)) * HTB)
#define G8_STAGE(bufoff, base, kb, o) do { \
    __builtin_amdgcn_global_load_lds((const unsigned*)((base) + (o)[0] + (kb)), (LAS unsigned*)(lds + (bufoff) + ldsw), 16, 0, 0); \
    __builtin_amdgcn_global_load_lds((const unsigned*)((base) + (o)[1] + (kb)), (LAS unsigned*)(lds + (bufoff) + ldsw + 8192), 16, 0, 0); } while (0)
#define G8_LDA(dst, b, h) do { _Pragma("unroll") for (int m = 0; m < 4; ++m) _Pragma("unroll") for (int k = 0; k < 2; ++k) dst[m][k] = *(const LAS bf16x8*)(lds + G8_SA(b, h) + aoff + m * 2048 + k * 1024); } while (0)
#define G8_LDB(dst, b, h) do { _Pragma("unroll") for (int n = 0; n < 2; ++n) _Pragma("unroll") for (int k = 0; k < 2; ++k) dst[n][k] = *(const LAS bf16x8*)(lds + G8_SB(b, h) + boff + n * 2048 + k * 1024); } while (0)
#define G8_MMA(ai, bj, At, Bt) do { __builtin_amdgcn_s_setprio(1); _Pragma("unroll") for (int m = 0; m < 4; ++m) _Pragma("unroll") for (int n = 0; n < 2; ++n) _Pragma("unroll") for (int k = 0; k < 2; ++k) \
    acc[ai][bj][m][n] = __builtin_amdgcn_mfma_f32_16x16x32_bf16(Bt[n][k], At[m][k], acc[ai][bj][m][n], 0, 0, 0); __builtin_amdgcn_s_setprio(0); } while (0)
#define G8_WAIT_V(n) asm volatile("s_waitcnt vmcnt(" #n ")" ::: "memory")
#define G8_WAIT_L(n) asm volatile("s_waitcnt lgkmcnt(" #n ")" ::: "memory")
#define G8_BAR __builtin_amdgcn_s_barrier()
#define G8_SCHED __builtin_amdgcn_sched_barrier(0)
  Unit cur, nxt; int ui = 0;
  if (!S.next(0, cur)) return;
  Acc acc;
#pragma unroll
  for (int a = 0; a < 2; ++a)
#pragma unroll
    for (int b = 0; b < 2; ++b)
#pragma unroll
      for (int m = 0; m < 4; ++m)
#pragma unroll
        for (int n = 0; n < 2; ++n) acc[a][b][m][n] = f32x4{0.f, 0.f, 0.f, 0.f};
  bf16x8 At[4][2], B0[2][2], B1[2][2];
  unsigned oAc[2][2], oBc[2][2], oAn[2][2], oBn[2][2];
#pragma unroll
  for (int h = 0; h < 2; ++h)
#pragma unroll
    for (int i = 0; i < 2; ++i) { oAc[h][i] = aA(cur, h * 128 + Rr[i]) + Cc[i] * 2; oBc[h][i] = aB(cur, h * 128 + Rb[i]) + Cc[i] * 2; oAn[h][i] = oAc[h][i]; oBn[h][i] = oBc[h][i]; }
  G8_STAGE(G8_SB(0, 0), Bbase, 0, oBc[0]); G8_STAGE(G8_SA(0, 0), Abase, 0, oAc[0]); G8_STAGE(G8_SB(0, 1), Bbase, 0, oBc[1]); G8_STAGE(G8_SA(0, 1), Abase, 0, oAc[1]);
  if (wr == 1) G8_BAR;
  G8_WAIT_V(4); G8_BAR;
  G8_STAGE(G8_SB(1, 0), Bbase, 128, oBc[0]); G8_STAGE(G8_SA(1, 0), Abase, 128, oAc[0]); G8_STAGE(G8_SB(1, 1), Bbase, 128, oBc[1]);
  G8_WAIT_V(6); G8_BAR;
  for (;;) {
    const bool has_next = S.next(ui + 1, nxt);
    if (has_next) {
#pragma unroll
      for (int h = 0; h < 2; ++h)
#pragma unroll
        for (int i = 0; i < 2; ++i) { oAn[h][i] = aA(nxt, h * 128 + Rr[i]) + Cc[i] * 2; oBn[h][i] = aB(nxt, h * 128 + Rb[i]) + Cc[i] * 2; }
    } else {
#pragma unroll
      for (int h = 0; h < 2; ++h)
#pragma unroll
        for (int i = 0; i < 2; ++i) { oAn[h][i] = oAc[h][i]; oBn[h][i] = oBc[h][i]; }
    }
    for (int t = 0; t < nt; t += 2) {
      const bool last = (t == nt - 2);
      const int k1 = (t + 1) * 128, k2 = last ? 0 : (t + 2) * 128, k3 = k2 + 128;
      unsigned a2[2][2], b2[2][2];
#pragma unroll
      for (int h = 0; h < 2; ++h)
#pragma unroll
        for (int i = 0; i < 2; ++i) { a2[h][i] = last ? oAn[h][i] : oAc[h][i]; b2[h][i] = last ? oBn[h][i] : oBc[h][i]; }
      G8_LDB(B0, 0, 0); G8_SCHED; G8_LDA(At, 0, 0); G8_STAGE(G8_SA(1, 1), Abase, k1, oAc[1]);
      G8_WAIT_L(8); G8_BAR; G8_WAIT_L(0); G8_MMA(0, 0, At, B0); G8_BAR; G8_SCHED;
      G8_LDB(B1, 0, 1); G8_STAGE(G8_SB(0, 0), Bbase, k2, b2[0]);
      G8_BAR; G8_WAIT_L(0); G8_MMA(0, 1, At, B1); G8_BAR;
      G8_LDA(At, 0, 1); G8_STAGE(G8_SA(0, 0), Abase, k2, a2[0]);
      G8_BAR; G8_WAIT_L(0); G8_MMA(1, 0, At, B0); G8_BAR; G8_SCHED;
      G8_STAGE(G8_SB(0, 1), Bbase, k2, b2[1]);
      G8_WAIT_V(6); G8_BAR; G8_MMA(1, 1, At, B1); G8_BAR;
      G8_LDB(B0, 1, 0); G8_SCHED; G8_LDA(At, 1, 0); G8_STAGE(G8_SA(0, 1), Abase, k2, a2[1]);
      G8_WAIT_L(8); G8_BAR; G8_WAIT_L(0); G8_MMA(0, 0, At, B0); G8_BAR; G8_SCHED;
      G8_LDB(B1, 1, 1); G8_STAGE(G8_SB(1, 0), Bbase, k3, b2[0]);
      G8_BAR; G8_WAIT_L(0); G8_MMA(0, 1, At, B1); G8_BAR;
      G8_LDA(At, 1, 1); G8_STAGE(G8_SA(1, 0), Abase, k3, a2[0]);
      G8_BAR; G8_WAIT_L(0); G8_MMA(1, 0, At, B0); G8_BAR; G8_SCHED;
      G8_STAGE(G8_SB(1, 1), Bbase, k3, b2[1]);
      G8_WAIT_V(6); G8_BAR; G8_MMA(1, 1, At, B1); G8_BAR;
    }
    E(acc, cur, wr, wc, fr, fq);
    if (!has_next) break;
#pragma unroll
    for (int a = 0; a < 2; ++a)
#pragma unroll
      for (int b = 0; b < 2; ++b)
#pragma unroll
        for (int m = 0; m < 4; ++m)
#pragma unroll
          for (int n = 0; n < 2; ++n) acc[a][b][m][n] = f32x4{0.f, 0.f, 0.f, 0.f};
    cur = nxt; ++ui;
#pragma unroll
    for (int h = 0; h < 2; ++h)
#pragma unroll
      for (int i = 0; i < 2; ++i) { oAc[h][i] = oAn[h][i]; oBc[h][i] = oBn[h][i]; }
  }
  G8_WAIT_V(0);
  if (wr == 0) G8_BAR;
  G8_BAR;
#undef G8_SA
#undef G8_SB
#undef G8_STAGE
#undef G8_LDA
#undef G8_LDB
#undef G8_MMA
#undef G8_WAIT_V
#undef G8_WAIT_L
#undef G8_BAR
#undef G8_SCHED
}
}

#define CONV_ARGS(x) const float* x##src, bfr* x##dst, int x##N, int x##Kd, int x##kt, int x##nt, int x##drow0
#define CONV_REFS(x) const float*& x##src, bfr*& x##dst, int& x##N, int& x##Kd, int& x##kt, int& x##nt, int& x##drow0
#define CONV_PASS(x) x##src, x##dst, x##N, x##Kd, x##kt, x##nt, x##drow0
DEVINL void conv_load(CONV_ARGS(d_), f32x4& v0, f32x4& v1) {
  const int tid = threadIdx.x, r = tid >> 4, c4 = (tid & 15) * 4;
  (void)d_dst; (void)d_Kd; (void)d_drow0;
  if (d_src) {
    const float* s = d_src + (size_t)(d_kt * 64 + r) * d_N + d_nt * 64 + c4;
    v0 = *(const f32x4*)s; v1 = *(const f32x4*)(s + (size_t)32 * d_N);
  } else { v0 = f32x4{0.f, 0.f, 0.f, 0.f}; v1 = v0; }
}
DEVINL void conv_store(CONV_ARGS(d_), const f32x4& v0, const f32x4& v1, char* sm) {
  float* tile = (float*)sm;
  const int tid = threadIdx.x, r = tid >> 4, c4 = (tid & 15) * 4;
  (void)d_src; (void)d_N; (void)d_nt;
  __syncthreads();
  tile[r * 65 + c4] = v0[0]; tile[r * 65 + c4 + 1] = v0[1]; tile[r * 65 + c4 + 2] = v0[2]; tile[r * 65 + c4 + 3] = v0[3];
  tile[(r + 32) * 65 + c4] = v1[0]; tile[(r + 32) * 65 + c4 + 1] = v1[1]; tile[(r + 32) * 65 + c4 + 2] = v1[2]; tile[(r + 32) * 65 + c4 + 3] = v1[3];
  __syncthreads();
  const int n = tid >> 3, k8 = (tid & 7) * 8;
  float y[8];
#pragma unroll
  for (int j = 0; j < 8; ++j) y[j] = tile[(k8 + j) * 65 + n];
  *(uint4*)(d_dst + (size_t)(d_drow0 + n) * d_Kd + d_kt * 64 + k8) = make_uint4(pack2(y[0], y[1]), pack2(y[2], y[3]), pack2(y[4], y[5]), pack2(y[6], y[7]));
}
constexpr int CONV_L_ITEMS = 1712 + 16 + 1024 + 512 + 256;
DEVINL void conv_layer_desc(const Params& p, int l, int it, CONV_REFS(d_)) {
  if (it < 1712) { d_src = p.w_in + (size_t)l * D * NIN; d_dst = p.WinT; d_N = NIN; d_Kd = D; d_kt = it / 107; d_nt = it % 107; }
  else if (it < 1728) { d_src = nullptr; d_dst = p.WinT; d_N = 0; d_Kd = D; d_kt = it - 1712; d_nt = 107; }
  else if (it < 2752) { const int g = (it - 1728) >> 8, r = (it - 1728) & 255; d_src = p.w_gate + ((size_t)l * 4 + g) * D * D; d_dst = p.WgT + (size_t)g * D * D; d_N = D; d_Kd = D; d_kt = r >> 4; d_nt = r & 15; }
  else if (it < 3264) { const int g = (it - 2752) >> 7, r = (it - 2752) & 127; d_src = p.w_branch + ((size_t)l * 4 + g) * 512 * D; d_dst = p.WbT + (size_t)g * D * 512; d_N = D; d_Kd = 512; d_kt = r >> 4; d_nt = r & 15; }
  else { const int r = it - 3264; d_src = p.w_out + (size_t)l * D * D; d_dst = p.WoT; d_N = D; d_Kd = D; d_kt = r >> 4; d_nt = r & 15; }
  d_drow0 = d_nt * 64;
}
constexpr int CONV_M_ITEMS = 6144;
DEVINL void conv_moe_desc(const Params& p, int l, int it, CONV_REFS(d_)) {
  const int which = it / 2048, r = it % 2048, e = r >> 7, tt = r & 127;
  const size_t eo = ((size_t)l * 16 + e) * (size_t)D * 512;
  if (which < 2) { d_src = (which ? p.moe_w_up : p.moe_w_gate) + eo; d_dst = p.WmguT + (size_t)e * D * D; d_N = 512; d_Kd = D; d_kt = tt >> 3; d_nt = tt & 7; d_drow0 = ((tt & 7) >> 1) * 256 + which * 128 + ((tt & 7) & 1) * 64; }
  else { d_src = p.moe_w_down + eo; d_dst = p.WmdT + (size_t)e * D * 512; d_N = D; d_Kd = 512; d_kt = tt >> 4; d_nt = tt & 15; d_drow0 = (tt & 15) * 64; }
}
template <bool MOE>
DEVINL void convert_range(const Params& p, int l, int start, int end, int stride, char* sm) {
  if (start >= end) return;
  const float* c_src; bfr* c_dst; int c_N, c_Kd, c_kt, c_nt, c_drow0;
  if (MOE) conv_moe_desc(p, l, start, CONV_PASS(c_)); else conv_layer_desc(p, l, start, CONV_PASS(c_));
  f32x4 v0, v1; conv_load(CONV_PASS(c_), v0, v1);
#pragma unroll 1
  for (int it = start; it < end; it += stride) {
    const int itn = (it + stride < end) ? it + stride : it;
    const float* n_src; bfr* n_dst; int n_N, n_Kd, n_kt, n_nt, n_drow0;
    if (MOE) conv_moe_desc(p, l, itn, CONV_PASS(n_)); else conv_layer_desc(p, l, itn, CONV_PASS(n_));
    f32x4 n0, n1; conv_load(CONV_PASS(n_), n0, n1);
    conv_store(CONV_PASS(c_), v0, v1, sm);
    c_src = n_src; c_dst = n_dst; c_N = n_N; c_Kd = n_Kd; c_kt = n_kt; c_nt = n_nt; c_drow0 = n_drow0; v0 = n0; v1 = n1;
  }
}
#undef CONV_ARGS
#undef CONV_REFS
#undef CONV_PASS

DEVINL void adaln_item(const Params& p, int it, char* sm) {
  const int l = it / 96, jb = it % 96, tid = threadIdx.x, c = tid & 63, ks = tid >> 6;
  float* sc = (float*)sm;
  float* red = sc + 5 * 1024;
  __syncthreads();
  for (int i = tid; i < 5 * 1024; i += NTHR) { const int v = i >> 10, k = i & 1023; const float cv = v < 4 ? p.c[v * 1024 + k] : p.c_ctx[k]; sc[i] = silu(cv); }
  __syncthreads();
  const int j = jb * 64 + c;
  float a[5] = {0.f, 0.f, 0.f, 0.f, 0.f};
  const float* w = p.ada_w + (size_t)l * D * 6144 + j;
#pragma unroll 16
  for (int k = ks * 128; k < ks * 128 + 128; ++k) {
    const float wv = w[(size_t)k * 6144];
#pragma unroll
    for (int v = 0; v < 5; ++v) a[v] += sc[v * 1024 + k] * wv;
  }
#pragma unroll
  for (int v = 0; v < 5; ++v) red[(ks * 5 + v) * 64 + c] = a[v];
  __syncthreads();
  if (tid < 320) {
    const int v = tid >> 6;
    float sum = 0.f;
#pragma unroll
    for (int q = 0; q < 8; ++q) sum += red[(q * 5 + v) * 64 + c];
    p.mod[((size_t)l * 5 + v) * 6144 + j] = sum + p.ada_b[l * 6144 + j];
  }
}
DEVINL void phase_prologue(const Params& p, char* sm) {
  if (blockIdx.x < 192) adaln_item(p, blockIdx.x, sm);
  convert_range<false>(p, 0, blockIdx.x, 1728, gridDim.x, sm);
}

DEVINL int canon_row(int L, int R) {
  if (L & 1) { const int b = R >> 12, s = R & 4095; return (b << 12) | ((s & 63) << 6) | (s >> 6); }
  return R;
}
template <int L>
DEVINL void phase_norm1(const Params& p) {
  const int lane = threadIdx.x & 63, wave = threadIdx.x >> 6;
  for (int R = blockIdx.x * 8 + wave; R < T; R += gridDim.x * 8) {
    const bool lat = R < TL;
    const int cr = lat ? canon_row(L, R) : R;
    const int vv = lat ? (R >> 12) : 4;
    float* xp = lat ? p.out + (size_t)cr * D : p.xc + (size_t)(R - TL) * D;
    const float* src = lat ? p.x + (size_t)cr * D : p.ctx + (size_t)(R - TL) * D;
    float4 xq[4]; uint2 y0q[4], y1q[4]; float4 m5q[4];
#pragma unroll
    for (int q = 0; q < 4; ++q) {
      const int j = q * 256 + lane * 4;
      if (L == 0) xq[q] = *(const float4*)(src + j);
      else {
        xq[q] = *(const float4*)(xp + j);
        m5q[q] = *(const float4*)(p.mod + ((size_t)(L - 1) * 5 + vv) * 6144 + 5 * 1024 + j);
        y0q[q] = *(const uint2*)(p.YS + (size_t)cr * D + j); y1q[q] = *(const uint2*)(p.YS + (size_t)T * D + (size_t)cr * D + j);
      }
    }
    float v[16]; float ss = 0.f;
#pragma unroll
    for (int q = 0; q < 4; ++q) {
      const int j = q * 256 + lane * 4;
      float4 xv = xq[q];
      if (L != 0) {
        const float4 m5 = m5q[q]; const uint2 y0 = y0q[q], y1 = y1q[q];
        xv.x += m5.x * (bf2f(y0.x & 0xFFFF) + bf2f(y1.x & 0xFFFF)); xv.y += m5.y * (bf2f(y0.x >> 16) + bf2f(y1.x >> 16));
        xv.z += m5.z * (bf2f(y0.y & 0xFFFF) + bf2f(y1.y & 0xFFFF)); xv.w += m5.w * (bf2f(y0.y >> 16) + bf2f(y1.y >> 16));
      }
      *(float4*)(xp + j) = xv;
      v[q * 4] = xv.x; v[q * 4 + 1] = xv.y; v[q * 4 + 2] = xv.z; v[q * 4 + 3] = xv.w;
      ss += xv.x * xv.x + xv.y * xv.y + xv.z * xv.z + xv.w * xv.w;
    }
    ss = wave_sum(ss);
    const float rs = rsqrtf(ss * (1.f / 1024.f) + EPS);
    const float* md = p.mod + ((size_t)L * 5 + vv) * 6144;
    float4 nwq[4], shq[4], sclq[4];
#pragma unroll
    for (int q = 0; q < 4; ++q) { const int j = q * 256 + lane * 4; nwq[q] = *(const float4*)(p.norm_mix + L * D + j); shq[q] = *(const float4*)(md + j); sclq[q] = *(const float4*)(md + 1024 + j); }
#pragma unroll
    for (int q = 0; q < 4; ++q) {
      const int j = q * 256 + lane * 4;
      const float4 nw = nwq[q], sh = shq[q], scl = sclq[q];
      const float h0 = v[q * 4] * rs * nw.x * (1.f + scl.x) + sh.x, h1 = v[q * 4 + 1] * rs * nw.y * (1.f + scl.y) + sh.y;
      const float h2 = v[q * 4 + 2] * rs * nw.z * (1.f + scl.z) + sh.z, h3 = v[q * 4 + 3] * rs * nw.w * (1.f + scl.w) + sh.w;
      *(uint2*)(p.O + (size_t)R * OLD + 2048 + j) = make_uint2(pack2(h0, h1), pack2(h2, h3));
    }
  }
}

DEVINL void chunk_of_step(int step, int b, int d, int& rb, int& len, int& c) {
  const int seg = step >= 4, cc = seg ? step - 4 : step, nch = seg ? 64 : 4;
  c = d ? nch - 1 - cc : cc; len = seg ? SEQ : CTXL; rb = seg ? b * SEQ : TL + b * CTXL;
}
template <int KS>
DEVINL f32x4 mma16(const bfr* A, int lda, const bfr* Bt, int ldb, f32x4 acc) {
  const int lane = threadIdx.x & 63;
  const bfr* ap = A + (lane & 15) * lda + (lane >> 4) * 8;
  const bfr* bp = Bt + (lane & 15) * ldb + (lane >> 4) * 8;
#pragma unroll
  for (int ks = 0; ks < KS; ++ks) acc = __builtin_amdgcn_mfma_f32_16x16x32_bf16(*(const bf16x8*)(ap + 32 * ks), *(const bf16x8*)(bp + 32 * ks), acc, 0, 0, 0);
  return acc;
}
DEVINL void unpack8(const uint4 v, float (&o)[8]) {
  o[0] = __uint_as_float(v.x << 16); o[1] = __uint_as_float(v.x & 0xFFFF0000u); o[2] = __uint_as_float(v.y << 16); o[3] = __uint_as_float(v.y & 0xFFFF0000u);
  o[4] = __uint_as_float(v.z << 16); o[5] = __uint_as_float(v.z & 0xFFFF0000u); o[6] = __uint_as_float(v.w << 16); o[7] = __uint_as_float(v.w & 0xFFFF0000u);
}
DEVINL void unpack4(const uint2 v, float (&o)[4]) {
  o[0] = __uint_as_float(v.x << 16); o[1] = __uint_as_float(v.x & 0xFFFF0000u); o[2] = __uint_as_float(v.y << 16); o[3] = __uint_as_float(v.y & 0xFFFF0000u);
}


template <int W8>
DEVINL void prep_item(const Params& p, int b, int col0, const float* t0g, const float* t1g, const float* t2g, const float* bg, bool shiftmode, int act, bool norm, float nscale, char* sm) {
  constexpr int W = W8 * 8, RS = 256, NV = (RS + 1) * W8, NPF = (NV + NTHR - 1) / NTHR, G = W8 / 8;
  const int tid = threadIdx.x;
  bfr* RAWP = (bfr*)sm;
  float* PT = (float*)(RAWP + (RS + 2) * W);
  __syncthreads();
  for (int c = tid; c < W; c += NTHR) {
    if (shiftmode) { const float mu = t0g[c]; PT[c] = 0.5f * mu; PT[W + c] = 1.f - mu; PT[2 * W + c] = 0.5f * mu; PT[3 * W + c] = 0.f; }
    else { PT[c] = t0g[c]; PT[W + c] = t1g[c]; PT[2 * W + c] = t2g[c]; PT[3 * W + c] = bg ? bg[c] : 0.f; }
  }
  uint4 pf[NPF];
  auto prefetch = [&](int step) {
    const int seg = step >= 1, cc = seg ? step - 1 : 0, len = seg ? SEQ : CTXL, rb = seg ? b * SEQ : TL + b * CTXL;
#pragma unroll
    for (int q = 0; q < NPF; ++q) {
      const int idx = tid + NTHR * q;
      uint4 v = make_uint4(0, 0, 0, 0);
      if (idx < NV) { const int r = idx / W8, g = idx % W8, t = cc * RS + r; if (t < len) v = *(const uint4*)(p.P + (size_t)(rb + t) * NINP + col0 + g * 8); }
      pf[q] = v;
    }
  };
  prefetch(0);
#pragma unroll 1
  for (int step = 0; step < 17; ++step) {
    const int seg = step >= 1, cc = seg ? step - 1 : 0, rb = seg ? b * SEQ : TL + b * CTXL;
    __syncthreads();
    if (tid < W8) *(uint4*)(RAWP + tid * 8) = (cc == 0) ? make_uint4(0, 0, 0, 0) : *(const uint4*)(RAWP + RS * W + tid * 8);
    __syncthreads();
#pragma unroll
    for (int q = 0; q < NPF; ++q) { const int idx = tid + NTHR * q; if (idx < NV) *(uint4*)(RAWP + (1 + idx / W8) * W + (idx % W8) * 8) = pf[q]; }
    __syncthreads();
    if (step + 1 < 17) prefetch(step + 1);
#pragma unroll 1
    for (int rep = 0; rep < 4; ++rep) {
      const int i = rep * 64 + (tid >> 3);
      float ssq = 0.f; float y[G][8];
#pragma unroll
      for (int gq = 0; gq < G; ++gq) {
        const int cbase = ((tid & 7) * G + gq) * 8;
        float x0[8], x1[8], x2[8];
        unpack8(*(const uint4*)(RAWP + i * W + cbase), x0); unpack8(*(const uint4*)(RAWP + (i + 1) * W + cbase), x1); unpack8(*(const uint4*)(RAWP + (i + 2) * W + cbase), x2);
#pragma unroll
        for (int e = 0; e < 8; ++e) {
          float v = PT[cbase + e] * x0[e] + PT[W + cbase + e] * x1[e] + PT[2 * W + cbase + e] * x2[e] + PT[3 * W + cbase + e];
          if (act == 1) v = silu(v); else if (act == 2) v = 1.f - 2.f * __builtin_amdgcn_rcpf(1.f + __expf(2.f * v)); else if (act == 3) v = sigm(v);
          y[gq][e] = v; ssq += v * v;
        }
      }
      float sc = 1.f;
      if (norm) { ssq = dpp_sum8(ssq); sc = __builtin_amdgcn_rsqf(ssq + EPS) * nscale; }
#pragma unroll
      for (int gq = 0; gq < G; ++gq) {
        const int cbase = ((tid & 7) * G + gq) * 8;
        *(uint4*)(p.P + (size_t)(rb + cc * RS + i) * NINP + col0 + cbase) =
            make_uint4(pack2(y[gq][0] * sc, y[gq][1] * sc), pack2(y[gq][2] * sc, y[gq][3] * sc), pack2(y[gq][4] * sc, y[gq][5] * sc), pack2(y[gq][6] * sc, y[gq][7] * sc));
      }
    }
  }
}
template <int L>
DEVINL void phase_prep(const Params& p, char* sm) {
  const int it = blockIdx.x;
  if (it >= 232) {
    for (int idx = (it - 232) * NTHR + threadIdx.x; idx < 512 * 256; idx += 24 * NTHR) { const int c = idx >> 8, k = idx & 255; p.g2T[idx] = k < 128 ? f2bf(p.rwkv_g2[((size_t)L * 128 + k) * 512 + c]) : (bfr)0; }
    return;
  }
  if (it < 32) {
    const int b = it >> 3, r = it & 7, isk = r >> 2, h = r & 3, ch = isk * 512 + h * 128;
    const float* cw = p.gdn_conv_w + (size_t)L * 3 * 1536 + ch;
    prep_item<16>(p, b, C_GDN + ch, cw, cw + 1536, cw + 3072, nullptr, false, 1, true, isk ? 1.f : 0.08838834764831845f, sm);
    return;
  }
  const int j = it - 32, b = j / 50, r = j % 50;
  if (r < 12) {
    const int ch = r * 64; const float* cw = p.ssm_conv_w + (size_t)L * 3 * 768 + ch;
    prep_item<8>(p, b, C_SSM + 512 + ch, cw, cw + 768, cw + 1536, p.ssm_conv_b + L * 768 + ch, false, 1, false, 1.f, sm);
  } else if (r < 20) {
    const int ch = 1024 + (r - 12) * 64; const float* cw = p.gdn_conv_w + (size_t)L * 3 * 1536 + ch;
    prep_item<8>(p, b, C_GDN + ch, cw, cw + 1536, cw + 3072, nullptr, false, 1, false, 1.f, sm);
  } else {
    const int ch = (r - 20) * 64; const float* mu = p.rwkv_mu + L * 1920 + ch;
    const int act = (ch >= 1536 && ch < 1664) ? 2 : (ch >= 1792 ? 3 : 0);
    prep_item<8>(p, b, C_RWKV + ch, mu, mu, mu, nullptr, true, act, false, 1.f, sm);
  }
}

DEVINL int rwkv_colbase(int g, int h, int d) { return g == 0 ? h * 64 : g == 1 ? 512 + h * 64 : g == 2 ? 1024 + h * 64 : g == 3 ? 1536 + d * 64 : 1664 + d * 64; }
DEVINL f32x4 bmm16(const float* A, int lda, const float* B, int ldb, f32x4 acc) {
  const int lane = threadIdx.x & 63;
#pragma unroll
  for (int s2 = 0; s2 < 4; ++s2) {
    const float a = A[(lane & 15) * lda + 4 * s2 + (lane >> 4)], b = B[(4 * s2 + (lane >> 4)) * ldb + (lane & 15)];
    acc = __builtin_amdgcn_mfma_f32_16x16x4f32(a, b, acc, 0, 0, 0);
  }
  asm volatile("" ::: "memory");
  return acc;
}
DEVINL void chunk32_of_step(int step, int b, int d, int& rb, int& c) {
  const int seg = step >= 8, cc = seg ? step - 8 : step, nch = seg ? 128 : 8;
  c = d ? nch - 1 - cc : cc; rb = seg ? b * SEQ : TL + b * CTXL;
}
DEVINL void rwkv3_prefetch(const Params& p, uint4& pfA, uint4& pfB, uint4 (&fw)[2], int step, int b, int d, int h) {
  int rb, c; chunk32_of_step(step, b, d, rb, c);
  const int tid = threadIdx.x, lane = tid & 63, ti = (tid >> 7) & 1, mat = (tid >> 6) & 1;
  const bfr* base = p.P + (size_t)(rb + c * 32) * NINP + C_RWKV;
  { const int r = tid >> 4, g = tid & 15; pfA = *(const uint4*)(base + (size_t)r * NINP + (g < 8 ? rwkv_colbase(0, h, d) + g * 8 : rwkv_colbase(1, h, d) + (g - 8) * 8)); }
  if (tid < 256) { const int r = tid >> 3, g = tid & 7; pfB = *(const uint4*)(base + (size_t)r * NINP + rwkv_colbase(2, h, d) + g * 8); }
  {
    const int i = ti * 16 + (lane & 15), r = d ? 31 - i : i;
    const bfr* rowp = base + (size_t)r * NINP + (lane >> 4) * 8;
    const int cb = mat ? rwkv_colbase(4, h, d) : rwkv_colbase(3, h, d);
    fw[0] = *(const uint4*)(rowp + cb); fw[1] = *(const uint4*)(rowp + cb + 32);
  }
}
template <int L>
DEVINL void scan_rwkv3(const Params& p, int item, char* sm) {
  const int d = item & 1, h = (item >> 1) & 7, b = item >> 4;
  const int tid = threadIdx.x, lane = tid & 63, wave = __builtin_amdgcn_readfirstlane(tid >> 6);
  constexpr int LK = 72, LJ = 40, LFS = 36, NCH = 136;
  bfr* w2T = (bfr*)sm; bfr* a2T = w2T + 64 * LK; bfr* RK = a2T + 64 * LK; bfr* BR = RK + 32 * 128; bfr* KR = BR + 32 * LK;
  float* Gf = (float*)(KR + 32 * LK); float* LWf = Gf + 2048; float* ARf = LWf + 2048;
  bfr* KH = (bfr*)(ARf + 2048); bfr* RH = KH + 32 * LK; bfr* BC = RH + 32 * LK; bfr* KC = BC + 32 * LK;
  bfr* BTt = KC + 32 * LK; bfr* KTt = BTt + 64 * LJ; bfr* VT0 = KTt + 64 * LJ; bfr* VT1 = VT0 + 64 * LJ;
  float* Lf = (float*)(VT1 + 64 * LJ); float* Tf = Lf + 32 * LFS;
  bfr* Tm = (bfr*)(Tf + 32 * LFS); bfr* Aak = Tm + 32 * LJ; bfr* Arb = Aak + 32 * LJ; bfr* Ark = Arb + 32 * LJ;
  bfr* ZT = Ark + 32 * LJ; bfr* UT = ZT + 64 * LJ; bfr* S0b = UT + 64 * LJ; bfr* OST = S0b + 64 * LK; bfr* VR = OST + 32 * LK;
  float* GC0 = (float*)(VR + 32 * LK); float* GC1 = GC0 + 64; float* TMPX = GC1 + 64; float* BONL = TMPX + 256;
  for (int i = tid; i < 4096; i += NTHR) {
    const int r = i >> 6, c = i & 63;
    w2T[c * LK + r] = f2bf(p.rwkv_w2[((size_t)(L * 2 + d) * 64 + r) * 512 + h * 64 + c]);
    a2T[c * LK + r] = f2bf(p.rwkv_a2[((size_t)(L * 2 + d) * 64 + r) * 512 + h * 64 + c]);
  }
  for (int i = tid; i < 64 * LK; i += NTHR) S0b[i] = 0;
  const int c4 = (tid & 15) * 4;
  const float4 a0v = *(const float4*)(p.rwkv_a0 + (L * 2 + d) * 512 + h * 64 + c4);
  const float4 kkv = *(const float4*)(p.rwkv_k_k + L * 512 + h * 64 + c4), kav = *(const float4*)(p.rwkv_k_a + L * 512 + h * 64 + c4), rkv = *(const float4*)(p.rwkv_r_k + L * 512 + h * 64 + c4);
  const int lr_mat = wave & 1, lr_ti = (wave >> 1) & 1, lr_tj = (wave >> 2) * 2;
  const float w0c0 = p.rwkv_w0[(L * 2 + d) * 512 + h * 64 + lr_tj * 16 + (lane & 15)], w0c1 = p.rwkv_w0[(L * 2 + d) * 512 + h * 64 + lr_tj * 16 + 16 + (lane & 15)];
  f32x4 Sm[4];
#pragma unroll
  for (int u = 0; u < 4; ++u) Sm[u] = f32x4{0.f, 0.f, 0.f, 0.f};
  uint4 pfA, pfB = make_uint4(0, 0, 0, 0), fw[2];
  const int tv = wave & 3;
  f32x4 p1[2], p2[2];
#define RW3_STAGE_LOWRANK() do { \
    { const int r_ = tid >> 4, g_ = tid & 15, i_ = d ? 31 - r_ : r_; *(uint4*)(RK + i_ * 128 + g_ * 8) = pfA; } \
    if (tid < 256) { const int r_ = tid >> 3, g_ = tid & 7, i_ = d ? 31 - r_ : r_; *(uint4*)(VR + i_ * LK + g_ * 8) = pfB; } \
    { const bfr* bm_ = (lr_mat ? a2T : w2T) + (lr_tj * 16 + (lane & 15)) * LK + (lane >> 4) * 8; \
      _Pragma("unroll") for (int q_ = 0; q_ < 2; ++q_) { \
        f32x4 cw_ = f32x4{0.f, 0.f, 0.f, 0.f}; \
        _Pragma("unroll") for (int ks_ = 0; ks_ < 2; ++ks_) \
          cw_ = __builtin_amdgcn_mfma_f32_16x16x32_bf16(__builtin_bit_cast(bf16x8, fw[ks_]), *(const bf16x8*)(bm_ + q_ * 16 * LK + 32 * ks_), cw_, 0, 0, 0); \
        _Pragma("unroll") for (int r_ = 0; r_ < 4; ++r_) { const int i_ = lr_ti * 16 + (lane >> 4) * 4 + r_, cc_ = (lr_tj + q_) * 16 + (lane & 15); \
          if (lr_mat) ARf[i_ * 64 + cc_] = cw_[r_]; else LWf[i_ * 64 + cc_] = -0.6065306597f * sigm(cw_[r_] + (q_ ? w0c1 : w0c0)); } } } } while (0)
#define RW3_VT(VTn, tl) do { const int v_ = (tl) & 63, iq_ = ((tl) >> 6) * 8; unsigned w_[4]; \
    _Pragma("unroll") for (int e_ = 0; e_ < 4; ++e_) w_[e_] = (unsigned)VR[(iq_ + 2 * e_) * LK + v_] | ((unsigned)VR[(iq_ + 2 * e_ + 1) * LK + v_] << 16); \
    *(uint4*)((VTn) + v_ * LJ + iq_) = make_uint4(w_[0], w_[1], w_[2], w_[3]); } while (0)
#define RW3_CUMSUM_TILE(GCn, id_) do { const int ti_ = (id_) >> 2, tj_ = (id_) & 3; \
      f32x4 gacc_ = f32x4{0.f, 0.f, 0.f, 0.f}; \
      _Pragma("unroll") for (int kb_ = 0; kb_ < 2; ++kb_) { if (kb_ <= ti_) { \
        _Pragma("unroll") for (int s4_ = 0; s4_ < 4; ++s4_) { const int kk2_ = 4 * s4_ + (lane >> 4); \
          const float av_ = (kb_ < ti_ || kk2_ <= (lane & 15)) ? 1.f : 0.f; const float bv_ = LWf[(kb_ * 16 + kk2_) * 64 + tj_ * 16 + (lane & 15)]; \
          gacc_ = __builtin_amdgcn_mfma_f32_16x16x4f32(av_, bv_, gacc_, 0, 0, 0); } } } \
      _Pragma("unroll") for (int r_ = 0; r_ < 4; ++r_) Gf[(ti_ * 16 + (lane >> 4) * 4 + r_) * 64 + tj_ * 16 + (lane & 15)] = gacc_[r_]; \
      if (ti_ == 1 && (lane >> 4) == 3) (GCn)[tj_ * 16 + (lane & 15)] = gacc_[3]; } while (0)
  rwkv3_prefetch(p, pfA, pfB, fw, 0, b, d, h);
  __syncthreads();
  RW3_STAGE_LOWRANK();
  rwkv3_prefetch(p, pfA, pfB, fw, 1, b, d, h);
  __syncthreads();
  RW3_CUMSUM_TILE(GC0, wave);
  if (wave >= 4) RW3_VT(VT0, tid - 256);
  __syncthreads();
  {
    int rb0, c0; chunk32_of_step(0, b, d, rb0, c0);
#define EW_I (tid >> 4)
#define EW_GC GC0
#define EW_RB rb0
#define EW_C c0
    {
      const int i = EW_I, t = d ? 31 - i : i;
      float rr[4], kk_[4];
      unpack4(*(const uint2*)(RK + i * 128 + c4), rr); unpack4(*(const uint2*)(RK + i * 128 + 64 + c4), kk_);
      const float4 g4 = *(const float4*)&Gf[i * 64 + c4], l4 = *(const float4*)&LWf[i * 64 + c4], ar4 = *(const float4*)&ARf[i * 64 + c4], gc4 = *(const float4*)&EW_GC[c4];
      const float gA[4] = {g4.x, g4.y, g4.z, g4.w}, lA[4] = {l4.x, l4.y, l4.z, l4.w}, arA[4] = {ar4.x, ar4.y, ar4.z, ar4.w}, gcA[4] = {gc4.x, gc4.y, gc4.z, gc4.w};
      const float a0A[4] = {a0v.x, a0v.y, a0v.z, a0v.w}, kkA[4] = {kkv.x, kkv.y, kkv.z, kkv.w}, kaA[4] = {kav.x, kav.y, kav.z, kav.w}, rkA[4] = {rkv.x, rkv.y, rkv.z, rkv.w};
      float a_[4], kraw[4], kd_[4]; float ss = 0.f;
#pragma unroll
      for (int e = 0; e < 4; ++e) { a_[e] = sigm(arA[e] + a0A[e]); kraw[e] = kk_[e] * kkA[e]; ss += kraw[e] * kraw[e]; kd_[e] = kk_[e] * (1.f + (a_[e] - 1.f) * kaA[e]); }
      ss = dpp_sum16(ss);
      const float rn = __builtin_amdgcn_rsqf(ss + EPS);
      float khv[4], rhv[4], bcv[4], kcv[4], btv[4], ktv[4]; float sb = 0.f;
#pragma unroll
      for (int e = 0; e < 4; ++e) {
        const float kn = kraw[e] * rn, bb = kn * a_[e];
        const float eI = __expf(gA[e]), eIm1 = __expf(gA[e] - lA[e]), eInv = __expf(-gA[e]), eC = __expf(gcA[e] - gA[e]);
        khv[e] = kn * eIm1; rhv[e] = rr[e] * eI; bcv[e] = bb * eInv; kcv[e] = kd_[e] * eInv;
        btv[e] = bb * eC; ktv[e] = kd_[e] * eC;
        sb += rr[e] * kd_[e] * rkA[e];
      }
      sb = dpp_sum16(sb);
      *(uint2*)(KH + i * LK + c4) = make_uint2(pack2(khv[0], khv[1]), pack2(khv[2], khv[3]));
      *(uint2*)(RH + i * LK + c4) = make_uint2(pack2(rhv[0], rhv[1]), pack2(rhv[2], rhv[3]));
      *(uint2*)(BC + i * LK + c4) = make_uint2(pack2(bcv[0], bcv[1]), pack2(bcv[2], bcv[3]));
      *(uint2*)(KC + i * LK + c4) = make_uint2(pack2(kcv[0], kcv[1]), pack2(kcv[2], kcv[3]));
      *(uint2*)(BR + i * LK + c4) = make_uint2(pack2(btv[0], btv[1]), pack2(btv[2], btv[3]));
      *(uint2*)(KR + i * LK + c4) = make_uint2(pack2(ktv[0], ktv[1]), pack2(ktv[2], ktv[3]));
      if ((tid & 15) == 0) p.bon[((size_t)d * T + EW_RB + EW_C * 32 + t) * 8 + h] = sb;
    }
#undef EW_I
#undef EW_GC
#undef EW_RB
#undef EW_C
  }
  __syncthreads();
#pragma unroll 1
  for (int step = 0; step < NCH; ++step) {
    int rb, c; chunk32_of_step(step, b, d, rb, c);
    bfr* VTc = (step & 1) ? VT1 : VT0; bfr* VTn = (step & 1) ? VT0 : VT1;
    float* GCc = (step & 1) ? GC1 : GC0; float* GCn = (step & 1) ? GC0 : GC1;
    const bool more = step + 1 < NCH;
    __builtin_amdgcn_s_waitcnt(0x0F70);
    if (more) RW3_STAGE_LOWRANK();
    if (step > 0 && lr_mat) {
      int rbp, cp; chunk32_of_step(step - 1, b, d, rbp, cp);
      const int tl = (wave >> 1) * 64 + lane, i = tl >> 3, c8 = (tl & 7) * 8, t = d ? 31 - i : i;
      *(uint4*)(p.O + (size_t)(rbp + cp * 32 + t) * OLD + d * 2048 + 2 * 512 + h * 64 + c8) = *(const uint4*)(OST + i * LK + c8);
      if (tl < 32) p.bon[((size_t)d * T + rb + c * 32 + tl) * 8 + h] = BONL[tl];
    }
    if (step + 2 < NCH) rwkv3_prefetch(p, pfA, pfB, fw, step + 2, b, d, h);
    __syncthreads();
    if (wave == 0) {
#pragma unroll
      for (int q = 0; q < 3; ++q) {
        const int ta = q >> 1 | (q & 1), tb = q >> 1;
        const f32x4 a = mma16<2>(KH + ta * 16 * LK, LK, BC + tb * 16 * LK, LK, f32x4{0.f, 0.f, 0.f, 0.f});
#pragma unroll
        for (int r = 0; r < 4; ++r) { const int t = ta * 16 + (lane >> 4) * 4 + r, j = tb * 16 + (lane & 15); Lf[t * LFS + j] = (j < t) ? a[r] : 0.f; }
      }
      asm volatile("s_waitcnt lgkmcnt(0)" ::: "memory");
      if (lane < 32) {
        const int blk = lane >> 4, cc = lane & 15;
        float x[16];
#pragma unroll
        for (int i = 0; i < 16; ++i) x[i] = (i == cc) ? 1.f : 0.f;
#pragma unroll
        for (int i = 1; i < 16; ++i) {
          const float* lr = Lf + (16 * blk + i) * LFS + 16 * blk;
#pragma unroll
          for (int j4 = 0; j4 < (i + 3) / 4; ++j4) {
            const float4 l4 = *(const float4*)(lr + 4 * j4);
            const float la[4] = {l4.x, l4.y, l4.z, l4.w};
#pragma unroll
            for (int e = 0; e < 4; ++e) if (4 * j4 + e < i) x[i] -= la[e] * x[4 * j4 + e];
          }
          asm volatile("" ::: "memory");
        }
#pragma unroll
        for (int i = 0; i < 16; ++i) Tf[(16 * blk + i) * LFS + 16 * blk + cc] = x[i];
      }
      asm volatile("s_waitcnt lgkmcnt(0)" ::: "memory");
      {
        const f32x4 xa = bmm16(Lf + 16 * LFS, LFS, Tf, LFS, f32x4{0.f, 0.f, 0.f, 0.f});
#pragma unroll
        for (int r = 0; r < 4; ++r) TMPX[((lane >> 4) * 4 + r) * 16 + (lane & 15)] = xa[r];
        asm volatile("s_waitcnt lgkmcnt(0)" ::: "memory");
        const f32x4 ta2 = bmm16(Tf + 16 * LFS + 16, LFS, TMPX, 16, f32x4{0.f, 0.f, 0.f, 0.f});
#pragma unroll
        for (int r = 0; r < 4; ++r) Tf[(16 + (lane >> 4) * 4 + r) * LFS + (lane & 15)] = -ta2[r];
      }
      asm volatile("s_waitcnt lgkmcnt(0)" ::: "memory");
#pragma unroll
      for (int q = 0; q < 4; ++q) {
        const int idx = lane + 64 * q, i = idx >> 3, j4 = (idx & 7) * 4;
        float tvv[4];
#pragma unroll
        for (int e = 0; e < 4; ++e) tvv[e] = ((j4 >> 4) <= (i >> 4)) ? Tf[i * LFS + j4 + e] : 0.f;
        *(uint2*)(Tm + i * LJ + j4) = make_uint2(pack2(tvv[0], tvv[1]), pack2(tvv[2], tvv[3]));
      }
    } else if (wave < 4) {
#pragma unroll
      for (int u = 0; u < 4; ++u) {
        const int id = (wave - 1) * 4 + u, prod = 1 + (id >> 2), ta = (id >> 1) & 1, tb = id & 1;
        f32x4 a = f32x4{0.f, 0.f, 0.f, 0.f};
        const bfr* Aop = (prod == 2) ? BC : KC; const bfr* Bop = (prod == 1) ? KH : RH;
        if (tb <= ta) a = mma16<2>(Aop + tb * 16 * LK, LK, Bop + ta * 16 * LK, LK, a);
        const int t = ta * 16 + (lane & 15), j0 = tb * 16 + (lane >> 4) * 4;
        float v4[4];
#pragma unroll
        for (int r = 0; r < 4; ++r) { const int j = j0 + r; v4[r] = ((prod == 1) ? (j < t) : (j <= t)) ? a[r] : 0.f; }
        bfr* Dst = (prod == 1) ? Aak : (prod == 2 ? Arb : Ark);
        *(uint2*)(Dst + t * LJ + j0) = make_uint2(pack2(v4[0], v4[1]), pack2(v4[2], v4[3]));
      }
    } else {
      {
        const int tl = tid - 256, k = tl & 63, iq = (tl >> 6) * 8;
        unsigned bw[4], kw[4];
#pragma unroll
        for (int e = 0; e < 4; ++e) {
          bw[e] = (unsigned)BR[(iq + 2 * e) * LK + k] | ((unsigned)BR[(iq + 2 * e + 1) * LK + k] << 16);
          kw[e] = (unsigned)KR[(iq + 2 * e) * LK + k] | ((unsigned)KR[(iq + 2 * e + 1) * LK + k] << 16);
        }
        *(uint4*)(BTt + k * LJ + iq) = make_uint4(bw[0], bw[1], bw[2], bw[3]);
        *(uint4*)(KTt + k * LJ + iq) = make_uint4(kw[0], kw[1], kw[2], kw[3]);
      }
#pragma unroll
      for (int ti = 0; ti < 2; ++ti) {
        p1[ti] = mma16<2>(KH + ti * 16 * LK, LK, S0b + tv * 16 * LK, LK, f32x4{0.f, 0.f, 0.f, 0.f});
        p2[ti] = mma16<2>(RH + ti * 16 * LK, LK, S0b + tv * 16 * LK, LK, f32x4{0.f, 0.f, 0.f, 0.f});
      }
    }
    if (more) {
      if (wave >= 1 && wave < 4) { RW3_CUMSUM_TILE(GCn, wave - 1); RW3_CUMSUM_TILE(GCn, wave + 2); if (wave < 3) RW3_CUMSUM_TILE(GCn, wave + 5); }
      if (wave >= 4) RW3_VT(VTn, tid - 256);
    }
    __syncthreads();
    if (wave >= 4) {
      const int vrow = (tv * 16 + (lane & 15)) * LJ + (lane >> 4) * 4;
#pragma unroll
      for (int ti = 0; ti < 2; ++ti) {
        const f32x4 z = mma16<1>(Aak + ti * 16 * LJ, LJ, VTc + tv * 16 * LJ, LJ, p1[ti]);
        *(uint2*)(ZT + vrow + ti * 16) = make_uint2(pack2(-z[0], -z[1]), pack2(-z[2], -z[3]));
      }
#pragma unroll
      for (int ti = 0; ti < 2; ++ti) {
        const f32x4 uu = mma16<1>(Tm + ti * 16 * LJ, LJ, ZT + tv * 16 * LJ, LJ, f32x4{0.f, 0.f, 0.f, 0.f});
        *(uint2*)(UT + vrow + ti * 16) = make_uint2(pack2(uu[0], uu[1]), pack2(uu[2], uu[3]));
      }
#pragma unroll
      for (int ti = 0; ti < 2; ++ti) {
        f32x4 o = mma16<1>(Arb + ti * 16 * LJ, LJ, UT + tv * 16 * LJ, LJ, p2[ti]);
        o = mma16<1>(Ark + ti * 16 * LJ, LJ, VTc + tv * 16 * LJ, LJ, o);
#pragma unroll
        for (int r = 0; r < 4; ++r) OST[(ti * 16 + (lane >> 4) * 4 + r) * LK + tv * 16 + (lane & 15)] = f2bf(o[r]);
      }
#pragma unroll
      for (int sk = 0; sk < 4; ++sk) {
        const float gcx = __expf(GCc[sk * 16 + (lane & 15)]);
        f32x4 sn = Sm[sk] * gcx;
        sn = mma16<1>(UT + tv * 16 * LJ, LJ, BTt + sk * 16 * LJ, LJ, sn);
        sn = mma16<1>(VTc + tv * 16 * LJ, LJ, KTt + sk * 16 * LJ, LJ, sn);
        Sm[sk] = sn;
#pragma unroll
        for (int r = 0; r < 4; ++r) S0b[(tv * 16 + (lane >> 4) * 4 + r) * LK + sk * 16 + (lane & 15)] = f2bf(sn[r]);
      }
    }
    if (wave < 4 && more) {
      int rbn, cn; chunk32_of_step(step + 1, b, d, rbn, cn);
#pragma unroll 1
      for (int pass = 0; pass < 2; ++pass) {
#define EW_I ((tid >> 4) + 16 * pass)
#define EW_GC GCn
#define EW_RB rbn
#define EW_C cn
    {
      const int i = EW_I, t = d ? 31 - i : i;
      float rr[4], kk_[4];
      unpack4(*(const uint2*)(RK + i * 128 + c4), rr); unpack4(*(const uint2*)(RK + i * 128 + 64 + c4), kk_);
      const float4 g4 = *(const float4*)&Gf[i * 64 + c4], l4 = *(const float4*)&LWf[i * 64 + c4], ar4 = *(const float4*)&ARf[i * 64 + c4], gc4 = *(const float4*)&EW_GC[c4];
      const float gA[4] = {g4.x, g4.y, g4.z, g4.w}, lA[4] = {l4.x, l4.y, l4.z, l4.w}, arA[4] = {ar4.x, ar4.y, ar4.z, ar4.w}, gcA[4] = {gc4.x, gc4.y, gc4.z, gc4.w};
      const float a0A[4] = {a0v.x, a0v.y, a0v.z, a0v.w}, kkA[4] = {kkv.x, kkv.y, kkv.z, kkv.w}, kaA[4] = {kav.x, kav.y, kav.z, kav.w}, rkA[4] = {rkv.x, rkv.y, rkv.z, rkv.w};
      float a_[4], kraw[4], kd_[4]; float ss = 0.f;
#pragma unroll
      for (int e = 0; e < 4; ++e) { a_[e] = sigm(arA[e] + a0A[e]); kraw[e] = kk_[e] * kkA[e]; ss += kraw[e] * kraw[e]; kd_[e] = kk_[e] * (1.f + (a_[e] - 1.f) * kaA[e]); }
      ss = dpp_sum16(ss);
      const float rn = __builtin_amdgcn_rsqf(ss + EPS);
      float khv[4], rhv[4], bcv[4], kcv[4], btv[4], ktv[4]; float sb = 0.f;
#pragma unroll
      for (int e = 0; e < 4; ++e) {
        const float kn = kraw[e] * rn, bb = kn * a_[e];
        const float eI = __expf(gA[e]), eIm1 = __expf(gA[e] - lA[e]), eInv = __expf(-gA[e]), eC = __expf(gcA[e] - gA[e]);
        khv[e] = kn * eIm1; rhv[e] = rr[e] * eI; bcv[e] = bb * eInv; kcv[e] = kd_[e] * eInv;
        btv[e] = bb * eC; ktv[e] = kd_[e] * eC;
        sb += rr[e] * kd_[e] * rkA[e];
      }
      sb = dpp_sum16(sb);
      *(uint2*)(KH + i * LK + c4) = make_uint2(pack2(khv[0], khv[1]), pack2(khv[2], khv[3]));
      *(uint2*)(RH + i * LK + c4) = make_uint2(pack2(rhv[0], rhv[1]), pack2(rhv[2], rhv[3]));
      *(uint2*)(BC + i * LK + c4) = make_uint2(pack2(bcv[0], bcv[1]), pack2(bcv[2], bcv[3]));
      *(uint2*)(KC + i * LK + c4) = make_uint2(pack2(kcv[0], kcv[1]), pack2(kcv[2], kcv[3]));
      *(uint2*)(BR + i * LK + c4) = make_uint2(pack2(btv[0], btv[1]), pack2(btv[2], btv[3]));
      *(uint2*)(KR + i * LK + c4) = make_uint2(pack2(ktv[0], ktv[1]), pack2(ktv[2], ktv[3]));
      if ((tid & 15) == 0) BONL[t] = sb;
    }
#undef EW_I
#undef EW_GC
#undef EW_RB
#undef EW_C
      }
    }
    __syncthreads();
  }
  if (tid < 256) {
    int rb, c; chunk32_of_step(NCH - 1, b, d, rb, c);
    const int i = tid >> 3, c8 = (tid & 7) * 8, t = d ? 31 - i : i;
    *(uint4*)(p.O + (size_t)(rb + c * 32 + t) * OLD + d * 2048 + 2 * 512 + h * 64 + c8) = *(const uint4*)(OST + i * LK + c8);
  }
#undef RW3_STAGE_LOWRANK
#undef RW3_CUMSUM_TILE
#undef RW3_VT
}

DEVINL void ssm_prefetch(const Params& p, uint4& pf0, uint4& pf1, uint4& pf2, float& dtraw, int step, int b, int d, int h) {
  int rb, len, c; chunk_of_step(step, b, d, rb, len, c);
  const int tid = threadIdx.x, r = tid >> 3, g8 = (tid & 7) * 8, gq = h >> 2;
  const bfr* base = p.P + (size_t)(rb + c * 64 + r) * NINP + C_SSM + 512 + g8;
  pf0 = *(const uint4*)(base + h * 64); pf1 = *(const uint4*)(base + 512 + gq * 64); pf2 = *(const uint4*)(base + 640 + gq * 64);
  if (tid < 64) { const int t = c * 64 + (d ? 63 - tid : tid); dtraw = bf2f(p.P[(size_t)(rb + t) * NINP + C_SSM + 1280 + d * 8 + h]); }
}
template <int L>
DEVINL void scan_ssm2(const Params& p, int item, char* sm) {
  const int d = item & 1, h = (item >> 1) & 7, b = item >> 4;
  const int tid = threadIdx.x, lane = tid & 63, wave = tid >> 6;
  constexpr int LB = 72;
  bfr* Qm = (bfr*)sm; bfr* Qg = Qm + 64 * LB; bfr* Km = Qg + 64 * LB; bfr* K2T = Km + 64 * LB; bfr* VT = K2T + 64 * LB; bfr* SCm = VT + 64 * LB; bfr* ST = SCm + 64 * LB; bfr* OST = ST + 64 * LB;
  float* gsv = (float*)(OST + 64 * LB); float* dtv = gsv + 64;
  for (int i = tid; i < 64 * LB; i += NTHR) ST[i] = 0;
  const float dtb = p.ssm_dt_bias[L * 16 + d * 8 + h], Aneg = -__expf(p.ssm_a_log[L * 16 + d * 8 + h]);
  f32x4 Sm[2] = {f32x4{0.f, 0.f, 0.f, 0.f}, f32x4{0.f, 0.f, 0.f, 0.f}};
  uint4 pf0, pf1, pf2; float dtraw = 0.f;
  ssm_prefetch(p, pf0, pf1, pf2, dtraw, 0, b, d, h);
#pragma unroll 1
  for (int step = 0; step < 68; ++step) {
    int rb, len, c; chunk_of_step(step, b, d, rb, len, c);
    __syncthreads();
    if (tid < 64) {
      const float dt = softplus(dtraw + dtb);
      float la = dt * Aneg;
#pragma unroll
      for (int o = 1; o < 64; o <<= 1) { const float n = __shfl_up(la, o); if (tid >= o) la += n; }
      gsv[tid] = la; dtv[tid] = dt;
    }
    __syncthreads();
    const float g63 = gsv[63];
    {
      const int r = tid >> 3, g = tid & 7, i = d ? 63 - r : r;
      float y[8];
      unpack8(pf0, y);
#pragma unroll
      for (int e = 0; e < 8; ++e) VT[(g * 8 + e) * LB + i] = f2bf(y[e]);
      unpack8(pf1, y);
      const float dt = dtv[i], e2 = __expf(g63 - gsv[i]);
#pragma unroll
      for (int e = 0; e < 8; ++e) y[e] *= dt;
      *(uint4*)(Km + i * LB + g * 8) = make_uint4(pack2(y[0], y[1]), pack2(y[2], y[3]), pack2(y[4], y[5]), pack2(y[6], y[7]));
#pragma unroll
      for (int e = 0; e < 8; ++e) K2T[(g * 8 + e) * LB + i] = f2bf(y[e] * e2);
      unpack8(pf2, y);
      const float eg = __expf(gsv[i]);
      *(uint4*)(Qm + i * LB + g * 8) = pf2;
      *(uint4*)(Qg + i * LB + g * 8) = make_uint4(pack2(y[0] * eg, y[1] * eg), pack2(y[2] * eg, y[3] * eg), pack2(y[4] * eg, y[5] * eg), pack2(y[6] * eg, y[7] * eg));
    }
    __syncthreads();
    if (step + 1 < 68) ssm_prefetch(p, pf0, pf1, pf2, dtraw, step + 1, b, d, h);
#pragma unroll
    for (int u = 0; u < 2; ++u) {
      const int id = 2 * wave + u, ti = id >> 2, tj = id & 3;
      f32x4 a = f32x4{0.f, 0.f, 0.f, 0.f};
      if (tj <= ti) a = mma16<2>(Qm + ti * 16 * LB, LB, Km + tj * 16 * LB, LB, a);
#pragma unroll
      for (int r = 0; r < 4; ++r) {
        const int i = ti * 16 + (lane >> 4) * 4 + r, j = tj * 16 + (lane & 15);
        SCm[i * LB + j] = (j <= i) ? f2bf(a[r] * __expf(gsv[i] - gsv[j])) : (bfr)0;
      }
    }
    __syncthreads();
    const float sd = __expf(g63);
#pragma unroll
    for (int u = 0; u < 2; ++u) {
      const int id = 2 * wave + u, ti = id >> 2, tp = id & 3;
      f32x4 o = mma16<2>(SCm + ti * 16 * LB, LB, VT + tp * 16 * LB, LB, f32x4{0.f, 0.f, 0.f, 0.f});
      o = mma16<2>(Qg + ti * 16 * LB, LB, ST + tp * 16 * LB, LB, o);
#pragma unroll
      for (int r = 0; r < 4; ++r) OST[(ti * 16 + (lane >> 4) * 4 + r) * LB + tp * 16 + (lane & 15)] = f2bf(o[r]);
      Sm[u] = mma16<2>(K2T + ti * 16 * LB, LB, VT + tp * 16 * LB, LB, Sm[u] * sd);
    }
    __syncthreads();
#pragma unroll
    for (int u = 0; u < 2; ++u) {
      const int id = 2 * wave + u, tn = id >> 2, tp = id & 3;
      *(uint2*)(ST + (tp * 16 + (lane & 15)) * LB + tn * 16 + (lane >> 4) * 4) = make_uint2(pack2(Sm[u][0], Sm[u][1]), pack2(Sm[u][2], Sm[u][3]));
    }
    {
      const int i = tid >> 3, c8 = (tid & 7) * 8, t = d ? 63 - i : i;
      *(uint4*)(p.O + (size_t)(rb + c * 64 + t) * OLD + d * 2048 + 0 * 512 + h * 64 + c8) = *(const uint4*)(OST + i * LB + c8);
    }
  }
}

DEVINL void gla_prefetch(const Params& p, uint4 (&pf)[5], int step, int b, int d, int h) {
  int rb, len, c; chunk_of_step(step, b, d, rb, len, c);
#pragma unroll
  for (int q = 0; q < 5; ++q) {
    const int idx = threadIdx.x + NTHR * q;
    uint4 v = make_uint4(0, 0, 0, 0);
    if (idx < 64 * 34) {
      const int r = idx / 34, qq = idx % 34;
      const int col = qq < 8 ? h * 64 + qq * 8 : (qq < 16 ? 256 + h * 64 + (qq - 8) * 8 : (qq < 32 ? 512 + h * 128 + (qq - 16) * 8 : 1536 + d * 16 + (qq - 32) * 8));
      v = *(const uint4*)(p.P + (size_t)(rb + c * 64 + r) * NINP + C_GLA + col);
    }
    pf[q] = v;
  }
}
template <int L>
DEVINL void scan_gla2(const Params& p, int item, char* sm) {
  const int d = item & 1, h = (item >> 1) & 3, b = item >> 3;
  const int tid = threadIdx.x, lane = tid & 63, wave = tid >> 6;
  constexpr int LB = 72, LO = 136, LR = 272;
  bfr* Qg = (bfr*)sm; bfr* Kn = Qg + 64 * LB; bfr* K2T = Kn + 64 * LB; bfr* SCm = K2T + 64 * LB; bfr* VT = SCm + 64 * LB; bfr* ST = VT + 128 * LB; bfr* OST = ST + 128 * LB;
  bfr* RAWG = OST + 64 * LO;
  float* SEG = (float*)(RAWG + 64 * LR);
  float* sdec = SEG + 512;
  for (int i = tid; i < 128 * LB; i += NTHR) ST[i] = 0;
  float w2r[16];
  const int kch = tid & 63;
#pragma unroll
  for (int r = 0; r < 16; ++r) w2r[r] = p.gla_w2[((size_t)(L * 2 + d) * 16 + r) * 256 + h * 64 + kch];
  const float bk = p.gla_b[(L * 2 + d) * 256 + h * 64 + kch];
  f32x4 Sm[4];
#pragma unroll
  for (int u = 0; u < 4; ++u) Sm[u] = f32x4{0.f, 0.f, 0.f, 0.f};
  uint4 pf[5];
  gla_prefetch(p, pf, 0, b, d, h);
#pragma unroll 1
  for (int step = 0; step < 68; ++step) {
    int rb, len, c; chunk_of_step(step, b, d, rb, len, c);
    __syncthreads();
#pragma unroll
    for (int q = 0; q < 5; ++q) { const int idx = tid + NTHR * q; if (idx < 64 * 34) *(uint4*)(RAWG + (idx / 34) * LR + (idx % 34) * 8) = pf[q]; }
    __syncthreads();
    if (step + 1 < 68) gla_prefetch(p, pf, step + 1, b, d, h);
    float gl[8];
    {
      float run = 0.f;
#pragma unroll
      for (int q = 0; q < 8; ++q) {
        const int i = 8 * wave + q, t = d ? 63 - i : i;
        float gr[8]; float lg = bk;
        unpack8(*(const uint4*)(RAWG + t * LR + 256), gr);
#pragma unroll
        for (int r = 0; r < 8; ++r) lg += gr[r] * w2r[r];
        unpack8(*(const uint4*)(RAWG + t * LR + 264), gr);
#pragma unroll
        for (int r = 0; r < 8; ++r) lg += gr[r] * w2r[8 + r];
        run += -softplus(-lg) * (1.f / 16.f);
        gl[q] = run;
      }
      SEG[wave * 64 + kch] = run;
    }
    __syncthreads();
    {
      float pre = 0.f, tot = 0.f;
#pragma unroll
      for (int w = 0; w < 8; ++w) { const float sv = SEG[w * 64 + kch]; tot += sv; if (w < wave) pre += sv; }
      float k2v[8];
#pragma unroll
      for (int q = 0; q < 8; ++q) {
        const int i = 8 * wave + q, t = d ? 63 - i : i;
        const float gg = gl[q] + pre;
        const float qv = bf2f(RAWG[t * LR + kch]), kv = bf2f(RAWG[t * LR + 64 + kch]);
        Qg[i * LB + kch] = f2bf(qv * 0.125f * __expf(gg)); Kn[i * LB + kch] = f2bf(kv * __expf(-gg)); k2v[q] = kv * __expf(tot - gg);
      }
      *(uint4*)(K2T + kch * LB + 8 * wave) = make_uint4(pack2(k2v[0], k2v[1]), pack2(k2v[2], k2v[3]), pack2(k2v[4], k2v[5]), pack2(k2v[6], k2v[7]));
      if (wave == 0) sdec[kch] = __expf(tot);
      const int pp = tid & 127, i0 = (tid >> 7) * 16;
      float vv[16];
#pragma unroll
      for (int q = 0; q < 16; ++q) { const int i = i0 + q, t = d ? 63 - i : i; vv[q] = bf2f(RAWG[t * LR + 128 + pp]); }
      *(uint4*)(VT + pp * LB + i0) = make_uint4(pack2(vv[0], vv[1]), pack2(vv[2], vv[3]), pack2(vv[4], vv[5]), pack2(vv[6], vv[7]));
      *(uint4*)(VT + pp * LB + i0 + 8) = make_uint4(pack2(vv[8], vv[9]), pack2(vv[10], vv[11]), pack2(vv[12], vv[13]), pack2(vv[14], vv[15]));
    }
    __syncthreads();
#pragma unroll
    for (int u = 0; u < 2; ++u) {
      const int id = 2 * wave + u, ti = id >> 2, tj = id & 3;
      f32x4 a = f32x4{0.f, 0.f, 0.f, 0.f};
      if (tj <= ti) a = mma16<2>(Qg + ti * 16 * LB, LB, Kn + tj * 16 * LB, LB, a);
#pragma unroll
      for (int r = 0; r < 4; ++r) {
        const int i = ti * 16 + (lane >> 4) * 4 + r, j = tj * 16 + (lane & 15);
        SCm[i * LB + j] = (j <= i) ? f2bf(a[r]) : (bfr)0;
      }
    }
    __syncthreads();
#pragma unroll
    for (int u = 0; u < 4; ++u) {
      const int id = 4 * wave + u, ti = id >> 3, tp = id & 7;
      f32x4 o = mma16<2>(SCm + ti * 16 * LB, LB, VT + tp * 16 * LB, LB, f32x4{0.f, 0.f, 0.f, 0.f});
      o = mma16<2>(Qg + ti * 16 * LB, LB, ST + tp * 16 * LB, LB, o);
#pragma unroll
      for (int r = 0; r < 4; ++r) OST[(ti * 16 + (lane >> 4) * 4 + r) * LO + tp * 16 + (lane & 15)] = f2bf(o[r]);
      f32x4 sdv;
#pragma unroll
      for (int r = 0; r < 4; ++r) sdv[r] = sdec[ti * 16 + (lane >> 4) * 4 + r];
      Sm[u] = mma16<2>(K2T + ti * 16 * LB, LB, VT + tp * 16 * LB, LB, Sm[u] * sdv);
    }
    __syncthreads();
#pragma unroll
    for (int u = 0; u < 4; ++u) {
      const int id = 4 * wave + u, tk = id >> 3, tp = id & 7;
      *(uint2*)(ST + (tp * 16 + (lane & 15)) * LB + tk * 16 + (lane >> 4) * 4) = make_uint2(pack2(Sm[u][0], Sm[u][1]), pack2(Sm[u][2], Sm[u][3]));
    }
    {
      const int i = tid >> 3, t = d ? 63 - i : i;
#pragma unroll
      for (int q = 0; q < 2; ++q) {
        const int c8 = (tid & 7) * 8 + q * 64;
        *(uint4*)(p.O + (size_t)(rb + c * 64 + t) * OLD + d * 2048 + 1 * 512 + h * 128 + c8) = *(const uint4*)(OST + i * LO + c8);
      }
    }
  }
}


DEVINL void gdn_prefetch(const Params& p, uint4& pf0, uint4& pf1, uint4& pf2, uint4& pf3, uint4& pf4, bfr& araw, bfr& braw, int step, int b, int d, int h, int vh) {
  int rb, len, c; chunk_of_step(step, b, d, rb, len, c);
  const int tid = threadIdx.x;
  const bfr* base = p.P + (size_t)(rb + c * 64) * NINP + C_GDN;
  { const int r = tid >> 4, g = tid & 15;
    pf0 = *(const uint4*)(base + (size_t)r * NINP + h * 128 + g * 8); pf1 = *(const uint4*)(base + (size_t)(r + 32) * NINP + h * 128 + g * 8);
    pf2 = *(const uint4*)(base + (size_t)r * NINP + 512 + h * 128 + g * 8); pf3 = *(const uint4*)(base + (size_t)(r + 32) * NINP + 512 + h * 128 + g * 8); }
  { const int r = tid >> 3, g = tid & 7; pf4 = *(const uint4*)(base + (size_t)r * NINP + 1024 + h * 128 + vh * 64 + g * 8); }
  if (tid >= 64 && tid < 128) {
    const int tl = tid - 64, t = c * 64 + (d ? 63 - tl : tl);
    const bfr* pr = p.P + (size_t)(rb + t) * NINP + C_GDN;
    araw = pr[2048 + d * 4 + h]; braw = pr[2056 + d * 4 + h];
  }
}
template <int L>
DEVINL void scan_gdn2(const Params& p, int item, char* sm) {
  const int vh = item & 1, d = (item >> 1) & 1, h = (item >> 2) & 3, b = item >> 4;
  const int tid = threadIdx.x, lane = tid & 63, wave = __builtin_amdgcn_readfirstlane(tid >> 6);
  constexpr int LQ = 136, LB = 72, LF = 68;
  bfr* QN = (bfr*)sm; bfr* KN = QN + 64 * LQ; bfr* U0 = KN + 64 * LQ; bfr* KdT = U0 + 64 * LB; bfr* Tm = KdT + 128 * LB; bfr* ATm = Tm + 64 * LB; bfr* ST = ATm + 64 * LB;
  float* SMALL = (float*)(ST + 64 * LQ);
  float* TMPX = SMALL + 512;
  bfr* ZT = (bfr*)(TMPX + 6 * 256);
  char* REG = (char*)(ZT + 64 * LB);
  float* Lf = (float*)REG; float* Tf = Lf + 64 * LF;
  bfr* VnT = (bfr*)REG; bfr* OST = VnT + 64 * LB;
  for (int i = tid; i < 64 * LQ; i += NTHR) ST[i] = 0;
  const float Aneg = -__expf(p.gdn_a_log[L * 8 + d * 4 + h]), dtb = p.gdn_dt_bias[L * 8 + d * 4 + h];
  f32x4 Sm[4];
#pragma unroll
  for (int u = 0; u < 4; ++u) Sm[u] = f32x4{0.f, 0.f, 0.f, 0.f};
  uint4 pf0, pf1, pf2, pf3, pf4; bfr araw = 0, braw = 0;
  gdn_prefetch(p, pf0, pf1, pf2, pf3, pf4, araw, braw, 0, b, d, h, vh);
#define GDN_GBETA(DST) do { \
    float g_ = Aneg * softplus(bf2f(araw) + dtb); const float beta_ = sigm(bf2f(braw)); \
    _Pragma("unroll") for (int o_ = 1; o_ < 64; o_ <<= 1) { const float n_ = __shfl_up(g_, o_); if (lane >= o_) g_ += n_; } \
    const float g63_ = __shfl(g_, 63); \
    (DST)[lane] = g_; (DST)[64 + lane] = beta_; (DST)[128 + lane] = __expf(g63_ - g_); (DST)[192 + lane] = __expf(g_); } while (0)
  if (wave == 1) GDN_GBETA(SMALL);
  __syncthreads();
#pragma unroll 1
  for (int step = 0; step < 68; ++step) {
    int rb, len, c; chunk_of_step(step, b, d, rb, len, c);
    float* Gs = SMALL + (step & 1) * 256; float* Bts = Gs + 64; float* EK = Bts + 64; float* EG = EK + 64;
    float* SMn = SMALL + ((step + 1) & 1) * 256;
    __builtin_amdgcn_s_waitcnt(0x0F70);
    {
      const int r = tid >> 4, g = tid & 15, i0 = d ? 63 - r : r, i1 = d ? 31 - r : r + 32;
      *(uint4*)(QN + i0 * LQ + g * 8) = pf0; *(uint4*)(QN + i1 * LQ + g * 8) = pf1;
      *(uint4*)(KN + i0 * LQ + g * 8) = pf2; *(uint4*)(KN + i1 * LQ + g * 8) = pf3;
    }
    {
      const int r = tid >> 3, g = tid & 7, i = d ? 63 - r : r;
      float y[8]; unpack8(pf4, y);
      const float bt = Bts[i];
      *(uint4*)(U0 + i * LB + g * 8) = make_uint4(pack2(y[0] * bt, y[1] * bt), pack2(y[2] * bt, y[3] * bt), pack2(y[4] * bt, y[5] * bt), pack2(y[6] * bt, y[7] * bt));
    }
    if (step > 0) {
      int rbp, lenp, cp; chunk_of_step(step - 1, b, d, rbp, lenp, cp);
      const int i = tid >> 3, c8 = (tid & 7) * 8, t = d ? 63 - i : i;
      *(uint4*)(p.O + (size_t)(rbp + cp * 64 + t) * OLD + d * 2048 + 3 * 512 + h * 128 + vh * 64 + c8) = *(const uint4*)(OST + i * LB + c8);
    }
    if (step + 1 < 68) gdn_prefetch(p, pf0, pf1, pf2, pf3, pf4, araw, braw, step + 1, b, d, h, vh);
    __syncthreads();
    {
      const int k = tid & 127, jq = (tid >> 7) * 16;
      float v[16];
#pragma unroll
      for (int q = 0; q < 16; ++q) v[q] = bf2f(KN[(jq + q) * LQ + k]) * EK[jq + q];
      *(uint4*)(KdT + k * LB + jq) = make_uint4(pack2(v[0], v[1]), pack2(v[2], v[3]), pack2(v[4], v[5]), pack2(v[6], v[7]));
      *(uint4*)(KdT + k * LB + jq + 8) = make_uint4(pack2(v[8], v[9]), pack2(v[10], v[11]), pack2(v[12], v[13]), pack2(v[14], v[15]));
    }
#pragma unroll 1
    for (int u = 0; u < 4; ++u) {
      const int id = 4 * wave + u;
      if (id < 16) {
        const int ti = id >> 2, tj = id & 3;
        if (tj <= ti) {
          const f32x4 a = mma16<4>(KN + ti * 16 * LQ, LQ, KN + tj * 16 * LQ, LQ, f32x4{0.f, 0.f, 0.f, 0.f});
#pragma unroll
          for (int r = 0; r < 4; ++r) {
            const int i = ti * 16 + (lane >> 4) * 4 + r, j = tj * 16 + (lane & 15);
            Lf[i * LF + j] = (j < i) ? a[r] * __expf(Gs[i] - Gs[j]) * Bts[i] : 0.f;
          }
        }
      } else {
        const int ti = (id - 16) >> 2, tj = (id - 16) & 3;
        f32x4 a = f32x4{0.f, 0.f, 0.f, 0.f};
        if (tj <= ti) a = mma16<4>(KN + tj * 16 * LQ, LQ, QN + ti * 16 * LQ, LQ, a);
        const int i = ti * 16 + (lane & 15), j0 = tj * 16 + (lane >> 4) * 4;
        float v4[4];
#pragma unroll
        for (int r = 0; r < 4; ++r) { const int j = j0 + r; v4[r] = (j <= i) ? a[r] * __expf(Gs[i] - Gs[j]) : 0.f; }
        *(uint2*)(ATm + i * LB + j0) = make_uint2(pack2(v4[0], v4[1]), pack2(v4[2], v4[3]));
      }
    }
    __syncthreads();
    f32x4 o1[4];
    if (wave == 1) { if (step + 1 < 68) GDN_GBETA(SMn); }
    else if (wave >= 4) {
#pragma unroll
      for (int u = 0; u < 4; ++u) {
        const int id = 4 * (wave - 4) + u, ti = id >> 2, tv = id & 3;
        const f32x4 y = mma16<4>(KN + ti * 16 * LQ, LQ, ST + tv * 16 * LQ, LQ, f32x4{0.f, 0.f, 0.f, 0.f});
        f32x4 q1 = mma16<4>(QN + ti * 16 * LQ, LQ, ST + tv * 16 * LQ, LQ, f32x4{0.f, 0.f, 0.f, 0.f});
        const int i0 = ti * 16 + (lane >> 4) * 4, v = tv * 16 + (lane & 15);
        float z[4];
#pragma unroll
        for (int r = 0; r < 4; ++r) { const int i = i0 + r; const float eg = EG[i]; z[r] = bf2f(U0[i * LB + v]) - Bts[i] * eg * y[r]; q1[r] *= eg; }
        o1[u] = q1;
        *(uint2*)(ZT + v * LB + i0) = make_uint2(pack2(z[0], z[1]), pack2(z[2], z[3]));
        asm volatile("" ::: "memory");
      }
    }
    if (wave == 0) {
      const int blk = lane >> 4, cc = lane & 15;
      float x[16];
#pragma unroll
      for (int i = 0; i < 16; ++i) x[i] = (i == cc) ? 1.f : 0.f;
#pragma unroll
      for (int i = 1; i < 16; ++i) {
        const float* lr = Lf + (16 * blk + i) * LF + 16 * blk;
#pragma unroll
        for (int j4 = 0; j4 < (i + 3) / 4; ++j4) {
          const float4 l4 = *(const float4*)(lr + 4 * j4);
          const float la[4] = {l4.x, l4.y, l4.z, l4.w};
#pragma unroll
          for (int e = 0; e < 4; ++e) if (4 * j4 + e < i) x[i] -= la[e] * x[4 * j4 + e];
        }
        asm volatile("" ::: "memory");
      }
#pragma unroll
      for (int i = 0; i < 16; ++i) Tf[(16 * blk + i) * LF + 16 * blk + cc] = x[i];
    }
    __syncthreads();
    if (wave < 3) {
      const int bi = wave + 1, bj = wave;
      f32x4 xa = bmm16(Lf + 16 * bi * LF + 16 * bj, LF, Tf + 16 * bj * LF + 16 * bj, LF, f32x4{0.f, 0.f, 0.f, 0.f});
      float* X = TMPX + wave * 256;
#pragma unroll
      for (int r = 0; r < 4; ++r) X[((lane >> 4) * 4 + r) * 16 + (lane & 15)] = xa[r];
      asm volatile("s_waitcnt lgkmcnt(0)" ::: "memory");
      const f32x4 ta = bmm16(Tf + 16 * bi * LF + 16 * bi, LF, X, 16, f32x4{0.f, 0.f, 0.f, 0.f});
#pragma unroll
      for (int r = 0; r < 4; ++r) Tf[(16 * bi + (lane >> 4) * 4 + r) * LF + 16 * bj + (lane & 15)] = -ta[r];
    }
    __syncthreads();
    if (wave < 2) {
      const int bi = wave + 2, bj = wave;
      f32x4 xa = bmm16(Lf + 16 * bi * LF + 16 * bj, LF, Tf + 16 * bj * LF + 16 * bj, LF, f32x4{0.f, 0.f, 0.f, 0.f});
      xa = bmm16(Lf + 16 * bi * LF + 16 * (bj + 1), LF, Tf + 16 * (bj + 1) * LF + 16 * bj, LF, xa);
      float* X = TMPX + (3 + wave) * 256;
#pragma unroll
      for (int r = 0; r < 4; ++r) X[((lane >> 4) * 4 + r) * 16 + (lane & 15)] = xa[r];
      asm volatile("s_waitcnt lgkmcnt(0)" ::: "memory");
      const f32x4 ta = bmm16(Tf + 16 * bi * LF + 16 * bi, LF, X, 16, f32x4{0.f, 0.f, 0.f, 0.f});
#pragma unroll
      for (int r = 0; r < 4; ++r) Tf[(16 * bi + (lane >> 4) * 4 + r) * LF + 16 * bj + (lane & 15)] = -ta[r];
    }
    __syncthreads();
    if (wave == 0) {
      f32x4 xa = bmm16(Lf + 48 * LF, LF, Tf, LF, f32x4{0.f, 0.f, 0.f, 0.f});
      xa = bmm16(Lf + 48 * LF + 16, LF, Tf + 16 * LF, LF, xa);
      xa = bmm16(Lf + 48 * LF + 32, LF, Tf + 32 * LF, LF, xa);
      float* X = TMPX + 5 * 256;
#pragma unroll
      for (int r = 0; r < 4; ++r) X[((lane >> 4) * 4 + r) * 16 + (lane & 15)] = xa[r];
      asm volatile("s_waitcnt lgkmcnt(0)" ::: "memory");
      const f32x4 ta = bmm16(Tf + 48 * LF + 48, LF, X, 16, f32x4{0.f, 0.f, 0.f, 0.f});
#pragma unroll
      for (int r = 0; r < 4; ++r) Tf[(48 + (lane >> 4) * 4 + r) * LF + (lane & 15)] = -ta[r];
    }
    __syncthreads();
    for (int idx = tid; idx < 64 * 16; idx += NTHR) {
      const int i = idx >> 4, j4 = (idx & 15) * 4;
      float tv[4];
#pragma unroll
      for (int e = 0; e < 4; ++e) tv[e] = ((j4 >> 4) <= (i >> 4)) ? Tf[i * LF + j4 + e] : 0.f;
      *(uint2*)(Tm + i * LB + j4) = make_uint2(pack2(tv[0], tv[1]), pack2(tv[2], tv[3]));
    }
    __syncthreads();
#pragma unroll
    for (int u = 0; u < 2; ++u) {
      const int id = 2 * wave + u, ti = id >> 2, tv = id & 3;
      const f32x4 vn = mma16<2>(Tm + ti * 16 * LB, LB, ZT + tv * 16 * LB, LB, f32x4{0.f, 0.f, 0.f, 0.f});
      *(uint2*)(VnT + (tv * 16 + (lane & 15)) * LB + ti * 16 + (lane >> 4) * 4) = make_uint2(pack2(vn[0], vn[1]), pack2(vn[2], vn[3]));
    }
    __syncthreads();
    {
      const float gl = __expf(Gs[63]);
      if (wave >= 4) {
#pragma unroll
        for (int u = 0; u < 4; ++u) {
          const int id = 4 * (wave - 4) + u, ti = id >> 2, tv = id & 3;
          const f32x4 o = mma16<2>(ATm + ti * 16 * LB, LB, VnT + tv * 16 * LB, LB, o1[u]);
#pragma unroll
          for (int r = 0; r < 4; ++r) OST[(ti * 16 + (lane >> 4) * 4 + r) * LB + tv * 16 + (lane & 15)] = f2bf(o[r]);
        }
      }
#pragma unroll
      for (int u = 0; u < 4; ++u) {
        const int id = 4 * wave + u, tk = id >> 2, tv = id & 3;
        Sm[u] = mma16<2>(KdT + tk * 16 * LB, LB, VnT + tv * 16 * LB, LB, Sm[u] * gl);
        *(uint2*)(ST + (tv * 16 + (lane & 15)) * LQ + tk * 16 + (lane >> 4) * 4) = make_uint2(pack2(Sm[u][0], Sm[u][1]), pack2(Sm[u][2], Sm[u][3]));
        asm volatile("" ::: "memory");
      }
    }
    __syncthreads();
  }
  {
    int rb, len, c; chunk_of_step(67, b, d, rb, len, c);
    const int i = tid >> 3, c8 = (tid & 7) * 8, t = d ? 63 - i : i;
    *(uint4*)(p.O + (size_t)(rb + c * 64 + t) * OLD + d * 2048 + 3 * 512 + h * 128 + vh * 64 + c8) = *(const uint4*)(OST + i * LB + c8);
  }
#undef GDN_GBETA
}

template <int L> DEVINL void phase_gproj(const Params& p, char* sm, int c);
template <int L>
DEVINL void phase_scans(const Params& p, char* sm) {
  const int it = blockIdx.x;
  if (it < 64) scan_rwkv3<L>(p, it, sm);
  else if (it < 128) scan_gdn2<L>(p, it - 64, sm);
  else if (it < 192) scan_ssm2<L>(p, it - 128, sm);
  else if (it < 224) scan_gla2<L>(p, it - 192, sm);
  else {
    phase_gproj<L>(p, sm, it - 224);
  }
}

template <int L>
DEVINL void phase_post2(const Params& p) {
  const int lane = threadIdx.x & 63, wave = threadIdx.x >> 6;
  const int nrows = (L == 1) ? TL : T;
  const int c8 = lane * 8;
  float pw_ssm[8], pw_gla[8], pw_lnw[8], pw_lnb[8], pw_gdn[8];
#pragma unroll
  for (int e = 0; e < 8; ++e) {
    pw_ssm[e] = p.ssm_norm[L * 512 + c8 + e]; pw_gla[e] = p.gla_norm[L * 128 + ((c8 + e) & 127)]; pw_lnw[e] = p.rwkv_ln_w[L * 512 + c8 + e];
    pw_lnb[e] = p.rwkv_ln_b[L * 512 + c8 + e]; pw_gdn[e] = p.gdn_norm[L * 128 + ((c8 + e) & 127)];
  }
  const float dssm = p.ssm_d[L * 8 + (lane >> 3)];
  for (int R = blockIdx.x * 8 + wave; R < nrows; R += gridDim.x * 8) {
    const bool lat = R < TL; const int vvb = lat ? (R >> 12) : 4;
    bfr* orow = p.O + (size_t)R * OLD; const bfr* prow = p.P + (size_t)R * NINP;
    uint4 of_[4], ob_[4];
#pragma unroll
    for (int m = 0; m < 4; ++m) { of_[m] = *(const uint4*)(orow + m * 512 + c8); ob_[m] = *(const uint4*)(orow + 2048 + m * 512 + c8); }
    const uint4 pxh = *(const uint4*)(prow + C_SSM + 512 + c8), pz = *(const uint4*)(prow + C_SSM + c8), prg = *(const uint4*)(prow + C_GLA + 1024 + c8);
    const uint4 pv = *(const uint4*)(prow + C_RWKV + 1024 + c8), pzg = *(const uint4*)(prow + C_GDN + 1536 + c8), pgg = *(const uint4*)(p.Gb + (size_t)R * 512 + c8);
    const int cr = lat ? canon_row(L, R) : R;
    const float* xp = lat ? p.out + (size_t)cr * D : p.xc + (size_t)(R - TL) * D;
    float4 xv[4];
#pragma unroll
    for (int q = 0; q < 4; ++q) xv[q] = *(const float4*)(xp + q * 256 + lane * 4);
    const float bsum = p.bon[((size_t)0 * T + R) * 8 + (lane >> 3)] + p.bon[((size_t)1 * T + R) * 8 + (lane >> 3)];
    float a[8], b[8], t1[8], t2[8];
    float y0[8]; float ss0 = 0.f;
    unpack8(of_[0], a); unpack8(ob_[0], b); unpack8(pxh, t1); unpack8(pz, t2);
#pragma unroll
    for (int e = 0; e < 8; ++e) { y0[e] = (a[e] + b[e] + dssm * t1[e]) * silu(t2[e]); ss0 += y0[e] * y0[e]; }
    ss0 = dpp_sum16(ss0); ss0 += __shfl_xor(ss0, 16);
    float y1[8]; float ss1 = 0.f;
    unpack8(of_[1], a); unpack8(ob_[1], b); unpack8(prg, t1);
#pragma unroll
    for (int e = 0; e < 8; ++e) { y1[e] = a[e] + b[e]; ss1 += y1[e] * y1[e]; }
    ss1 = dpp_sum16(ss1);
    const float r1 = __builtin_amdgcn_rsqf(ss1 * (1.f / 128.f) + EPS);
#pragma unroll
    for (int e = 0; e < 8; ++e) y1[e] = y1[e] * r1 * pw_gla[e] * silu(t1[e]);
    float y2[8]; float s2 = 0.f;
    unpack8(of_[2], a); unpack8(ob_[2], b); unpack8(pv, t1); unpack8(pgg, t2);
#pragma unroll
    for (int e = 0; e < 8; ++e) { y2[e] = a[e] + b[e]; s2 += y2[e]; }
    const float mu = dpp_sum8(s2) * (1.f / 64.f);
    float v2 = 0.f;
#pragma unroll
    for (int e = 0; e < 8; ++e) { y2[e] -= mu; v2 += y2[e] * y2[e]; }
    const float r2 = __builtin_amdgcn_rsqf(dpp_sum8(v2) * (1.f / 64.f) + 64e-5f);
#pragma unroll
    for (int e = 0; e < 8; ++e) y2[e] = (y2[e] * r2 * pw_lnw[e] + pw_lnb[e] + bsum * t1[e]) * t2[e];
    float y3[8]; float ss3 = 0.f;
    unpack8(of_[3], a); unpack8(ob_[3], b); unpack8(pzg, t1);
#pragma unroll
    for (int e = 0; e < 8; ++e) { y3[e] = a[e] + b[e]; ss3 += y3[e] * y3[e]; }
    ss3 = dpp_sum16(ss3);
    const float r3 = __builtin_amdgcn_rsqf(ss3 * (1.f / 128.f) + EPS);
#pragma unroll
    for (int e = 0; e < 8; ++e) y3[e] = y3[e] * r3 * pw_gdn[e] * silu(t1[e]);
    const float r0 = __builtin_amdgcn_rsqf(ss0 * (1.f / 256.f) + EPS);
#pragma unroll
    for (int e = 0; e < 8; ++e) y0[e] = y0[e] * r0 * pw_ssm[e];
    float xs = 0.f;
#pragma unroll
    for (int q = 0; q < 4; ++q) xs += xv[q].x * xv[q].x + xv[q].y * xv[q].y + xv[q].z * xv[q].z + xv[q].w * xv[q].w;
    xs = wave_sum(xs);
    const float rs = __builtin_amdgcn_rsqf(xs * (1.f / 1024.f) + EPS);
    const float* md = p.mod + ((size_t)L * 5 + vvb) * 6144;
    *(uint4*)(orow + 0 * 512 + c8) = make_uint4(pack2(y0[0], y0[1]), pack2(y0[2], y0[3]), pack2(y0[4], y0[5]), pack2(y0[6], y0[7]));
    *(uint4*)(orow + 1 * 512 + c8) = make_uint4(pack2(y1[0], y1[1]), pack2(y1[2], y1[3]), pack2(y1[4], y1[5]), pack2(y1[6], y1[7]));
    *(uint4*)(orow + 2 * 512 + c8) = make_uint4(pack2(y2[0], y2[1]), pack2(y2[2], y2[3]), pack2(y2[4], y2[5]), pack2(y2[6], y2[7]));
    *(uint4*)(orow + 3 * 512 + c8) = make_uint4(pack2(y3[0], y3[1]), pack2(y3[2], y3[3]), pack2(y3[4], y3[5]), pack2(y3[6], y3[7]));
#pragma unroll
    for (int q = 0; q < 4; ++q) {
      const int j = q * 256 + lane * 4;
      const float4 nw = *(const float4*)(p.norm_mix + L * D + j), sh = *(const float4*)(md + j), scl = *(const float4*)(md + 1024 + j);
      const float h0 = xv[q].x * rs * nw.x * (1.f + scl.x) + sh.x, h1 = xv[q].y * rs * nw.y * (1.f + scl.y) + sh.y;
      const float h2 = xv[q].z * rs * nw.z * (1.f + scl.z) + sh.z, h3 = xv[q].w * rs * nw.w * (1.f + scl.w) + sh.w;
      *(uint2*)(orow + 2048 + j) = make_uint2(pack2(h0, h1), pack2(h2, h3));
    }
  }
}

template <int L>
DEVINL void phase_route(const Params& p, char* sm) {
  const int tid = threadIdx.x, lane = tid & 63, wave = tid >> 6;
  float* rw = (float*)sm;
  __syncthreads();
  for (int i = tid; i < 1024 * 16; i += NTHR) rw[(i & 15) * 1024 + (i >> 4)] = p.router_w[i];
  __syncthreads();
  const int ntok = (L == 1) ? TL : T;
  for (int tk = blockIdx.x * 8 + wave; tk < ntok; tk += gridDim.x * 8) {
    const bool lat = tk < TL;
    const int vv = lat ? (tk >> 12) : 4;
    const float* xp = lat ? p.out + (size_t)tk * D : p.xc + (size_t)(tk - TL) * D;
    float ss = 0.f;
#pragma unroll
    for (int q = 0; q < 4; ++q) {
      const float4 xv = *(const float4*)(xp + q * 256 + lane * 4);
      ss += xv.x * xv.x + xv.y * xv.y + xv.z * xv.z + xv.w * xv.w;
    }
    ss = wave_sum(ss);
    const float rs = rsqrtf(ss * (1.f / 1024.f) + EPS);
    const float* md = p.mod + ((size_t)L * 5 + vv) * 6144;
    float lg[16];
#pragma unroll
    for (int e = 0; e < 16; ++e) lg[e] = 0.f;
#pragma unroll 1
    for (int q = 0; q < 4; ++q) {
      const int j = q * 256 + lane * 4;
      const float4 xv = *(const float4*)(xp + j);
      const float4 nw = *(const float4*)(p.norm_ffn + L * D + j), sh = *(const float4*)(md + 3 * 1024 + j), scl = *(const float4*)(md + 4 * 1024 + j);
      float hv[4];
      hv[0] = xv.x * rs * nw.x * (1.f + scl.x) + sh.x; hv[1] = xv.y * rs * nw.y * (1.f + scl.y) + sh.y;
      hv[2] = xv.z * rs * nw.z * (1.f + scl.z) + sh.z; hv[3] = xv.w * rs * nw.w * (1.f + scl.w) + sh.w;
      uint2 o; o.x = (unsigned)f2bf(hv[0]) | ((unsigned)f2bf(hv[1]) << 16); o.y = (unsigned)f2bf(hv[2]) | ((unsigned)f2bf(hv[3]) << 16);
      *(uint2*)(p.HF + (size_t)tk * D + j) = o;
#pragma unroll
      for (int e = 0; e < 16; ++e) {
        const float4 r4 = *(const float4*)&rw[e * 1024 + j];
        lg[e] += hv[0] * r4.x + hv[1] * r4.y + hv[2] * r4.z + hv[3] * r4.w;
      }
    }
    {
      float sel = 0.f;
#pragma unroll
      for (int e = 0; e < 16; ++e) { const float rsum = dpp_sum16(lg[e]); sel = ((lane & 15) == e) ? rsum : sel; }
      sel += __shfl_xor(sel, 16); sel += __shfl_xor(sel, 32);
#pragma unroll
      for (int e = 0; e < 16; ++e) lg[e] = __int_as_float(__builtin_amdgcn_readlane(__float_as_int(sel), e));
    }
    if (lane == 0) {
      float sc[16], sel[16];
#pragma unroll
      for (int e = 0; e < 16; ++e) { sc[e] = sigm(lg[e]); sel[e] = sc[e] + p.router_b[e]; }
      int bg = 0; float bgs = -1e30f;
#pragma unroll
      for (int g = 0; g < 4; ++g) {
        float m1 = -1e30f, m2 = -1e30f;
#pragma unroll
        for (int u = 0; u < 4; ++u) { const float s = sel[g * 4 + u]; if (s > m1) { m2 = m1; m1 = s; } else if (s > m2) m2 = s; }
        const float gs = m1 + m2;
        if (gs > bgs) { bgs = gs; bg = g; }
      }
      int i1 = 0, i2 = 0; float m1 = -1e30f, m2 = -1e30f;
#pragma unroll
      for (int u = 0; u < 4; ++u) {
        float s = 0.f, c2 = 0.f;
#pragma unroll
        for (int g = 0; g < 4; ++g) if (g == bg) { s = sel[g * 4 + u]; }
        (void)c2;
        if (s > m1) { m2 = m1; i2 = i1; m1 = s; i1 = u; } else if (s > m2) { m2 = s; i2 = u; }
      }
      const int e1 = bg * 4 + i1, e2 = bg * 4 + i2;
      float s1 = 0.f, s2 = 0.f;
#pragma unroll
      for (int e = 0; e < 16; ++e) { if (e == e1) s1 = sc[e]; if (e == e2) s2 = sc[e]; }
      const float inv = 1.f / (s1 + s2);
      const int p1 = atomicAdd(&p.cnt[L * 16 + e1], 1), p2 = atomicAdd(&p.cnt[L * 16 + e2], 1);
      p.list[(size_t)e1 * T + p1] = tk * 2; p.list[(size_t)e2 * T + p2] = tk * 2 + 1;
      p.gatew[tk * 2] = s1 * inv; p.gatew[tk * 2 + 1] = s2 * inv;
    }
  }
}

namespace g8 {
DEVINL uint4 pack8(const f32x4& a, const f32x4& b) { return make_uint4(pack2(a[0], a[1]), pack2(a[2], a[3]), pack2(b[0], b[1]), pack2(b[2], b[3])); }
struct EpiP {
  static constexpr bool PERM = true;
  bfr* C; int ldc; int act;
  DEVINL void operator()(const Acc& acc, const Unit& u, int wr, int wc, int fr, int fq) const {
    const int row0 = u.pm * 256 + wr * 64 + fr, col0 = u.pn * 256 + wc * 32 + 8 * fq;
#pragma unroll
    for (int ai = 0; ai < 2; ++ai)
#pragma unroll
      for (int m = 0; m < 4; ++m) {
        bfr* rowp = C + (size_t)(row0 + ai * 128 + m * 16) * ldc + col0;
#pragma unroll
        for (int bj = 0; bj < 2; ++bj) {
          f32x4 v0 = acc[ai][bj][m][0], v1 = acc[ai][bj][m][1];
          if (act) {
#pragma unroll
            for (int j = 0; j < 4; ++j) { v0[j] = sigm(v0[j]); v1[j] = sigm(v1[j]); }
          }
          *(uint4*)(rowp + bj * 128) = pack8(v0, v1);
        }
      }
  }
};
struct EpiBranch {
  static constexpr bool PERM = true;
  bfr* ACC; const bfr* GATES;
  DEVINL void operator()(const Acc& acc, const Unit& u, int wr, int wc, int fr, int fq) const {
    const int row0 = u.pm * 256 + wr * 64 + fr, col0 = u.pn * 256 + wc * 32 + 8 * fq;
#pragma unroll
    for (int ai = 0; ai < 2; ++ai) {
      uint4 gq[4][2], pq[4][2];
#pragma unroll
      for (int m = 0; m < 4; ++m)
#pragma unroll
        for (int bj = 0; bj < 2; ++bj) {
          const size_t row = (size_t)(row0 + ai * 128 + m * 16); const int col = col0 + bj * 128;
          gq[m][bj] = *(const uint4*)(GATES + row * 4096 + u.e * 1024 + col);
          pq[m][bj] = u.e ? *(const uint4*)(ACC + row * 1024 + col) : make_uint4(0, 0, 0, 0);
        }
#pragma unroll
      for (int m = 0; m < 4; ++m)
#pragma unroll
        for (int bj = 0; bj < 2; ++bj) {
          const size_t row = (size_t)(row0 + ai * 128 + m * 16); const int col = col0 + bj * 128;
          float gt[8], pv[8];
          unpack8(gq[m][bj], gt); unpack8(pq[m][bj], pv);
          f32x4 v0, v1;
#pragma unroll
          for (int j = 0; j < 4; ++j) { v0[j] = pv[j] + gt[j] * acc[ai][bj][m][0][j]; v1[j] = pv[4 + j] + gt[4 + j] * acc[ai][bj][m][1][j]; }
          *(uint4*)(ACC + row * 1024 + col) = pack8(v0, v1);
        }
    }
  }
};
struct EpiOut {
  static constexpr bool PERM = false;
  float* xlat; float* xctx; const float* mod; int layer;
  DEVINL void operator()(const Acc& acc, const Unit& u, int wr, int wc, int fr, int fq) const {
    const int row0 = u.pm * 256 + wr * 64 + fr, col0 = u.pn * 256 + wc * 32 + 4 * fq;
#pragma unroll
    for (int ai = 0; ai < 2; ++ai) {
      float4 xq[4][2][2];
      float* xpp[4];
      const float* m2p = nullptr;
#pragma unroll
      for (int m = 0; m < 4; ++m) {
        const int R = row0 + ai * 128 + m * 16;
        const bool lat = R < TL;
        xpp[m] = lat ? xlat + (size_t)canon_row(layer, R) * D : xctx + (size_t)(R - TL) * D;
        if (m == 0) m2p = mod + ((size_t)layer * 5 + (lat ? (R >> 12) : 4)) * 6144 + 2 * 1024;
#pragma unroll
        for (int bj = 0; bj < 2; ++bj)
#pragma unroll
          for (int n = 0; n < 2; ++n) xq[m][bj][n] = *(const float4*)(xpp[m] + col0 + bj * 128 + n * 16);
      }
      float4 mq[2][2];
#pragma unroll
      for (int bj = 0; bj < 2; ++bj)
#pragma unroll
        for (int n = 0; n < 2; ++n) mq[bj][n] = *(const float4*)(m2p + col0 + bj * 128 + n * 16);
#pragma unroll
      for (int m = 0; m < 4; ++m)
#pragma unroll
        for (int bj = 0; bj < 2; ++bj)
#pragma unroll
          for (int n = 0; n < 2; ++n) {
            float4 xv = xq[m][bj][n]; const float4 mv = mq[bj][n]; const f32x4 a = acc[ai][bj][m][n];
            xv.x += mv.x * a[0]; xv.y += mv.y * a[1]; xv.z += mv.z * a[2]; xv.w += mv.w * a[3];
            *(float4*)(xpp[m] + col0 + bj * 128 + n * 16) = xv;
          }
    }
  }
};
struct EpiMoeUp {
  static constexpr bool PERM = true;
  bfr* HB; const int* list; const int* cnt;
  DEVINL void operator()(const Acc& acc, const Unit& u, int wr, int wc, int fr, int fq) const {
    const int ce = cnt[u.e];
#pragma unroll
    for (int ai = 0; ai < 2; ++ai) {
      int en[4];
#pragma unroll
      for (int m = 0; m < 4; ++m) { const int ei = u.pm * 256 + ai * 128 + wr * 64 + m * 16 + fr; en[m] = ei < ce ? list[(size_t)u.e * T + ei] : -1; }
#pragma unroll
      for (int m = 0; m < 4; ++m) {
        if (en[m] >= 0) {
          f32x4 v0, v1;
#pragma unroll
          for (int j = 0; j < 4; ++j) { v0[j] = silu(acc[ai][0][m][0][j]) * acc[ai][1][m][0][j]; v1[j] = silu(acc[ai][0][m][1][j]) * acc[ai][1][m][1][j]; }
          *(uint4*)(HB + (size_t)en[m] * 512 + u.pn * 128 + wc * 32 + 8 * fq) = pack8(v0, v1);
        }
      }
    }
  }
};
struct EpiMoeDown {
  static constexpr bool PERM = true;
  bfr* YS; const int* list; const int* cnt; const float* gatew;
  DEVINL void operator()(const Acc& acc, const Unit& u, int wr, int wc, int fr, int fq) const {
    const int ce = cnt[u.e];
#pragma unroll
    for (int ai = 0; ai < 2; ++ai) {
      int en[4]; float gw[4];
#pragma unroll
      for (int m = 0; m < 4; ++m) { const int ei = u.pm * 256 + ai * 128 + wr * 64 + m * 16 + fr; en[m] = ei < ce ? list[(size_t)u.e * T + ei] : -1; }
#pragma unroll
      for (int m = 0; m < 4; ++m) gw[m] = en[m] >= 0 ? gatew[en[m]] : 0.f;
#pragma unroll
      for (int m = 0; m < 4; ++m) {
        if (en[m] >= 0) {
          bfr* yp = YS + (size_t)(en[m] & 1) * T * D + (size_t)(en[m] >> 1) * D + u.pn * 256 + wc * 32 + 8 * fq;
#pragma unroll
          for (int bj = 0; bj < 2; ++bj) *(uint4*)(yp + bj * 128) = pack8(acc[ai][bj][m][0] * gw[m], acc[ai][bj][m][1] * gw[m]);
        }
      }
    }
  }
};
}

template <int L>
DEVINL void phase_gproj(const Params& p, char* sm, int c) {
  g8::TileSched S; S.init(L == 1 ? 64 : 68, 2); S.G = 32; S.c = c;
  g8::EpiP E{p.Gb, 512, 0};
  g8::RowAddr aA{NINP, 0, 0u}, aB{256, 1, 0u};
  g8::gemm8((LAS unsigned char*)sm, (const char*)(p.P + C_RWKV + 1792), (const char*)p.g2T, 256, S, E, aA, aB);
}
template <int L>
DEVINL void phase_gemm_in8(const Params& p, char* sm) {
  g8::TileSched S; S.init(T / 256, NINP / 256);
  g8::EpiP E{p.P, NINP, 0};
  g8::RowAddr aA{OLD, 0, 0u}, aB{D, 1, 0u};
  g8::gemm8(( LAS unsigned char*)sm, (const char*)(p.O + 2048), (const char*)p.WinT, D, S, E, aA, aB);
  if (L == 0 && blockIdx.x >= 44) {
    __syncthreads();
    convert_range<false>(p, 0, 1728 + blockIdx.x - 44, CONV_L_ITEMS, gridDim.x - 44, sm);
  }
}
template <int L>
DEVINL void phase_gates8(const Params& p, char* sm) {
  g8::TileSched S; S.init(L == 1 ? 64 : 68, 16);
  g8::EpiP E{p.GATES, 4096, 1};
  g8::RowAddr aA{OLD, 0, 0u}, aB{D, 1, 0u};
  g8::gemm8((LAS unsigned char*)sm, (const char*)(p.O + 2048), (const char*)p.WgT, D, S, E, aA, aB);
  __syncthreads();
  if (L == 1) convert_range<true>(p, L, blockIdx.x, 2048, gridDim.x, sm);
}
template <int L>
DEVINL void phase_branch8(const Params& p, char* sm) {
  g8::MergeSched S; S.init(L == 1 ? 64 : 68);
  g8::EpiBranch E{p.ACC, p.GATES};
  g8::RowAddr aA{OLD, 0, 512u * 2u}, aB{512, 1, (unsigned)(D * 512 * 2)};
  g8::gemm8((LAS unsigned char*)sm, (const char*)p.O, (const char*)p.WbT, 512, S, E, aA, aB);
  __syncthreads();
  if (L == 1) convert_range<true>(p, L, 2048 + blockIdx.x, 4096, gridDim.x, sm);
  else if (blockIdx.x >= 16) convert_range<true>(p, L, blockIdx.x - 16, CONV_M_ITEMS, gridDim.x - 16, sm);
}
template <int L>
DEVINL void phase_out8(const Params& p, char* sm) {
  g8::TileSched S; S.init(L == 1 ? 64 : 68, 4);
  g8::EpiOut E{p.out, p.xc, p.mod, L};
  g8::RowAddr aA{D, 0, 0u}, aB{D, 1, 0u};
  g8::gemm8((LAS unsigned char*)sm, (const char*)p.ACC, (const char*)p.WoT, D, S, E, aA, aB);
  __syncthreads();
  if (L == 0 && blockIdx.x >= 16) convert_range<false>(p, 1, blockIdx.x - 16, 3264, gridDim.x - 16, sm);
}
template <int L>
DEVINL void phase_moe_up8(const Params& p, char* sm) {
  const int* cnt = p.cnt + L * 16;
  g8::MoeSched S{cnt, 4, (int)gridDim.x, (int)blockIdx.x, 0};
  g8::EpiMoeUp E{p.HB, p.list, cnt};
  g8::GatherAddr aA{p.list, cnt, D * 2, 1};
  g8::RowAddr aB{D, 1, (unsigned)(D * D * 2)};
  g8::gemm8((LAS unsigned char*)sm, (const char*)p.HF, (const char*)p.WmguT, D, S, E, aA, aB);
  {
    int U = 0;
#pragma unroll 1
    for (int e = 0; e < 16; ++e) U += ((cnt[e] + 255) >> 8) * 4;
    const int G = gridDim.x, r = U % G, nl = G - r, c = blockIdx.x;
    const int first = (nl >= 64) ? c - r : c, stride = (nl >= 64) ? nl : G;
    __syncthreads();
    if (first >= 0) {
      if (L == 0) convert_range<false>(p, 1, 3264 + first, CONV_L_ITEMS, stride, sm);
      else convert_range<true>(p, L, 4096 + first, CONV_M_ITEMS, stride, sm);
    }
  }
}
template <int L>
DEVINL void phase_moe_down8(const Params& p, char* sm) {
  const int* cnt = p.cnt + L * 16;
  g8::MoeSched S{cnt, 4, (int)gridDim.x, (int)blockIdx.x, 0};
  g8::EpiMoeDown E{p.YS, p.list, cnt, p.gatew};
  g8::GatherAddr aA{p.list, cnt, 512 * 2, 0};
  g8::RowAddr aB{512, 1, (unsigned)(D * 512 * 2)};
  g8::gemm8((LAS unsigned char*)sm, (const char*)p.HB, (const char*)p.WmdT, 512, S, E, aA, aB);
}

DEVINL void phase_final(const Params& p) {
  const int lane = threadIdx.x & 63, wave = threadIdx.x >> 6;
  for (int tk = blockIdx.x * 8 + wave; tk < TL; tk += gridDim.x * 8) {
    float* xp = p.out + (size_t)tk * D;
    const int vv = tk >> 12;
    float v[16]; float ss = 0.f;
#pragma unroll
    for (int q = 0; q < 4; ++q) {
      const int j = q * 256 + lane * 4;
      float4 xv = *(const float4*)(xp + j);
      const float4 m5 = *(const float4*)(p.mod + ((size_t)1 * 5 + vv) * 6144 + 5 * 1024 + j);
      const uint2 y0 = *(const uint2*)(p.YS + (size_t)tk * D + j), y1 = *(const uint2*)(p.YS + (size_t)T * D + (size_t)tk * D + j);
      xv.x += m5.x * (bf2f(y0.x & 0xFFFF) + bf2f(y1.x & 0xFFFF)); xv.y += m5.y * (bf2f(y0.x >> 16) + bf2f(y1.x >> 16));
      xv.z += m5.z * (bf2f(y0.y & 0xFFFF) + bf2f(y1.y & 0xFFFF)); xv.w += m5.w * (bf2f(y0.y >> 16) + bf2f(y1.y >> 16));
      v[q * 4] = xv.x; v[q * 4 + 1] = xv.y; v[q * 4 + 2] = xv.z; v[q * 4 + 3] = xv.w;
      ss += xv.x * xv.x + xv.y * xv.y + xv.z * xv.z + xv.w * xv.w;
    }
    ss = wave_sum(ss);
    const float rs = rsqrtf(ss * (1.f / 1024.f) + EPS);
#pragma unroll
    for (int q = 0; q < 4; ++q) {
      const int j = q * 256 + lane * 4;
      const float4 fw = *(const float4*)(p.final_norm + j);
      *(float4*)(xp + j) = make_float4(v[q * 4] * rs * fw.x, v[q * 4 + 1] * rs * fw.y, v[q * 4 + 2] * rs * fw.z, v[q * 4 + 3] * rs * fw.w);
    }
  }
}

constexpr int NPHASE = 24;

template <int L>
DEVINL void layer_phases(const Params& p, const XcdBarrier& bar, char* sm, int ph0, int ph1) {
  constexpr int B0 = 1 + 11 * L;
#define PH(id, call) { if (ph0 <= (id) && (id) < ph1) { call; } if (ph0 <= (id) && (id) + 1 < ph1) xcd_barrier(bar); }
  PH(B0 + 0, phase_norm1<L>(p))
  PH(B0 + 1, phase_gemm_in8<L>(p, sm))
  PH(B0 + 2, phase_prep<L>(p, sm))
  PH(B0 + 3, phase_scans<L>(p, sm))
  PH(B0 + 4, phase_post2<L>(p))
  PH(B0 + 5, phase_gates8<L>(p, sm))
  PH(B0 + 6, phase_branch8<L>(p, sm))
  PH(B0 + 7, phase_out8<L>(p, sm))
  PH(B0 + 8, phase_route<L>(p, sm))
  PH(B0 + 9, phase_moe_up8<L>(p, sm))
  PH(B0 + 10, phase_moe_down8<L>(p, sm))
}

__global__ void __launch_bounds__(NTHR, 2) mega(Params p, unsigned* barw, int ph0, int ph1) {
  extern __shared__ __attribute__((aligned(16))) char smem[];
  if (threadIdx.x == 0) *(uint4*)smem = make_uint4(0u, 0u, 0u, 0u);
  __syncthreads();
  XcdBarrier bar = xcd_barrier_post(barw, (volatile LAS unsigned*)smem);
  char* sm = smem + 16;
  PH(0, phase_prologue(p, sm))
  layer_phases<0>(p, bar, sm, ph0, ph1);
  layer_phases<1>(p, bar, sm, ph0, ph1);
  if (ph0 <= 23 && 23 < ph1) phase_final(p);
}

}

extern "C" void kernel_launch(void* const* d_in, const int* in_sizes, int n_in, void* d_out, int out_size, void* d_ws, size_t ws_size, hipStream_t stream) {
  (void)in_sizes; (void)n_in; (void)out_size;
  static int inited = 0;
  if (!inited) {
    if (hipFuncSetAttribute((const void*)mega, hipFuncAttributeMaxDynamicSharedMemorySize, LDS_BYTES) != hipSuccess) fprintf(stderr, "hipFuncSetAttribute failed\n");
    int per_cu = 0;
    if (hipOccupancyMaxActiveBlocksPerMultiprocessor(&per_cu, (const void*)mega, NTHR, LDS_BYTES) != hipSuccess || per_cu < 1) fprintf(stderr, "occupancy query: %d\n", per_cu);
    inited = 1;
  }
  Params p{};
  const float** f = (const float**)&p;
  for (int i = 0; i < 42; ++i) f[i] = (const float*)d_in[i];
  p.out = (float*)d_out;
  char* w = (char*)d_ws;
  size_t off = 0;
  auto take = [&](size_t bytes) { char* r = w + off; off += (bytes + 255) & ~(size_t)255; return r; };
  unsigned* barw = (unsigned*)take(65536);
  p.cnt = (int*)(barw + 4 * XCD_BAR_WORDS);
  p.xc = (float*)take((size_t)TC * D * 4);
  p.mod = (float*)take((size_t)2 * 5 * 6144 * 4);
  p.bon = (float*)take((size_t)2 * T * 8 * 4);
  p.list = (int*)take((size_t)16 * T * 4);
  p.gatew = (float*)take((size_t)2 * T * 4);
  p.WinT = (bfr*)take((size_t)NINP * D * 2);
  p.WgT = (bfr*)take((size_t)4 * D * D * 2);
  p.WbT = (bfr*)take((size_t)4 * D * 512 * 2);
  p.WoT = (bfr*)take((size_t)D * D * 2);
  p.Gb = (bfr*)take((size_t)T * 512 * 2);
  p.g2T = (bfr*)take((size_t)512 * 256 * 2);
  p.O = (bfr*)take((size_t)T * OLD * 2);
  p.P = (bfr*)take((size_t)T * NINP * 2);
  {
    bfr* q = p.P;
    p.ACC = q; q += (size_t)T * D;
    p.GATES = q;
    p.HF = q; q += (size_t)T * D;
    p.HB = q; q += (size_t)2 * T * 512;
    p.YS = q; q += (size_t)2 * T * D;
    p.WmguT = q; q += (size_t)16 * D * D;
    p.WmdT = q; q += (size_t)16 * D * 512;
  }
  if (off > ws_size) { fprintf(stderr, "workspace too small: need %zu have %zu\n", off, ws_size); return; }
  hipMemsetAsync(barw, 0, 65536, stream);
#if MK_SINGLE
  hipLaunchKernelGGL(mega, dim3(256), dim3(NTHR), LDS_BYTES, stream, p, barw, 0, NPHASE);
#else
  for (int ph = 0; ph < NPHASE; ++ph) hipLaunchKernelGGL(mega, dim3(256), dim3(NTHR), LDS_BYTES, stream, p, barw, ph, ph + 1);
#endif
}
```

```cpp
#include <hip/hip_runtime.h>
#include <stdint.h>
#include <cstdio>

#ifndef MK_SINGLE
#define MK_SINGLE 1
#endif

namespace {

typedef unsigned short bfr;
typedef short bf16x8 __attribute__((ext_vector_type(8)));
typedef float f32x4 __attribute__((ext_vector_type(4)));
typedef float f32x2 __attribute__((ext_vector_type(2)));
typedef __bf16 bf16x2v __attribute__((ext_vector_type(2)));
#define DEVINL __device__ __forceinline__
#define LAS __attribute__((address_space(3)))

constexpr int D = 1024, NB = 4, SEQ = 4096, CTXL = 256;
constexpr int TL = NB * SEQ, TC = NB * CTXL, T = TL + TC;
constexpr int NIN = 6848, NINP = 6912, OLD = 4096;
constexpr int C_SSM = 0, C_GLA = 1296, C_RWKV = 2864, C_GDN = 4784;
constexpr int NTHR = 512;
constexpr int LDS_BYTES = 155648;
constexpr float EPS = 1e-6f;

struct Params {
  const float *x, *c, *ctx, *c_ctx, *ada_w, *ada_b, *norm_mix, *norm_ffn, *w_in, *w_gate, *w_branch, *w_out;
  const float *ssm_conv_w, *ssm_conv_b, *ssm_a_log, *ssm_dt_bias, *ssm_d, *ssm_norm;
  const float *gla_w2, *gla_b, *gla_norm;
  const float *rwkv_mu, *rwkv_w0, *rwkv_w2, *rwkv_a0, *rwkv_a2, *rwkv_g2, *rwkv_k_k, *rwkv_k_a, *rwkv_r_k, *rwkv_ln_w, *rwkv_ln_b;
  const float *gdn_conv_w, *gdn_a_log, *gdn_dt_bias, *gdn_norm;
  const float *router_w, *router_b, *moe_w_gate, *moe_w_up, *moe_w_down, *final_norm;
  float* out;
  float* xc;
  float* mod;
  bfr* O;
  bfr* P;
  bfr *WinT, *WgT, *WbT, *WoT;
  float* bon;
  int* cnt;
  int* list;
  float* gatew;
  bfr *ACC, *GATES, *HF, *HB, *YS, *WmguT, *WmdT;
  bfr *Gb, *g2T;
};

DEVINL float bf2f(bfr v) { return __uint_as_float(((unsigned)v) << 16); }
DEVINL bfr f2bf(float f) { return __builtin_bit_cast(bfr, (__bf16)f); }
DEVINL unsigned pack2(float a, float b) { f32x2 v = {a, b}; return __builtin_bit_cast(unsigned, __builtin_convertvector(v, bf16x2v)); }
DEVINL float sigm(float x) { return __builtin_amdgcn_rcpf(1.f + __expf(-x)); }
DEVINL float silu(float x) { return x * __builtin_amdgcn_rcpf(1.f + __expf(-x)); }
DEVINL float softplus(float x) { return fmaxf(x, 0.f) + __logf(1.f + __expf(-fabsf(x))); }
DEVINL float dpp_sum16(float v) {
  v += __int_as_float(__builtin_amdgcn_update_dpp(0, __float_as_int(v), 0xB1, 0xF, 0xF, true));
  v += __int_as_float(__builtin_amdgcn_update_dpp(0, __float_as_int(v), 0x4E, 0xF, 0xF, true));
  v += __int_as_float(__builtin_amdgcn_update_dpp(0, __float_as_int(v), 0x141, 0xF, 0xF, true));
  v += __int_as_float(__builtin_amdgcn_update_dpp(0, __float_as_int(v), 0x140, 0xF, 0xF, true));
  return v;
}
DEVINL float dpp_sum8(float v) {
  v += __int_as_float(__builtin_amdgcn_update_dpp(0, __float_as_int(v), 0xB1, 0xF, 0xF, true));
  v += __int_as_float(__builtin_amdgcn_update_dpp(0, __float_as_int(v), 0x4E, 0xF, 0xF, true));
  v += __int_as_float(__builtin_amdgcn_update_dpp(0, __float_as_int(v), 0x141, 0xF, 0xF, true));
  return v;
}
DEVINL float wave_sum(float v) { v = dpp_sum16(v); v += __shfl_xor(v, 16); v += __shfl_xor(v, 32); return v; }
template <int W> DEVINL float group_sum(float v) {
#pragma unroll
  for (int o = W / 2; o > 0; o >>= 1) v += __shfl_xor(v, o);
  return v;
}

#define XB_TMO      128
#define XB_XCNT(j)  (256  + 64 * (j))
#define XB_XSUB(j)  (1280 + 64 * (j))
#define XB_XGEN(j)  (2304 + 64 * (j))
#define XB_TOP      3328
#define XB_TOPGEN   3392
#define XCD_BAR_WORDS 3456
#define XB_SPIN_CAP (1u << 18)

DEVINL unsigned xb_ld(unsigned* p)              { return __hip_atomic_load(p, __ATOMIC_RELAXED, __HIP_MEMORY_SCOPE_AGENT); }
DEVINL unsigned xb_add(unsigned* p, unsigned v) { return __hip_atomic_fetch_add(p, v, __ATOMIC_RELAXED, __HIP_MEMORY_SCOPE_AGENT); }
DEVINL unsigned xb_xcc_id() { return (unsigned)__builtin_amdgcn_s_getreg((3 << 11) | 20) & 0xFu; }
#define XB_SPIN(cond, bar) do { unsigned _sp = 0; while (cond) { __builtin_amdgcn_s_sleep(1); \
    if ((++_sp & 255u) == 0u) { if (xb_ld(&(bar)[XB_TMO])) break; if (_sp > XB_SPIN_CAP) { atomicAdd(&(bar)[XB_TMO], 1u); break; } } } } while (0)

struct XcdBarrier { unsigned* bar; unsigned x; volatile LAS unsigned* st; };

DEVINL XcdBarrier xcd_barrier_post(unsigned* bar, volatile LAS unsigned* st) {
    XcdBarrier b; b.bar = bar; b.x = xb_xcc_id(); b.st = st;
    if (threadIdx.x == 0) (void)xb_add(&bar[XB_XCNT(b.x)], 1u);
    return b;
}
DEVINL void xcd_barrier_complete(unsigned* bar, unsigned x, unsigned& nloc, unsigned& nx) {
    const unsigned G = gridDim.x * gridDim.y * gridDim.z;
    unsigned sum, cnt, mine, sp = 0u;
    for (;;) {
        sum = 0u; cnt = 0u; mine = 0u;
#pragma unroll
        for (unsigned j = 0; j < 16; ++j) { const unsigned c = xb_ld(&bar[XB_XCNT(j)]); sum += c; cnt += (c > 0u) ? 1u : 0u; mine = (j == x) ? c : mine; }
        if (sum == G) break;
        __builtin_amdgcn_s_sleep(1);
        if ((++sp & 255u) == 0u) { if (xb_ld(&bar[XB_TMO])) break; if (sp > XB_SPIN_CAP) { atomicAdd(&bar[XB_TMO], 1u); break; } }
    }
    nloc = mine > 0u ? mine : 1u; nx = cnt > 0u ? cnt : 1u;
}
DEVINL void xcd_barrier(const XcdBarrier& b) {
    asm volatile("s_waitcnt vmcnt(0)" ::: "memory");
    __syncthreads();
    if (threadIdx.x == 0) {
        unsigned* bar = b.bar;
        __builtin_amdgcn_s_waitcnt(0);
        unsigned nloc = b.st[0], nx = b.st[1];
        if (nloc == 0u) { xcd_barrier_complete(bar, b.x, nloc, nx); b.st[0] = nloc; b.st[1] = nx; }
        const unsigned old = xb_add(&bar[XB_XSUB(b.x)], 1u);
        const unsigned gen = old / nloc;
        if (old + 1u == (gen + 1u) * nloc) {
            __builtin_amdgcn_fence(__ATOMIC_RELEASE, "agent");
            asm volatile("s_waitcnt vmcnt(0)" ::: "memory");
            const unsigned og = xb_add(&bar[XB_TOP], 1u);
            const unsigned tg = og / nx;
            if (og + 1u == (tg + 1u) * nx) xb_add(&bar[XB_TOPGEN], 1u);
            else XB_SPIN(xb_ld(&bar[XB_TOPGEN]) == tg, bar);
            __builtin_amdgcn_fence(__ATOMIC_ACQUIRE, "agent");
            xb_add(&bar[XB_XGEN(b.x)], 1u);
            asm volatile("s_waitcnt vmcnt(0)" ::: "memory");
        } else {
            XB_SPIN(xb_ld(&bar[XB_XGEN(b.x)]) == gen, bar);
            __builtin_amdgcn_fence(__ATOMIC_ACQUIRE, "agent");
            asm volatile("s_waitcnt vmcnt(0)" ::: "memory");
        }
    }
    __syncthreads();
}

namespace g8 {
constexpr int BM = 256, BK = 64, HALF = 128, HTB = HALF * BK * 2, NXCD = 8, WGM = 8;
DEVINL int lds_byte(int r, int c) { const int st = (r >> 4) * 2 + (c >> 5), rr = r & 15, cc = c & 31, ob = rr * 64 + cc * 2; return st * 1024 + (ob ^ (((ob >> 9) & 1) << 5)); }
DEVINL void stage_rc(int b, int& R, int& C) { const int st = b / 1024, sb = b % 1024, swz = sb ^ (((sb >> 9) & 1) << 5); R = (st >> 1) * 16 + swz / 64; C = (st & 1) * 32 + (swz % 64) / 2; }
DEVINL int perm32(int rho) { const int n = rho >> 4, i = rho & 15; return 8 * (i >> 2) + 4 * n + (i & 3); }
struct Unit { int pm, pn, e; };
typedef f32x4 Acc[2][2][4][2];

struct TileSched {
  int nM, nN, nwg, G, c;
  DEVINL void init(int nM_, int nN_) { nM = nM_; nN = nN_; nwg = nM * nN; G = gridDim.x; c = blockIdx.x; }
  DEVINL bool next(int i, Unit& u) const {
    const long L = (long)i * G + c; if (L >= nwg) return false;
    int wgid = (int)L; { const int q = nwg / NXCD, r = nwg % NXCD, xcd = wgid % NXCD, off = wgid / NXCD; wgid = (xcd < r ? xcd * (q + 1) : r * (q + 1) + (xcd - r) * q) + off; }
    const int nig = WGM * nN, gid = wgid / nig, fm = gid * WGM, gsz = (nM - fm) < WGM ? (nM - fm) : WGM;
    u.pm = fm + ((wgid % nig) % gsz); u.pn = (wgid % nig) / gsz; u.e = 0; return true;
  }
};
struct MergeSched {
  int nM, G, c;
  DEVINL void init(int nM_) { nM = nM_; G = gridDim.x; c = blockIdx.x; }
  DEVINL bool next(int i, Unit& u) const {
    const int tile = (i >> 2) * G + c; if (tile >= nM * 4) return false;
    const int hi = tile >> 8, x = tile & 7, idx = (tile & 255) >> 3;
    u.pm = hi ? 64 + (x >> 1) : x * 8 + (idx >> 2); u.pn = hi ? (x & 1) * 2 + idx : (idx & 3); u.e = i & 3; return true;
  }
};
struct MoeSched {
  const int* cnt; int npn, G, c, skip;
  DEVINL bool next(int i, Unit& u) const {
    int g = i * G + c - skip; if (g < 0) return false;
    g = (g & ~127) | ((g & 7) << 4) | ((g >> 3) & 15);
    int base = 0;
#pragma unroll 1
    for (int e = 0; e < 16; ++e) { const int n = ((cnt[e] + 255) >> 8) * npn; if (g < base + n) { const int r = g - base; u.e = e; u.pm = r / npn; u.pn = r % npn; return true; } base += n; }
    return false;
  }
};
struct RowAddr {
  int ld; int sel; unsigned estride;
  DEVINL unsigned operator()(const Unit& u, int r) const { return (unsigned)(((sel ? u.pn : u.pm) * 256 + r) * ld) * 2u + (unsigned)u.e * estride; }
};
struct GatherAddr {
  const int* list; const int* cnt; int rowbytes; int shift;
  DEVINL unsigned operator()(const Unit& u, int r) const {
    const int ce = cnt[u.e]; int ei = u.pm * 256 + r; ei = ei < ce ? ei : ce - 1;
    return (unsigned)(list[(size_t)u.e * T + ei] >> shift) * (unsigned)rowbytes;
  }
};

template <class Epi, class Sched, class AA, class AB>
DEVINL void gemm8(LAS unsigned char* lds, const char* Abase, const char* Bbase, int K, const Sched& S, const Epi& E, const AA& aA, const AB& aB) {
  const int tid = threadIdx.x, wid = __builtin_amdgcn_readfirstlane(tid >> 6), lane = tid & 63, wr = wid >> 2, wc = wid & 3, fr = lane & 15, fq = lane >> 4;
  const int nt = K / BK;
  int Rr[2], Cc[2], Rb[2];
#pragma unroll
  for (int i = 0; i < 2; ++i) { stage_rc(tid * 16 + i * 8192, Rr[i], Cc[i]); Rb[i] = Epi::PERM ? ((Rr[i] & ~31) + perm32(Rr[i] & 31)) : Rr[i]; }
  const unsigned ldsw = (unsigned)wid * 1024u;
  const int aoff = lds_byte(wr * 64 + fr, fq * 8), boff = lds_byte(wc * 32 + fr, fq * 8);
#define G8_SA(b, h) (((b) * 2 + (h)) * HTB)
#define G8_SB(b, h) ((4 + (b) * 2 + (h)) * HTB)
#define G8_STAGE(bufoff, base, kb, o) do { \
    __builtin_amdgcn_global_load_lds((const unsigned*)((base) + (o)[0] + (kb)), (LAS unsigned*)(lds + (bufoff) + ldsw), 16, 0, 0); \
    __builtin_amdgcn_global_load_lds((const unsigned*)((base) + (o)[1] + (kb)), (LAS unsigned*)(lds + (bufoff) + ldsw + 8192), 16, 0, 0); } while (0)
#define G8_LDA(dst, b, h) do { _Pragma("unroll") for (int m = 0; m < 4; ++m) _Pragma("unroll") for (int k = 0; k < 2; ++k) dst[m][k] = *(const LAS bf16x8*)(lds + G8_SA(b, h) + aoff + m * 2048 + k * 1024); } while (0)
#define G8_LDB(dst, b, h) do { _Pragma("unroll") for (int n = 0; n < 2; ++n) _Pragma("unroll") for (int k = 0; k < 2; ++k) dst[n][k] = *(const LAS bf16x8*)(lds + G8_SB(b, h) + boff + n * 2048 + k * 1024); } while (0)
#define G8_MMA(ai, bj, At, Bt) do { __builtin_amdgcn_s_setprio(1); _Pragma("unroll") for (int m = 0; m < 4; ++m) _Pragma("unroll") for (int n = 0; n < 2; ++n) _Pragma("unroll") for (int k = 0; k < 2; ++k) \
    acc[ai][bj][m][n] = __builtin_amdgcn_mfma_f32_16x16x32_bf16(Bt[n][k], At[m][k], acc[ai][bj][m][n], 0, 0, 0); __builtin_amdgcn_s_setprio(0); } while (0)
#define G8_WAIT_V(n) asm volatile("s_waitcnt vmcnt(" #n ")" ::: "memory")
#define G8_WAIT_L(n) asm volatile("s_waitcnt lgkmcnt(" #n ")" ::: "memory")
#define G8_BAR __builtin_amdgcn_s_barrier()
#define G8_SCHED __builtin_amdgcn_sched_barrier(0)
  Unit cur, nxt; int ui = 0;
  if (!S.next(0, cur)) return;
  Acc acc;
#pragma unroll
  for (int a = 0; a < 2; ++a)
#pragma unroll
    for (int b = 0; b < 2; ++b)
#pragma unroll
      for (int m = 0; m < 4; ++m)
#pragma unroll
        for (int n = 0; n < 2; ++n) acc[a][b][m][n] = f32x4{0.f, 0.f, 0.f, 0.f};
  bf16x8 At[4][2], B0[2][2], B1[2][2];
  unsigned oAc[2][2], oBc[2][2], oAn[2][2], oBn[2][2];
#pragma unroll
  for (int h = 0; h < 2; ++h)
#pragma unroll
    for (int i = 0; i < 2; ++i) { oAc[h][i] = aA(cur, h * 128 + Rr[i]) + Cc[i] * 2; oBc[h][i] = aB(cur, h * 128 + Rb[i]) + Cc[i] * 2; oAn[h][i] = oAc[h][i]; oBn[h][i] = oBc[h][i]; }
  G8_STAGE(G8_SB(0, 0), Bbase, 0, oBc[0]); G8_STAGE(G8_SA(0, 0), Abase, 0, oAc[0]); G8_STAGE(G8_SB(0, 1), Bbase, 0, oBc[1]); G8_STAGE(G8_SA(0, 1), Abase, 0, oAc[1]);
  if (wr == 1) G8_BAR;
  G8_WAIT_V(4); G8_BAR;
  G8_STAGE(G8_SB(1, 0), Bbase, 128, oBc[0]); G8_STAGE(G8_SA(1, 0), Abase, 128, oAc[0]); G8_STAGE(G8_SB(1, 1), Bbase, 128, oBc[1]);
  G8_WAIT_V(6); G8_BAR;
  for (;;) {
    const bool has_next = S.next(ui + 1, nxt);
    if (has_next) {
#pragma unroll
      for (int h = 0; h < 2; ++h)
#pragma unroll
        for (int i = 0; i < 2; ++i) { oAn[h][i] = aA(nxt, h * 128 + Rr[i]) + Cc[i] * 2; oBn[h][i] = aB(nxt, h * 128 + Rb[i]) + Cc[i] * 2; }
    } else {
#pragma unroll
      for (int h = 0; h < 2; ++h)
#pragma unroll
        for (int i = 0; i < 2; ++i) { oAn[h][i] = oAc[h][i]; oBn[h][i] = oBc[h][i]; }
    }
    for (int t = 0; t < nt; t += 2) {
      const bool last = (t == nt - 2);
      const int k1 = (t + 1) * 128, k2 = last ? 0 : (t + 2) * 128, k3 = k2 + 128;
      unsigned a2[2][2], b2[2][2];
#pragma unroll
      for (int h = 0; h < 2; ++h)
#pragma unroll
        for (int i = 0; i < 2; ++i) { a2[h][i] = last ? oAn[h][i] : oAc[h][i]; b2[h][i] = last ? oBn[h][i] : oBc[h][i]; }
      G8_LDB(B0, 0, 0); G8_SCHED; G8_LDA(At, 0, 0); G8_STAGE(G8_SA(1, 1), Abase, k1, oAc[1]);
      G8_WAIT_L(8); G8_BAR; G8_WAIT_L(0); G8_MMA(0, 0, At, B0); G8_BAR; G8_SCHED;
      G8_LDB(B1, 0, 1); G8_STAGE(G8_SB(0, 0), Bbase, k2, b2[0]);
      G8_BAR; G8_WAIT_L(0); G8_MMA(0, 1, At, B1); G8_BAR;
      G8_LDA(At, 0, 1); G8_STAGE(G8_SA(0, 0), Abase, k2, a2[0]);
      G8_BAR; G8_WAIT_L(0); G8_MMA(1, 0, At, B0); G8_BAR; G8_SCHED;
      G8_STAGE(G8_SB(0, 1), Bbase, k2, b2[1]);
      G8_WAIT_V(6); G8_BAR; G8_MMA(1, 1, At, B1); G8_BAR;
      G8_LDB(B0, 1, 0); G8_SCHED; G8_LDA(At, 1, 0); G8_STAGE(G8_SA(0, 1), Abase, k2, a2[1]);
      G8_WAIT_L(8); G8_BAR; G8_WAIT_L(0); G8_MMA(0, 0, At, B0); G8_BAR; G8_SCHED;
      G8_LDB(B1, 1, 1); G8_STAGE(G8_SB(1, 0), Bbase, k3, b2[0]);
      G8_BAR; G8_WAIT_L(0); G8_MMA(0, 1, At, B1); G8_BAR;
      G8_LDA(At, 1, 1); G8_STAGE(G8_SA(1, 0), Abase, k3, a2[0]);
      G8_BAR; G8_WAIT_L(0); G8_MMA(1, 0, At, B0); G8_BAR; G8_SCHED;
      G8_STAGE(G8_SB(1, 1), Bbase, k3, b2[1]);
      G8_WAIT_V(6); G8_BAR; G8_MMA(1, 1, At, B1); G8_BAR;
    }
    E(acc, cur, wr, wc, fr, fq);
    if (!has_next) break;
#pragma unroll
    for (int a = 0; a < 2; ++a)
#pragma unroll
      for (int b = 0; b < 2; ++b)
#pragma unroll
        for (int m = 0; m < 4; ++m)
#pragma unroll
          for (int n = 0; n < 2; ++n) acc[a][b][m][n] = f32x4{0.f, 0.f, 0.f, 0.f};
    cur = nxt; ++ui;
#pragma unroll
    for (int h = 0; h < 2; ++h)
#pragma unroll
      for (int i = 0; i < 2; ++i) { oAc[h][i] = oAn[h][i]; oBc[h][i] = oBn[h][i]; }
  }
  G8_WAIT_V(0);
  if (wr == 0) G8_BAR;
  G8_BAR;
#undef G8_SA
#undef G8_SB
#undef G8_STAGE
#undef G8_LDA
#undef G8_LDB
#undef G8_MMA
#undef G8_WAIT_V
#undef G8_WAIT_L
#undef G8_BAR
#undef G8_SCHED
}
}

#define CONV_ARGS(x) const float* x##src, bfr* x##dst, int x##N, int x##Kd, int x##kt, int x##nt, int x##drow0
#define CONV_REFS(x) const float*& x##src, bfr*& x##dst, int& x##N, int& x##Kd, int& x##kt, int& x##nt, int& x##drow0
#define CONV_PASS(x) x##src, x##dst, x##N, x##Kd, x##kt, x##nt, x##drow0
DEVINL void conv_load(CONV_ARGS(d_), f32x4& v0, f32x4& v1) {
  const int tid = threadIdx.x, r = tid >> 4, c4 = (tid & 15) * 4;
  (void)d_dst; (void)d_Kd; (void)d_drow0;
  if (d_src) {
    const float* s = d_src + (size_t)(d_kt * 64 + r) * d_N + d_nt * 64 + c4;
    v0 = *(const f32x4*)s; v1 = *(const f32x4*)(s + (size_t)32 * d_N);
  } else { v0 = f32x4{0.f, 0.f, 0.f, 0.f}; v1 = v0; }
}
DEVINL void conv_store(CONV_ARGS(d_), const f32x4& v0, const f32x4& v1, char* sm) {
  float* tile = (float*)sm;
  const int tid = threadIdx.x, r = tid >> 4, c4 = (tid & 15) * 4;
  (void)d_src; (void)d_N; (void)d_nt;
  __syncthreads();
  tile[r * 65 + c4] = v0[0]; tile[r * 65 + c4 + 1] = v0[1]; tile[r * 65 + c4 + 2] = v0[2]; tile[r * 65 + c4 + 3] = v0[3];
  tile[(r + 32) * 65 + c4] = v1[0]; tile[(r + 32) * 65 + c4 + 1] = v1[1]; tile[(r + 32) * 65 + c4 + 2] = v1[2]; tile[(r + 32) * 65 + c4 + 3] = v1[3];
  __syncthreads();
  const int n = tid >> 3, k8 = (tid & 7) * 8;
  float y[8];
#pragma unroll
  for (int j = 0; j < 8; ++j) y[j] = tile[(k8 + j) * 65 + n];
  *(uint4*)(d_dst + (size_t)(d_drow0 + n) * d_Kd + d_kt * 64 + k8) = make_uint4(pack2(y[0], y[1]), pack2(y[2], y[3]), pack2(y[4], y[5]), pack2(y[6], y[7]));
}
constexpr int CONV_L_ITEMS = 1712 + 16 + 1024 + 512 + 256;
DEVINL void conv_layer_desc(const Params& p, int l, int it, CONV_REFS(d_)) {
  if (it < 1712) { d_src = p.w_in + (size_t)l * D * NIN; d_dst = p.WinT; d_N = NIN; d_Kd = D; d_kt = it / 107; d_nt = it % 107; }
  else if (it < 1728) { d_src = nullptr; d_dst = p.WinT; d_N = 0; d_Kd = D; d_kt = it - 1712; d_nt = 107; }
  else if (it < 2752) { const int g = (it - 1728) >> 8, r = (it - 1728) & 255; d_src = p.w_gate + ((size_t)l * 4 + g) * D * D; d_dst = p.WgT + (size_t)g * D * D; d_N = D; d_Kd = D; d_kt = r >> 4; d_nt = r & 15; }
  else if (it < 3264) { const int g = (it - 2752) >> 7, r = (it - 2752) & 127; d_src = p.w_branch + ((size_t)l * 4 + g) * 512 * D; d_dst = p.WbT + (size_t)g * D * 512; d_N = D; d_Kd = 512; d_kt = r >> 4; d_nt = r & 15; }
  else { const int r = it - 3264; d_src = p.w_out + (size_t)l * D * D; d_dst = p.WoT; d_N = D; d_Kd = D; d_kt = r >> 4; d_nt = r & 15; }
  d_drow0 = d_nt * 64;
}
constexpr int CONV_M_ITEMS = 6144;
DEVINL void conv_moe_desc(const Params& p, int l, int it, CONV_REFS(d_)) {
  const int which = it / 2048, r = it % 2048, e = r >> 7, tt = r & 127;
  const size_t eo = ((size_t)l * 16 + e) * (size_t)D * 512;
  if (which < 2) { d_src = (which ? p.moe_w_up : p.moe_w_gate) + eo; d_dst = p.WmguT + (size_t)e * D * D; d_N = 512; d_Kd = D; d_kt = tt >> 3; d_nt = tt & 7; d_drow0 = ((tt & 7) >> 1) * 256 + which * 128 + ((tt & 7) & 1) * 64; }
  else { d_src = p.moe_w_down + eo; d_dst = p.WmdT + (size_t)e * D * 512; d_N = D; d_Kd = 512; d_kt = tt >> 4; d_nt = tt & 15; d_drow0 = (tt & 15) * 64; }
}
template <bool MOE>
DEVINL void convert_range(const Params& p, int l, int start, int end, int stride, char* sm) {
  if (start >= end) return;
  const float* c_src; bfr* c_dst; int c_N, c_Kd, c_kt, c_nt, c_drow0;
  if (MOE) conv_moe_desc(p, l, start, CONV_PASS(c_)); else conv_layer_desc(p, l, start, CONV_PASS(c_));
  f32x4 v0, v1; conv_load(CONV_PASS(c_), v0, v1);
#pragma unroll 1
  for (int it = start; it < end; it += stride) {
    const int itn = (it + stride < end) ? it + stride : it;
    const float* n_src; bfr* n_dst; int n_N, n_Kd, n_kt, n_nt, n_drow0;
    if (MOE) conv_moe_desc(p, l, itn, CONV_PASS(n_)); else conv_layer_desc(p, l, itn, CONV_PASS(n_));
    f32x4 n0, n1; conv_load(CONV_PASS(n_), n0, n1);
    conv_store(CONV_PASS(c_), v0, v1, sm);
    c_src = n_src; c_dst = n_dst; c_N = n_N; c_Kd = n_Kd; c_kt = n_kt; c_nt = n_nt; c_drow0 = n_drow0; v0 = n0; v1 = n1;
  }
}
#undef CONV_ARGS
#undef CONV_REFS
#undef CONV_PASS

DEVINL void adaln_item(const Params& p, int it, char* sm) {
  const int l = it / 96, jb = it % 96, tid = threadIdx.x, c = tid & 63, ks = tid >> 6;
  float* sc = (float*)sm;
  float* red = sc + 5 * 1024;
  __syncthreads();
  for (int i = tid; i < 5 * 1024; i += NTHR) { const int v = i >> 10, k = i & 1023; const float cv = v < 4 ? p.c[v * 1024 + k] : p.c_ctx[k]; sc[i] = silu(cv); }
  __syncthreads();
  const int j = jb * 64 + c;
  float a[5] = {0.f, 0.f, 0.f, 0.f, 0.f};
  const float* w = p.ada_w + (size_t)l * D * 6144 + j;
#pragma unroll 16
  for (int k = ks * 128; k < ks * 128 + 128; ++k) {
    const float wv = w[(size_t)k * 6144];
#pragma unroll
    for (int v = 0; v < 5; ++v) a[v] += sc[v * 1024 + k] * wv;
  }
#pragma unroll
  for (int v = 0; v < 5; ++v) red[(ks * 5 + v) * 64 + c] = a[v];
  __syncthreads();
  if (tid < 320) {
    const int v = tid >> 6;
    float sum = 0.f;
#pragma unroll
    for (int q = 0; q < 8; ++q) sum += red[(q * 5 + v) * 64 + c];
    p.mod[((size_t)l * 5 + v) * 6144 + j] = sum + p.ada_b[l * 6144 + j];
  }
}
DEVINL void phase_prologue(const Params& p, char* sm) {
  if (blockIdx.x < 192) adaln_item(p, blockIdx.x, sm);
  convert_range<false>(p, 0, blockIdx.x, 1728, gridDim.x, sm);
}

DEVINL int canon_row(int L, int R) {
  if (L & 1) { const int b = R >> 12, s = R & 4095; return (b << 12) | ((s & 63) << 6) | (s >> 6); }
  return R;
}
template <int L>
DEVINL void phase_norm1(const Params& p) {
  const int lane = threadIdx.x & 63, wave = threadIdx.x >> 6;
  for (int R = blockIdx.x * 8 + wave; R < T; R += gridDim.x * 8) {
    const bool lat = R < TL;
    const int cr = lat ? canon_row(L, R) : R;
    const int vv = lat ? (R >> 12) : 4;
    float* xp = lat ? p.out + (size_t)cr * D : p.xc + (size_t)(R - TL) * D;
    const float* src = lat ? p.x + (size_t)cr * D : p.ctx + (size_t)(R - TL) * D;
    float4 xq[4]; uint2 y0q[4], y1q[4]; float4 m5q[4];
#pragma unroll
    for (int q = 0; q < 4; ++q) {
      const int j = q * 256 + lane * 4;
      if (L == 0) xq[q] = *(const float4*)(src + j);
      else {
        xq[q] = *(const float4*)(xp + j);
        m5q[q] = *(const float4*)(p.mod + ((size_t)(L - 1) * 5 + vv) * 6144 + 5 * 1024 + j);
        y0q[q] = *(const uint2*)(p.YS + (size_t)cr * D + j); y1q[q] = *(const uint2*)(p.YS + (size_t)T * D + (size_t)cr * D + j);
      }
    }
    float v[16]; float ss = 0.f;
#pragma unroll
    for (int q = 0; q < 4; ++q) {
      const int j = q * 256 + lane * 4;
      float4 xv = xq[q];
      if (L != 0) {
        const float4 m5 = m5q[q]; const uint2 y0 = y0q[q], y1 = y1q[q];
        xv.x += m5.x * (bf2f(y0.x & 0xFFFF) + bf2f(y1.x & 0xFFFF)); xv.y += m5.y * (bf2f(y0.x >> 16) + bf2f(y1.x >> 16));
        xv.z += m5.z * (bf2f(y0.y & 0xFFFF) + bf2f(y1.y & 0xFFFF)); xv.w += m5.w * (bf2f(y0.y >> 16) + bf2f(y1.y >> 16));
      }
      *(float4*)(xp + j) = xv;
      v[q * 4] = xv.x; v[q * 4 + 1] = xv.y; v[q * 4 + 2] = xv.z; v[q * 4 + 3] = xv.w;
      ss += xv.x * xv.x + xv.y * xv.y + xv.z * xv.z + xv.w * xv.w;
    }
    ss = wave_sum(ss);
    const float rs = rsqrtf(ss * (1.f / 1024.f) + EPS);
    const float* md = p.mod + ((size_t)L * 5 + vv) * 6144;
    float4 nwq[4], shq[4], sclq[4];
#pragma unroll
    for (int q = 0; q < 4; ++q) { const int j = q * 256 + lane * 4; nwq[q] = *(const float4*)(p.norm_mix + L * D + j); shq[q] = *(const float4*)(md + j); sclq[q] = *(const float4*)(md + 1024 + j); }
#pragma unroll
    for (int q = 0; q < 4; ++q) {
      const int j = q * 256 + lane * 4;
      const float4 nw = nwq[q], sh = shq[q], scl = sclq[q];
      const float h0 = v[q * 4] * rs * nw.x * (1.f + scl.x) + sh.x, h1 = v[q * 4 + 1] * rs * nw.y * (1.f + scl.y) + sh.y;
      const float h2 = v[q * 4 + 2] * rs * nw.z * (1.f + scl.z) + sh.z, h3 = v[q * 4 + 3] * rs * nw.w * (1.f + scl.w) + sh.w;
      *(uint2*)(p.O + (size_t)R * OLD + 2048 + j) = make_uint2(pack2(h0, h1), pack2(h2, h3));
    }
  }
}

DEVINL void chunk_of_step(int step, int b, int d, int& rb, int& len, int& c) {
  const int seg = step >= 4, cc = seg ? step - 4 : step, nch = seg ? 64 : 4;
  c = d ? nch - 1 - cc : cc; len = seg ? SEQ : CTXL; rb = seg ? b * SEQ : TL + b * CTXL;
}
template <int KS>
DEVINL f32x4 mma16(const bfr* A, int lda, const bfr* Bt, int ldb, f32x4 acc) {
  const int lane = threadIdx.x & 63;
  const bfr* ap = A + (lane & 15) * lda + (lane >> 4) * 8;
  const bfr* bp = Bt + (lane & 15) * ldb + (lane >> 4) * 8;
#pragma unroll
  for (int ks = 0; ks < KS; ++ks) acc = __builtin_amdgcn_mfma_f32_16x16x32_bf16(*(const bf16x8*)(ap + 32 * ks), *(const bf16x8*)(bp + 32 * ks), acc, 0, 0, 0);
  return acc;
}
DEVINL void unpack8(const uint4 v, float (&o)[8]) {
  o[0] = __uint_as_float(v.x << 16); o[1] = __uint_as_float(v.x & 0xFFFF0000u); o[2] = __uint_as_float(v.y << 16); o[3] = __uint_as_float(v.y & 0xFFFF0000u);
  o[4] = __uint_as_float(v.z << 16); o[5] = __uint_as_float(v.z & 0xFFFF0000u); o[6] = __uint_as_float(v.w << 16); o[7] = __uint_as_float(v.w & 0xFFFF0000u);
}
DEVINL void unpack4(const uint2 v, float (&o)[4]) {
  o[0] = __uint_as_float(v.x << 16); o[1] = __uint_as_float(v.x & 0xFFFF0000u); o[2] = __uint_as_float(v.y << 16); o[3] = __uint_as_float(v.y & 0xFFFF0000u);
}


template <int W8>
DEVINL void prep_item(const Params& p, int b, int col0, const float* t0g, const float* t1g, const float* t2g, const float* bg, bool shiftmode, int act, bool norm, float nscale, char* sm) {
  constexpr int W = W8 * 8, RS = 256, NV = (RS + 1) * W8, NPF = (NV + NTHR - 1) / NTHR, G = W8 / 8;
  const int tid = threadIdx.x;
  bfr* RAWP = (bfr*)sm;
  float* PT = (float*)(RAWP + (RS + 2) * W);
  __syncthreads();
  for (int c = tid; c < W; c += NTHR) {
    if (shiftmode) { const float mu = t0g[c]; PT[c] = 0.5f * mu; PT[W + c] = 1.f - mu; PT[2 * W + c] = 0.5f * mu; PT[3 * W + c] = 0.f; }
    else { PT[c] = t0g[c]; PT[W + c] = t1g[c]; PT[2 * W + c] = t2g[c]; PT[3 * W + c] = bg ? bg[c] : 0.f; }
  }
  uint4 pf[NPF];
  auto prefetch = [&](int step) {
    const int seg = step >= 1, cc = seg ? step - 1 : 0, len = seg ? SEQ : CTXL, rb = seg ? b * SEQ : TL + b * CTXL;
#pragma unroll
    for (int q = 0; q < NPF; ++q) {
      const int idx = tid + NTHR * q;
      uint4 v = make_uint4(0, 0, 0, 0);
      if (idx < NV) { const int r = idx / W8, g = idx % W8, t = cc * RS + r; if (t < len) v = *(const uint4*)(p.P + (size_t)(rb + t) * NINP + col0 + g * 8); }
      pf[q] = v;
    }
  };
  prefetch(0);
#pragma unroll 1
  for (int step = 0; step < 17; ++step) {
    const int seg = step >= 1, cc = seg ? step - 1 : 0, rb = seg ? b * SEQ : TL + b * CTXL;
    __syncthreads();
    if (tid < W8) *(uint4*)(RAWP + tid * 8) = (cc == 0) ? make_uint4(0, 0, 0, 0) : *(const uint4*)(RAWP + RS * W + tid * 8);
    __syncthreads();
#pragma unroll
    for (int q = 0; q < NPF; ++q) { const int idx = tid + NTHR * q; if (idx < NV) *(uint4*)(RAWP + (1 + idx / W8) * W + (idx % W8) * 8) = pf[q]; }
    __syncthreads();
    if (step + 1 < 17) prefetch(step + 1);
#pragma unroll 1
    for (int rep = 0; rep < 4; ++rep) {
      const int i = rep * 64 + (tid >> 3);
      float ssq = 0.f; float y[G][8];
#pragma unroll
      for (int gq = 0; gq < G; ++gq) {
        const int cbase = ((tid & 7) * G + gq) * 8;
        float x0[8], x1[8], x2[8];
        unpack8(*(const uint4*)(RAWP + i * W + cbase), x0); unpack8(*(const uint4*)(RAWP + (i + 1) * W + cbase), x1); unpack8(*(const uint4*)(RAWP + (i + 2) * W + cbase), x2);
#pragma unroll
        for (int e = 0; e < 8; ++e) {
          float v = PT[cbase + e] * x0[e] + PT[W + cbase + e] * x1[e] + PT[2 * W + cbase + e] * x2[e] + PT[3 * W + cbase + e];
          if (act == 1) v = silu(v); else if (act == 2) v = 1.f - 2.f * __builtin_amdgcn_rcpf(1.f + __expf(2.f * v)); else if (act == 3) v = sigm(v);
          y[gq][e] = v; ssq += v * v;
        }
      }
      float sc = 1.f;
      if (norm) { ssq = dpp_sum8(ssq); sc = __builtin_amdgcn_rsqf(ssq + EPS) * nscale; }
#pragma unroll
      for (int gq = 0; gq < G; ++gq) {
        const int cbase = ((tid & 7) * G + gq) * 8;
        *(uint4*)(p.P + (size_t)(rb + cc * RS + i) * NINP + col0 + cbase) =
            make_uint4(pack2(y[gq][0] * sc, y[gq][1] * sc), pack2(y[gq][2] * sc, y[gq][3] * sc), pack2(y[gq][4] * sc, y[gq][5] * sc), pack2(y[gq][6] * sc, y[gq][7] * sc));
      }
    }
  }
}
template <int L>
DEVINL void phase_prep(const Params& p, char* sm) {
  const int it = blockIdx.x;
  if (it >= 232) {
    for (int idx = (it - 232) * NTHR + threadIdx.x; idx < 512 * 256; idx += 24 * NTHR) { const int c = idx >> 8, k = idx & 255; p.g2T[idx] = k < 128 ? f2bf(p.rwkv_g2[((size_t)L * 128 + k) * 512 + c]) : (bfr)0; }
    return;
  }
  if (it < 32) {
    const int b = it >> 3, r = it & 7, isk = r >> 2, h = r & 3, ch = isk * 512 + h * 128;
    const float* cw = p.gdn_conv_w + (size_t)L * 3 * 1536 + ch;
    prep_item<16>(p, b, C_GDN + ch, cw, cw + 1536, cw + 3072, nullptr, false, 1, true, isk ? 1.f : 0.08838834764831845f, sm);
    return;
  }
  const int j = it - 32, b = j / 50, r = j % 50;
  if (r < 12) {
    const int ch = r * 64; const float* cw = p.ssm_conv_w + (size_t)L * 3 * 768 + ch;
    prep_item<8>(p, b, C_SSM + 512 + ch, cw, cw + 768, cw + 1536, p.ssm_conv_b + L * 768 + ch, false, 1, false, 1.f, sm);
  } else if (r < 20) {
    const int ch = 1024 + (r - 12) * 64; const float* cw = p.gdn_conv_w + (size_t)L * 3 * 1536 + ch;
    prep_item<8>(p, b, C_GDN + ch, cw, cw + 1536, cw + 3072, nullptr, false, 1, false, 1.f, sm);
  } else {
    const int ch = (r - 20) * 64; const float* mu = p.rwkv_mu + L * 1920 + ch;
    const int act = (ch >= 1536 && ch < 1664) ? 2 : (ch >= 1792 ? 3 : 0);
    prep_item<8>(p, b, C_RWKV + ch, mu, mu, mu, nullptr, true, act, false, 1.f, sm);
  }
}

DEVINL int rwkv_colbase(int g, int h, int d) { return g == 0 ? h * 64 : g == 1 ? 512 + h * 64 : g == 2 ? 1024 + h * 64 : g == 3 ? 1536 + d * 64 : 1664 + d * 64; }
DEVINL f32x4 bmm16(const float* A, int lda, const float* B, int ldb, f32x4 acc) {
  const int lane = threadIdx.x & 63;
#pragma unroll
  for (int s2 = 0; s2 < 4; ++s2) {
    const float a = A[(lane & 15) * lda + 4 * s2 + (lane >> 4)], b = B[(4 * s2 + (lane >> 4)) * ldb + (lane & 15)];
    acc = __builtin_amdgcn_mfma_f32_16x16x4f32(a, b, acc, 0, 0, 0);
  }
  asm volatile("" ::: "memory");
  return acc;
}
DEVINL void chunk32_of_step(int step, int b, int d, int& rb, int& c) {
  const int seg = step >= 8, cc = seg ? step - 8 : step, nch = seg ? 128 : 8;
  c = d ? nch - 1 - cc : cc; rb = seg ? b * SEQ : TL + b * CTXL;
}
DEVINL void rwkv3_prefetch(const Params& p, uint4& pfA, uint4& pfB, uint4 (&fw)[2], int step, int b, int d, int h) {
  int rb, c; chunk32_of_step(step, b, d, rb, c);
  const int tid = threadIdx.x, lane = tid & 63, ti = (tid >> 7) & 1, mat = (tid >> 6) & 1;
  const bfr* base = p.P + (size_t)(rb + c * 32) * NINP + C_RWKV;
  { const int r = tid >> 4, g = tid & 15; pfA = *(const uint4*)(base + (size_t)r * NINP + (g < 8 ? rwkv_colbase(0, h, d) + g * 8 : rwkv_colbase(1, h, d) + (g - 8) * 8)); }
  if (tid < 256) { const int r = tid >> 3, g = tid & 7; pfB = *(const uint4*)(base + (size_t)r * NINP + rwkv_colbase(2, h, d) + g * 8); }
  {
    const int i = ti * 16 + (lane & 15), r = d ? 31 - i : i;
    const bfr* rowp = base + (size_t)r * NINP + (lane >> 4) * 8;
    const int cb = mat ? rwkv_colbase(4, h, d) : rwkv_colbase(3, h, d);
    fw[0] = *(const uint4*)(rowp + cb); fw[1] = *(const uint4*)(rowp + cb + 32);
  }
}
template <int L>
DEVINL void scan_rwkv3(const Params& p, int item, char* sm) {
  const int d = item & 1, h = (item >> 1) & 7, b = item >> 4;
  const int tid = threadIdx.x, lane = tid & 63, wave = __builtin_amdgcn_readfirstlane(tid >> 6);
  constexpr int LK = 72, LJ = 40, LFS = 36, NCH = 136;
  bfr* w2T = (bfr*)sm; bfr* a2T = w2T + 64 * LK; bfr* RK = a2T + 64 * LK; bfr* BR = RK + 32 * 128; bfr* KR = BR + 32 * LK;
  float* Gf = (float*)(KR + 32 * LK); float* LWf = Gf + 2048; float* ARf = LWf + 2048;
  bfr* KH = (bfr*)(ARf + 2048); bfr* RH = KH + 32 * LK; bfr* BC = RH + 32 * LK; bfr* KC = BC + 32 * LK;
  bfr* BTt = KC + 32 * LK; bfr* KTt = BTt + 64 * LJ; bfr* VT0 = KTt + 64 * LJ; bfr* VT1 = VT0 + 64 * LJ;
  float* Lf = (float*)(VT1 + 64 * LJ); float* Tf = Lf + 32 * LFS;
  bfr* Tm = (bfr*)(Tf + 32 * LFS); bfr* Aak = Tm + 32 * LJ; bfr* Arb = Aak + 32 * LJ; bfr* Ark = Arb + 32 * LJ;
  bfr* ZT = Ark + 32 * LJ; bfr* UT = ZT + 64 * LJ; bfr* S0b = UT + 64 * LJ; bfr* OST = S0b + 64 * LK; bfr* VR = OST + 32 * LK;
  float* GC0 = (float*)(VR + 32 * LK); float* GC1 = GC0 + 64; float* TMPX = GC1 + 64; float* BONL = TMPX + 256;
  for (int i = tid; i < 4096; i += NTHR) {
    const int r = i >> 6, c = i & 63;
    w2T[c * LK + r] = f2bf(p.rwkv_w2[((size_t)(L * 2 + d) * 64 + r) * 512 + h * 64 + c]);
    a2T[c * LK + r] = f2bf(p.rwkv_a2[((size_t)(L * 2 + d) * 64 + r) * 512 + h * 64 + c]);
  }
  for (int i = tid; i < 64 * LK; i += NTHR) S0b[i] = 0;
  const int c4 = (tid & 15) * 4;
  const float4 a0v = *(const float4*)(p.rwkv_a0 + (L * 2 + d) * 512 + h * 64 + c4);
  const float4 kkv = *(const float4*)(p.rwkv_k_k + L * 512 + h * 64 + c4), kav = *(const float4*)(p.rwkv_k_a + L * 512 + h * 64 + c4), rkv = *(const float4*)(p.rwkv_r_k + L * 512 + h * 64 + c4);
  const int lr_mat = wave & 1, lr_ti = (wave >> 1) & 1, lr_tj = (wave >> 2) * 2;
  const float w0c0 = p.rwkv_w0[(L * 2 + d) * 512 + h * 64 + lr_tj * 16 + (lane & 15)], w0c1 = p.rwkv_w0[(L * 2 + d) * 512 + h * 64 + lr_tj * 16 + 16 + (lane & 15)];
  f32x4 Sm[4];
#pragma unroll
  for (int u = 0; u < 4; ++u) Sm[u] = f32x4{0.f, 0.f, 0.f, 0.f};
  uint4 pfA, pfB = make_uint4(0, 0, 0, 0), fw[2];
  const int tv = wave & 3;
  f32x4 p1[2], p2[2];
#define RW3_STAGE_LOWRANK() do { \
    { const int r_ = tid >> 4, g_ = tid & 15, i_ = d ? 31 - r_ : r_; *(uint4*)(RK + i_ * 128 + g_ * 8) = pfA; } \
    if (tid < 256) { const int r_ = tid >> 3, g_ = tid & 7, i_ = d ? 31 - r_ : r_; *(uint4*)(VR + i_ * LK + g_ * 8) = pfB; } \
    { const bfr* bm_ = (lr_mat ? a2T : w2T) + (lr_tj * 16 + (lane & 15)) * LK + (lane >> 4) * 8; \
      _Pragma("unroll") for (int q_ = 0; q_ < 2; ++q_) { \
        f32x4 cw_ = f32x4{0.f, 0.f, 0.f, 0.f}; \
        _Pragma("unroll") for (int ks_ = 0; ks_ < 2; ++ks_) \
          cw_ = __builtin_amdgcn_mfma_f32_16x16x32_bf16(__builtin_bit_cast(bf16x8, fw[ks_]), *(const bf16x8*)(bm_ + q_ * 16 * LK + 32 * ks_), cw_, 0, 0, 0); \
        _Pragma("unroll") for (int r_ = 0; r_ < 4; ++r_) { const int i_ = lr_ti * 16 + (lane >> 4) * 4 + r_, cc_ = (lr_tj + q_) * 16 + (lane & 15); \
          if (lr_mat) ARf[i_ * 64 + cc_] = cw_[r_]; else LWf[i_ * 64 + cc_] = -0.6065306597f * sigm(cw_[r_] + (q_ ? w0c1 : w0c0)); } } } } while (0)
#define RW3_VT(VTn, tl) do { const int v_ = (tl) & 63, iq_ = ((tl) >> 6) * 8; unsigned w_[4]; \
    _Pragma("unroll") for (int e_ = 0; e_ < 4; ++e_) w_[e_] = (unsigned)VR[(iq_ + 2 * e_) * LK + v_] | ((unsigned)VR[(iq_ + 2 * e_ + 1) * LK + v_] << 16); \
    *(uint4*)((VTn) + v_ * LJ + iq_) = make_uint4(w_[0], w_[1], w_[2], w_[3]); } while (0)
#define RW3_CUMSUM_TILE(GCn, id_) do { const int ti_ = (id_) >> 2, tj_ = (id_) & 3; \
      f32x4 gacc_ = f32x4{0.f, 0.f, 0.f, 0.f}; \
      _Pragma("unroll") for (int kb_ = 0; kb_ < 2; ++kb_) { if (kb_ <= ti_) { \
        _Pragma("unroll") for (int s4_ = 0; s4_ < 4; ++s4_) { const int kk2_ = 4 * s4_ + (lane >> 4); \
          const float av_ = (kb_ < ti_ || kk2_ <= (lane & 15)) ? 1.f : 0.f; const float bv_ = LWf[(kb_ * 16 + kk2_) * 64 + tj_ * 16 + (lane & 15)]; \
          gacc_ = __builtin_amdgcn_mfma_f32_16x16x4f32(av_, bv_, gacc_, 0, 0, 0); } } } \
      _Pragma("unroll") for (int r_ = 0; r_ < 4; ++r_) Gf[(ti_ * 16 + (lane >> 4) * 4 + r_) * 64 + tj_ * 16 + (lane & 15)] = gacc_[r_]; \
      if (ti_ == 1 && (lane >> 4) == 3) (GCn)[tj_ * 16 + (lane & 15)] = gacc_[3]; } while (0)
  rwkv3_prefetch(p, pfA, pfB, fw, 0, b, d, h);
  __syncthreads();
  RW3_STAGE_LOWRANK();
  rwkv3_prefetch(p, pfA, pfB, fw, 1, b, d, h);
  __syncthreads();
  RW3_CUMSUM_TILE(GC0, wave);
  if (wave >= 4) RW3_VT(VT0, tid - 256);
  __syncthreads();
  {
    int rb0, c0; chunk32_of_step(0, b, d, rb0, c0);
#define EW_I (tid >> 4)
#define EW_GC GC0
#define EW_RB rb0
#define EW_C c0
    {
      const int i = EW_I, t = d ? 31 - i : i;
      float rr[4], kk_[4];
      unpack4(*(const uint2*)(RK + i * 128 + c4), rr); unpack4(*(const uint2*)(RK + i * 128 + 64 + c4), kk_);
      const float4 g4 = *(const float4*)&Gf[i * 64 + c4], l4 = *(const float4*)&LWf[i * 64 + c4], ar4 = *(const float4*)&ARf[i * 64 + c4], gc4 = *(const float4*)&EW_GC[c4];
      const float gA[4] = {g4.x, g4.y, g4.z, g4.w}, lA[4] = {l4.x, l4.y, l4.z, l4.w}, arA[4] = {ar4.x, ar4.y, ar4.z, ar4.w}, gcA[4] = {gc4.x, gc4.y, gc4.z, gc4.w};
      const float a0A[4] = {a0v.x, a0v.y, a0v.z, a0v.w}, kkA[4] = {kkv.x, kkv.y, kkv.z, kkv.w}, kaA[4] = {kav.x, kav.y, kav.z, kav.w}, rkA[4] = {rkv.x, rkv.y, rkv.z, rkv.w};
      float a_[4], kraw[4], kd_[4]; float ss = 0.f;
#pragma unroll
      for (int e = 0; e < 4; ++e) { a_[e] = sigm(arA[e] + a0A[e]); kraw[e] = kk_[e] * kkA[e]; ss += kraw[e] * kraw[e]; kd_[e] = kk_[e] * (1.f + (a_[e] - 1.f) * kaA[e]); }
      ss = dpp_sum16(ss);
      const float rn = __builtin_amdgcn_rsqf(ss + EPS);
      float khv[4], rhv[4], bcv[4], kcv[4], btv[4], ktv[4]; float sb = 0.f;
#pragma unroll
      for (int e = 0; e < 4; ++e) {
        const float kn = kraw[e] * rn, bb = kn * a_[e];
        const float eI = __expf(gA[e]), eIm1 = __expf(gA[e] - lA[e]), eInv = __expf(-gA[e]), eC = __expf(gcA[e] - gA[e]);
        khv[e] = kn * eIm1; rhv[e] = rr[e] * eI; bcv[e] = bb * eInv; kcv[e] = kd_[e] * eInv;
        btv[e] = bb * eC; ktv[e] = kd_[e] * eC;
        sb += rr[e] * kd_[e] * rkA[e];
      }
      sb = dpp_sum16(sb);
      *(uint2*)(KH + i * LK + c4) = make_uint2(pack2(khv[0], khv[1]), pack2(khv[2], khv[3]));
      *(uint2*)(RH + i * LK + c4) = make_uint2(pack2(rhv[0], rhv[1]), pack2(rhv[2], rhv[3]));
      *(uint2*)(BC + i * LK + c4) = make_uint2(pack2(bcv[0], bcv[1]), pack2(bcv[2], bcv[3]));
      *(uint2*)(KC + i * LK + c4) = make_uint2(pack2(kcv[0], kcv[1]), pack2(kcv[2], kcv[3]));
      *(uint2*)(BR + i * LK + c4) = make_uint2(pack2(btv[0], btv[1]), pack2(btv[2], btv[3]));
      *(uint2*)(KR + i * LK + c4) = make_uint2(pack2(ktv[0], ktv[1]), pack2(ktv[2], ktv[3]));
      if ((tid & 15) == 0) p.bon[((size_t)d * T + EW_RB + EW_C * 32 + t) * 8 + h] = sb;
    }
#undef EW_I
#undef EW_GC
#undef EW_RB
#undef EW_C
  }
  __syncthreads();
#pragma unroll 1
  for (int step = 0; step < NCH; ++step) {
    int rb, c; chunk32_of_step(step, b, d, rb, c);
    bfr* VTc = (step & 1) ? VT1 : VT0; bfr* VTn = (step & 1) ? VT0 : VT1;
    float* GCc = (step & 1) ? GC1 : GC0; float* GCn = (step & 1) ? GC0 : GC1;
    const bool more = step + 1 < NCH;
    __builtin_amdgcn_s_waitcnt(0x0F70);
    if (more) RW3_STAGE_LOWRANK();
    if (step > 0 && lr_mat) {
      int rbp, cp; chunk32_of_step(step - 1, b, d, rbp, cp);
      const int tl = (wave >> 1) * 64 + lane, i = tl >> 3, c8 = (tl & 7) * 8, t = d ? 31 - i : i;
      *(uint4*)(p.O + (size_t)(rbp + cp * 32 + t) * OLD + d * 2048 + 2 * 512 + h * 64 + c8) = *(const uint4*)(OST + i * LK + c8);
      if (tl < 32) p.bon[((size_t)d * T + rb + c * 32 + tl) * 8 + h] = BONL[tl];
    }
    if (step + 2 < NCH) rwkv3_prefetch(p, pfA, pfB, fw, step + 2, b, d, h);
    __syncthreads();
    if (wave == 0) {
#pragma unroll
      for (int q = 0; q < 3; ++q) {
        const int ta = q >> 1 | (q & 1), tb = q >> 1;
        const f32x4 a = mma16<2>(KH + ta * 16 * LK, LK, BC + tb * 16 * LK, LK, f32x4{0.f, 0.f, 0.f, 0.f});
#pragma unroll
        for (int r = 0; r < 4; ++r) { const int t = ta * 16 + (lane >> 4) * 4 + r, j = tb * 16 + (lane & 15); Lf[t * LFS + j] = (j < t) ? a[r] : 0.f; }
      }
      asm volatile("s_waitcnt lgkmcnt(0)" ::: "memory");
      if (lane < 32) {
        const int blk = lane >> 4, cc = lane & 15;
        float x[16];
#pragma unroll
        for (int i = 0; i < 16; ++i) x[i] = (i == cc) ? 1.f : 0.f;
#pragma unroll
        for (int i = 1; i < 16; ++i) {
          const float* lr = Lf + (16 * blk + i) * LFS + 16 * blk;
#pragma unroll
          for (int j4 = 0; j4 < (i + 3) / 4; ++j4) {
            const float4 l4 = *(const float4*)(lr + 4 * j4);
            const float la[4] = {l4.x, l4.y, l4.z, l4.w};
#pragma unroll
            for (int e = 0; e < 4; ++e) if (4 * j4 + e < i) x[i] -= la[e] * x[4 * j4 + e];
          }
          asm volatile("" ::: "memory");
        }
#pragma unroll
        for (int i = 0; i < 16; ++i) Tf[(16 * blk + i) * LFS + 16 * blk + cc] = x[i];
      }
      asm volatile("s_waitcnt lgkmcnt(0)" ::: "memory");
      {
        const f32x4 xa = bmm16(Lf + 16 * LFS, LFS, Tf, LFS, f32x4{0.f, 0.f, 0.f, 0.f});
#pragma unroll
        for (int r = 0; r < 4; ++r) TMPX[((lane >> 4) * 4 + r) * 16 + (lane & 15)] = xa[r];
        asm volatile("s_waitcnt lgkmcnt(0)" ::: "memory");
        const f32x4 ta2 = bmm16(Tf + 16 * LFS + 16, LFS, TMPX, 16, f32x4{0.f, 0.f, 0.f, 0.f});
#pragma unroll
        for (int r = 0; r < 4; ++r) Tf[(16 + (lane >> 4) * 4 + r) * LFS + (lane & 15)] = -ta2[r];
      }
      asm volatile("s_waitcnt lgkmcnt(0)" ::: "memory");
#pragma unroll
      for (int q = 0; q < 4; ++q) {
        const int idx = lane + 64 * q, i = idx >> 3, j4 = (idx & 7) * 4;
        float tvv[4];
#pragma unroll
        for (int e = 0; e < 4; ++e) tvv[e] = ((j4 >> 4) <= (i >> 4)) ? Tf[i * LFS + j4 + e] : 0.f;
        *(uint2*)(Tm + i * LJ + j4) = make_uint2(pack2(tvv[0], tvv[1]), pack2(tvv[2], tvv[3]));
      }
    } else if (wave < 4) {
#pragma unroll
      for (int u = 0; u < 4; ++u) {
        const int id = (wave - 1) * 4 + u, prod = 1 + (id >> 2), ta = (id >> 1) & 1, tb = id & 1;
        f32x4 a = f32x4{0.f, 0.f, 0.f, 0.f};
        const bfr* Aop = (prod == 2) ? BC : KC; const bfr* Bop = (prod == 1) ? KH : RH;
        if (tb <= ta) a = mma16<2>(Aop + tb * 16 * LK, LK, Bop + ta * 16 * LK, LK, a);
        const int t = ta * 16 + (lane & 15), j0 = tb * 16 + (lane >> 4) * 4;
        float v4[4];
#pragma unroll
        for (int r = 0; r < 4; ++r) { const int j = j0 + r; v4[r] = ((prod == 1) ? (j < t) : (j <= t)) ? a[r] : 0.f; }
        bfr* Dst = (prod == 1) ? Aak : (prod == 2 ? Arb : Ark);
        *(uint2*)(Dst + t * LJ + j0) = make_uint2(pack2(v4[0], v4[1]), pack2(v4[2], v4[3]));
      }
    } else {
      {
        const int tl = tid - 256, k = tl & 63, iq = (tl >> 6) * 8;
        unsigned bw[4], kw[4];
#pragma unroll
        for (int e = 0; e < 4; ++e) {
          bw[e] = (unsigned)BR[(iq + 2 * e) * LK + k] | ((unsigned)BR[(iq + 2 * e + 1) * LK + k] << 16);
          kw[e] = (unsigned)KR[(iq + 2 * e) * LK + k] | ((unsigned)KR[(iq + 2 * e + 1) * LK + k] << 16);
        }
        *(uint4*)(BTt + k * LJ + iq) = make_uint4(bw[0], bw[1], bw[2], bw[3]);
        *(uint4*)(KTt + k * LJ + iq) = make_uint4(kw[0], kw[1], kw[2], kw[3]);
      }
#pragma unroll
      for (int ti = 0; ti < 2; ++ti) {
        p1[ti] = mma16<2>(KH + ti * 16 * LK, LK, S0b + tv * 16 * LK, LK, f32x4{0.f, 0.f, 0.f, 0.f});
        p2[ti] = mma16<2>(RH + ti * 16 * LK, LK, S0b + tv * 16 * LK, LK, f32x4{0.f, 0.f, 0.f, 0.f});
      }
    }
    if (more) {
      if (wave >= 1 && wave < 4) { RW3_CUMSUM_TILE(GCn, wave - 1); RW3_CUMSUM_TILE(GCn, wave + 2); if (wave < 3) RW3_CUMSUM_TILE(GCn, wave + 5); }
      if (wave >= 4) RW3_VT(VTn, tid - 256);
    }
    __syncthreads();
    if (wave >= 4) {
      const int vrow = (tv * 16 + (lane & 15)) * LJ + (lane >> 4) * 4;
#pragma unroll
      for (int ti = 0; ti < 2; ++ti) {
        const f32x4 z = mma16<1>(Aak + ti * 16 * LJ, LJ, VTc + tv * 16 * LJ, LJ, p1[ti]);
        *(uint2*)(ZT + vrow + ti * 16) = make_uint2(pack2(-z[0], -z[1]), pack2(-z[2], -z[3]));
      }
#pragma unroll
      for (int ti = 0; ti < 2; ++ti) {
        const f32x4 uu = mma16<1>(Tm + ti * 16 * LJ, LJ, ZT + tv * 16 * LJ, LJ, f32x4{0.f, 0.f, 0.f, 0.f});
        *(uint2*)(UT + vrow + ti * 16) = make_uint2(pack2(uu[0], uu[1]), pack2(uu[2], uu[3]));
      }
#pragma unroll
      for (int ti = 0; ti < 2; ++ti) {
        f32x4 o = mma16<1>(Arb + ti * 16 * LJ, LJ, UT + tv * 16 * LJ, LJ, p2[ti]);
        o = mma16<1>(Ark + ti * 16 * LJ, LJ, VTc + tv * 16 * LJ, LJ, o);
#pragma unroll
        for (int r = 0; r < 4; ++r) OST[(ti * 16 + (lane >> 4) * 4 + r) * LK + tv * 16 + (lane & 15)] = f2bf(o[r]);
      }
#pragma unroll
      for (int sk = 0; sk < 4; ++sk) {
        const float gcx = __expf(GCc[sk * 16 + (lane & 15)]);
        f32x4 sn = Sm[sk] * gcx;
        sn = mma16<1>(UT + tv * 16 * LJ, LJ, BTt + sk * 16 * LJ, LJ, sn);
        sn = mma16<1>(VTc + tv * 16 * LJ, LJ, KTt + sk * 16 * LJ, LJ, sn);
        Sm[sk] = sn;
#pragma unroll
        for (int r = 0; r < 4; ++r) S0b[(tv * 16 + (lane >> 4) * 4 + r) * LK + sk * 16 + (lane & 15)] = f2bf(sn[r]);
      }
    }
    if (wave < 4 && more) {
      int rbn, cn; chunk32_of_step(step + 1, b, d, rbn, cn);
#pragma unroll 1
      for (int pass = 0; pass < 2; ++pass) {
#define EW_I ((tid >> 4) + 16 * pass)
#define EW_GC GCn
#define EW_RB rbn
#define EW_C cn
    {
      const int i = EW_I, t = d ? 31 - i : i;
      float rr[4], kk_[4];
      unpack4(*(const uint2*)(RK + i * 128 + c4), rr); unpack4(*(const uint2*)(RK + i * 128 + 64 + c4), kk_);
      const float4 g4 = *(const float4*)&Gf[i * 64 + c4], l4 = *(const float4*)&LWf[i * 64 + c4], ar4 = *(const float4*)&ARf[i * 64 + c4], gc4 = *(const float4*)&EW_GC[c4];
      const float gA[4] = {g4.x, g4.y, g4.z, g4.w}, lA[4] = {l4.x, l4.y, l4.z, l4.w}, arA[4] = {ar4.x, ar4.y, ar4.z, ar4.w}, gcA[4] = {gc4.x, gc4.y, gc4.z, gc4.w};
      const float a0A[4] = {a0v.x, a0v.y, a0v.z, a0v.w}, kkA[4] = {kkv.x, kkv.y, kkv.z, kkv.w}, kaA[4] = {kav.x, kav.y, kav.z, kav.w}, rkA[4] = {rkv.x, rkv.y, rkv.z, rkv.w};
      float a_[4], kraw[4], kd_[4]; float ss = 0.f;
#pragma unroll
      for (int e = 0; e < 4; ++e) { a_[e] = sigm(arA[e] + a0A[e]); kraw[e] = kk_[e] * kkA[e]; ss += kraw[e] * kraw[e]; kd_[e] = kk_[e] * (1.f + (a_[e] - 1.f) * kaA[e]); }
      ss = dpp_sum16(ss);
      const float rn = __builtin_amdgcn_rsqf(ss + EPS);
      float khv[4], rhv[4], bcv[4], kcv[4], btv[4], ktv[4]; float sb = 0.f;
#pragma unroll
      for (int e = 0; e < 4; ++e) {
        const float kn = kraw[e] * rn, bb = kn * a_[e];
        const float eI = __expf(gA[e]), eIm1 = __expf(gA[e] - lA[e]), eInv = __expf(-gA[e]), eC = __expf(gcA[e] - gA[e]);
        khv[e] = kn * eIm1; rhv[e] = rr[e] * eI; bcv[e] = bb * eInv; kcv[e] = kd_[e] * eInv;
        btv[e] = bb * eC; ktv[e] = kd_[e] * eC;
        sb += rr[e] * kd_[e] * rkA[e];
      }
      sb = dpp_sum16(sb);
      *(uint2*)(KH + i * LK + c4) = make_uint2(pack2(khv[0], khv[1]), pack2(khv[2], khv[3]));
      *(uint2*)(RH + i * LK + c4) = make_uint2(pack2(rhv[0], rhv[1]), pack2(rhv[2], rhv[3]));
      *(uint2*)(BC + i * LK + c4) = make_uint2(pack2(bcv[0], bcv[1]), pack2(bcv[2], bcv[3]));
      *(uint2*)(KC + i * LK + c4) = make_uint2(pack2(kcv[0], kcv[1]), pack2(kcv[2], kcv[3]));
      *(uint2*)(BR + i * LK + c4) = make_uint2(pack2(btv[0], btv[1]), pack2(btv[2], btv[3]));
      *(uint2*)(KR + i * LK + c4) = make_uint2(pack2(ktv[0], ktv[1]), pack2(ktv[2], ktv[3]));
      if ((tid & 15) == 0) BONL[t] = sb;
    }
#undef EW_I
#undef EW_GC
#undef EW_RB
#undef EW_C
      }
    }
    __syncthreads();
  }
  if (tid < 256) {
    int rb, c; chunk32_of_step(NCH - 1, b, d, rb, c);
    const int i = tid >> 3, c8 = (tid & 7) * 8, t = d ? 31 - i : i;
    *(uint4*)(p.O + (size_t)(rb + c * 32 + t) * OLD + d * 2048 + 2 * 512 + h * 64 + c8) = *(const uint4*)(OST + i * LK + c8);
  }
#undef RW3_STAGE_LOWRANK
#undef RW3_CUMSUM_TILE
#undef RW3_VT
}

DEVINL void ssm_prefetch(const Params& p, uint4& pf0, uint4& pf1, uint4& pf2, float& dtraw, int step, int b, int d, int h) {
  int rb, len, c; chunk_of_step(step, b, d, rb, len, c);
  const int tid = threadIdx.x, r = tid >> 3, g8 = (tid & 7) * 8, gq = h >> 2;
  const bfr* base = p.P + (size_t)(rb + c * 64 + r) * NINP + C_SSM + 512 + g8;
  pf0 = *(const uint4*)(base + h * 64); pf1 = *(const uint4*)(base + 512 + gq * 64); pf2 = *(const uint4*)(base + 640 + gq * 64);
  if (tid < 64) { const int t = c * 64 + (d ? 63 - tid : tid); dtraw = bf2f(p.P[(size_t)(rb + t) * NINP + C_SSM + 1280 + d * 8 + h]); }
}
template <int L>
DEVINL void scan_ssm2(const Params& p, int item, char* sm) {
  const int d = item & 1, h = (item >> 1) & 7, b = item >> 4;
  const int tid = threadIdx.x, lane = tid & 63, wave = tid >> 6;
  constexpr int LB = 72;
  bfr* Qm = (bfr*)sm; bfr* Qg = Qm + 64 * LB; bfr* Km = Qg + 64 * LB; bfr* K2T = Km + 64 * LB; bfr* VT = K2T + 64 * LB; bfr* SCm = VT + 64 * LB; bfr* ST = SCm + 64 * LB; bfr* OST = ST + 64 * LB;
  float* gsv = (float*)(OST + 64 * LB); float* dtv = gsv + 64;
  for (int i = tid; i < 64 * LB; i += NTHR) ST[i] = 0;
  const float dtb = p.ssm_dt_bias[L * 16 + d * 8 + h], Aneg = -__expf(p.ssm_a_log[L * 16 + d * 8 + h]);
  f32x4 Sm[2] = {f32x4{0.f, 0.f, 0.f, 0.f}, f32x4{0.f, 0.f, 0.f, 0.f}};
  uint4 pf0, pf1, pf2; float dtraw = 0.f;
  ssm_prefetch(p, pf0, pf1, pf2, dtraw, 0, b, d, h);
#pragma unroll 1
  for (int step = 0; step < 68; ++step) {
    int rb, len, c; chunk_of_step(step, b, d, rb, len, c);
    __syncthreads();
    if (tid < 64) {
      const float dt = softplus(dtraw + dtb);
      float la = dt * Aneg;
#pragma unroll
      for (int o = 1; o < 64; o <<= 1) { const float n = __shfl_up(la, o); if (tid >= o) la += n; }
      gsv[tid] = la; dtv[tid] = dt;
    }
    __syncthreads();
    const float g63 = gsv[63];
    {
      const int r = tid >> 3, g = tid & 7, i = d ? 63 - r : r;
      float y[8];
      unpack8(pf0, y);
#pragma unroll
      for (int e = 0; e < 8; ++e) VT[(g * 8 + e) * LB + i] = f2bf(y[e]);
      unpack8(pf1, y);
      const float dt = dtv[i], e2 = __expf(g63 - gsv[i]);
#pragma unroll
      for (int e = 0; e < 8; ++e) y[e] *= dt;
      *(uint4*)(Km + i * LB + g * 8) = make_uint4(pack2(y[0], y[1]), pack2(y[2], y[3]), pack2(y[4], y[5]), pack2(y[6], y[7]));
#pragma unroll
      for (int e = 0; e < 8; ++e) K2T[(g * 8 + e) * LB + i] = f2bf(y[e] * e2);
      unpack8(pf2, y);
      const float eg = __expf(gsv[i]);
      *(uint4*)(Qm + i * LB + g * 8) = pf2;
      *(uint4*)(Qg + i * LB + g * 8) = make_uint4(pack2(y[0] * eg, y[1] * eg), pack2(y[2] * eg, y[3] * eg), pack2(y[4] * eg, y[5] * eg), pack2(y[6] * eg, y[7] * eg));
    }
    __syncthreads();
    if (step + 1 < 68) ssm_prefetch(p, pf0, pf1, pf2, dtraw, step + 1, b, d, h);
#pragma unroll
    for (int u = 0; u < 2; ++u) {
      const int id = 2 * wave + u, ti = id >> 2, tj = id & 3;
      f32x4 a = f32x4{0.f, 0.f, 0.f, 0.f};
      if (tj <= ti) a = mma16<2>(Qm + ti * 16 * LB, LB, Km + tj * 16 * LB, LB, a);
#pragma unroll
      for (int r = 0; r < 4; ++r) {
        const int i = ti * 16 + (lane >> 4) * 4 + r, j = tj * 16 + (lane & 15);
        SCm[i * LB + j] = (j <= i) ? f2bf(a[r] * __expf(gsv[i] - gsv[j])) : (bfr)0;
      }
    }
    __syncthreads();
    const float sd = __expf(g63);
#pragma unroll
    for (int u = 0; u < 2; ++u) {
      const int id = 2 * wave + u, ti = id >> 2, tp = id & 3;
      f32x4 o = mma16<2>(SCm + ti * 16 * LB, LB, VT + tp * 16 * LB, LB, f32x4{0.f, 0.f, 0.f, 0.f});
      o = mma16<2>(Qg + ti * 16 * LB, LB, ST + tp * 16 * LB, LB, o);
#pragma unroll
      for (int r = 0; r < 4; ++r) OST[(ti * 16 + (lane >> 4) * 4 + r) * LB + tp * 16 + (lane & 15)] = f2bf(o[r]);
      Sm[u] = mma16<2>(K2T + ti * 16 * LB, LB, VT + tp * 16 * LB, LB, Sm[u] * sd);
    }
    __syncthreads();
#pragma unroll
    for (int u = 0; u < 2; ++u) {
      const int id = 2 * wave + u, tn = id >> 2, tp = id & 3;
      *(uint2*)(ST + (tp * 16 + (lane & 15)) * LB + tn * 16 + (lane >> 4) * 4) = make_uint2(pack2(Sm[u][0], Sm[u][1]), pack2(Sm[u][2], Sm[u][3]));
    }
    {
      const int i = tid >> 3, c8 = (tid & 7) * 8, t = d ? 63 - i : i;
      *(uint4*)(p.O + (size_t)(rb + c * 64 + t) * OLD + d * 2048 + 0 * 512 + h * 64 + c8) = *(const uint4*)(OST + i * LB + c8);
    }
  }
}

DEVINL void gla_prefetch(const Params& p, uint4 (&pf)[5], int step, int b, int d, int h) {
  int rb, len, c; chunk_of_step(step, b, d, rb, len, c);
#pragma unroll
  for (int q = 0; q < 5; ++q) {
    const int idx = threadIdx.x + NTHR * q;
    uint4 v = make_uint4(0, 0, 0, 0);
    if (idx < 64 * 34) {
      const int r = idx / 34, qq = idx % 34;
      const int col = qq < 8 ? h * 64 + qq * 8 : (qq < 16 ? 256 + h * 64 + (qq - 8) * 8 : (qq < 32 ? 512 + h * 128 + (qq - 16) * 8 : 1536 + d * 16 + (qq - 32) * 8));
      v = *(const uint4*)(p.P + (size_t)(rb + c * 64 + r) * NINP + C_GLA + col);
    }
    pf[q] = v;
  }
}
template <int L>
DEVINL void scan_gla2(const Params& p, int item, char* sm) {
  const int d = item & 1, h = (item >> 1) & 3, b = item >> 3;
  const int tid = threadIdx.x, lane = tid & 63, wave = tid >> 6;
  constexpr int LB = 72, LO = 136, LR = 272;
  bfr* Qg = (bfr*)sm; bfr* Kn = Qg + 64 * LB; bfr* K2T = Kn + 64 * LB; bfr* SCm = K2T + 64 * LB; bfr* VT = SCm + 64 * LB; bfr* ST = VT + 128 * LB; bfr* OST = ST + 128 * LB;
  bfr* RAWG = OST + 64 * LO;
  float* SEG = (float*)(RAWG + 64 * LR);
  float* sdec = SEG + 512;
  for (int i = tid; i < 128 * LB; i += NTHR) ST[i] = 0;
  float w2r[16];
  const int kch = tid & 63;
#pragma unroll
  for (int r = 0; r < 16; ++r) w2r[r] = p.gla_w2[((size_t)(L * 2 + d) * 16 + r) * 256 + h * 64 + kch];
  const float bk = p.gla_b[(L * 2 + d) * 256 + h * 64 + kch];
  f32x4 Sm[4];
#pragma unroll
  for (int u = 0; u < 4; ++u) Sm[u] = f32x4{0.f, 0.f, 0.f, 0.f};
  uint4 pf[5];
  gla_prefetch(p, pf, 0, b, d, h);
#pragma unroll 1
  for (int step = 0; step < 68; ++step) {
    int rb, len, c; chunk_of_step(step, b, d, rb, len, c);
    __syncthreads();
#pragma unroll
    for (int q = 0; q < 5; ++q) { const int idx = tid + NTHR * q; if (idx < 64 * 34) *(uint4*)(RAWG + (idx / 34) * LR + (idx % 34) * 8) = pf[q]; }
    __syncthreads();
    if (step + 1 < 68) gla_prefetch(p, pf, step + 1, b, d, h);
    float gl[8];
    {
      float run = 0.f;
#pragma unroll
      for (int q = 0; q < 8; ++q) {
        const int i = 8 * wave + q, t = d ? 63 - i : i;
        float gr[8]; float lg = bk;
        unpack8(*(const uint4*)(RAWG + t * LR + 256), gr);
#pragma unroll
        for (int r = 0; r < 8; ++r) lg += gr[r] * w2r[r];
        unpack8(*(const uint4*)(RAWG + t * LR + 264), gr);
#pragma unroll
        for (int r = 0; r < 8; ++r) lg += gr[r] * w2r[8 + r];
        run += -softplus(-lg) * (1.f / 16.f);
        gl[q] = run;
      }
      SEG[wave * 64 + kch] = run;
    }
    __syncthreads();
    {
      float pre = 0.f, tot = 0.f;
#pragma unroll
      for (int w = 0; w < 8; ++w) { const float sv = SEG[w * 64 + kch]; tot += sv; if (w < wave) pre += sv; }
      float k2v[8];
#pragma unroll
      for (int q = 0; q < 8; ++q) {
        const int i = 8 * wave + q, t = d ? 63 - i : i;
        const float gg = gl[q] + pre;
        const float qv = bf2f(RAWG[t * LR + kch]), kv = bf2f(RAWG[t * LR + 64 + kch]);
        Qg[i * LB + kch] = f2bf(qv * 0.125f * __expf(gg)); Kn[i * LB + kch] = f2bf(kv * __expf(-gg)); k2v[q] = kv * __expf(tot - gg);
      }
      *(uint4*)(K2T + kch * LB + 8 * wave) = make_uint4(pack2(k2v[0], k2v[1]), pack2(k2v[2], k2v[3]), pack2(k2v[4], k2v[5]), pack2(k2v[6], k2v[7]));
      if (wave == 0) sdec[kch] = __expf(tot);
      const int pp = tid & 127, i0 = (tid >> 7) * 16;
      float vv[16];
#pragma unroll
      for (int q = 0; q < 16; ++q) { const int i = i0 + q, t = d ? 63 - i : i; vv[q] = bf2f(RAWG[t * LR + 128 + pp]); }
      *(uint4*)(VT + pp * LB + i0) = make_uint4(pack2(vv[0], vv[1]), pack2(vv[2], vv[3]), pack2(vv[4], vv[5]), pack2(vv[6], vv[7]));
      *(uint4*)(VT + pp * LB + i0 + 8) = make_uint4(pack2(vv[8], vv[9]), pack2(vv[10], vv[11]), pack2(vv[12], vv[13]), pack2(vv[14], vv[15]));
    }
    __syncthreads();
#pragma unroll
    for (int u = 0; u < 2; ++u) {
      const int id = 2 * wave + u, ti = id >> 2, tj = id & 3;
      f32x4 a = f32x4{0.f, 0.f, 0.f, 0.f};
      if (tj <= ti) a = mma16<2>(Qg + ti * 16 * LB, LB, Kn + tj * 16 * LB, LB, a);
#pragma unroll
      for (int r = 0; r < 4; ++r) {
        const int i = ti * 16 + (lane >> 4) * 4 + r, j = tj * 16 + (lane & 15);
        SCm[i * LB + j] = (j <= i) ? f2bf(a[r]) : (bfr)0;
      }
    }
    __syncthreads();
#pragma unroll
    for (int u = 0; u < 4; ++u) {
      const int id = 4 * wave + u, ti = id >> 3, tp = id & 7;
      f32x4 o = mma16<2>(SCm + ti * 16 * LB, LB, VT + tp * 16 * LB, LB, f32x4{0.f, 0.f, 0.f, 0.f});
      o = mma16<2>(Qg + ti * 16 * LB, LB, ST + tp * 16 * LB, LB, o);
#pragma unroll
      for (int r = 0; r < 4; ++r) OST[(ti * 16 + (lane >> 4) * 4 + r) * LO + tp * 16 + (lane & 15)] = f2bf(o[r]);
      f32x4 sdv;
#pragma unroll
      for (int r = 0; r < 4; ++r) sdv[r] = sdec[ti * 16 + (lane >> 4) * 4 + r];
      Sm[u] = mma16<2>(K2T + ti * 16 * LB, LB, VT + tp * 16 * LB, LB, Sm[u] * sdv);
    }
    __syncthreads();
#pragma unroll
    for (int u = 0; u < 4; ++u) {
      const int id = 4 * wave + u, tk = id >> 3, tp = id & 7;
      *(uint2*)(ST + (tp * 16 + (lane & 15)) * LB + tk * 16 + (lane >> 4) * 4) = make_uint2(pack2(Sm[u][0], Sm[u][1]), pack2(Sm[u][2], Sm[u][3]));
    }
    {
      const int i = tid >> 3, t = d ? 63 - i : i;
#pragma unroll
      for (int q = 0; q < 2; ++q) {
        const int c8 = (tid & 7) * 8 + q * 64;
        *(uint4*)(p.O + (size_t)(rb + c * 64 + t) * OLD + d * 2048 + 1 * 512 + h * 128 + c8) = *(const uint4*)(OST + i * LO + c8);
      }
    }
  }
}


DEVINL void gdn_prefetch(const Params& p, uint4& pf0, uint4& pf1, uint4& pf2, uint4& pf3, uint4& pf4, bfr& araw, bfr& braw, int step, int b, int d, int h, int vh) {
  int rb, len, c; chunk_of_step(step, b, d, rb, len, c);
  const int tid = threadIdx.x;
  const bfr* base = p.P + (size_t)(rb + c * 64) * NINP + C_GDN;
  { const int r = tid >> 4, g = tid & 15;
    pf0 = *(const uint4*)(base + (size_t)r * NINP + h * 128 + g * 8); pf1 = *(const uint4*)(base + (size_t)(r + 32) * NINP + h * 128 + g * 8);
    pf2 = *(const uint4*)(base + (size_t)r * NINP + 512 + h * 128 + g * 8); pf3 = *(const uint4*)(base + (size_t)(r + 32) * NINP + 512 + h * 128 + g * 8); }
  { const int r = tid >> 3, g = tid & 7; pf4 = *(const uint4*)(base + (size_t)r * NINP + 1024 + h * 128 + vh * 64 + g * 8); }
  if (tid >= 64 && tid < 128) {
    const int tl = tid - 64, t = c * 64 + (d ? 63 - tl : tl);
    const bfr* pr = p.P + (size_t)(rb + t) * NINP + C_GDN;
    araw = pr[2048 + d * 4 + h]; braw = pr[2056 + d * 4 + h];
  }
}
template <int L>
DEVINL void scan_gdn2(const Params& p, int item, char* sm) {
  const int vh = item & 1, d = (item >> 1) & 1, h = (item >> 2) & 3, b = item >> 4;
  const int tid = threadIdx.x, lane = tid & 63, wave = __builtin_amdgcn_readfirstlane(tid >> 6);
  constexpr int LQ = 136, LB = 72, LF = 68;
  bfr* QN = (bfr*)sm; bfr* KN = QN + 64 * LQ; bfr* U0 = KN + 64 * LQ; bfr* KdT = U0 + 64 * LB; bfr* Tm = KdT + 128 * LB; bfr* ATm = Tm + 64 * LB; bfr* ST = ATm + 64 * LB;
  float* SMALL = (float*)(ST + 64 * LQ);
  float* TMPX = SMALL + 512;
  bfr* ZT = (bfr*)(TMPX + 6 * 256);
  char* REG = (char*)(ZT + 64 * LB);
  float* Lf = (float*)REG; float* Tf = Lf + 64 * LF;
  bfr* VnT = (bfr*)REG; bfr* OST = VnT + 64 * LB;
  for (int i = tid; i < 64 * LQ; i += NTHR) ST[i] = 0;
  const float Aneg = -__expf(p.gdn_a_log[L * 8 + d * 4 + h]), dtb = p.gdn_dt_bias[L * 8 + d * 4 + h];
  f32x4 Sm[4];
#pragma unroll
  for (int u = 0; u < 4; ++u) Sm[u] = f32x4{0.f, 0.f, 0.f, 0.f};
  uint4 pf0, pf1, pf2, pf3, pf4; bfr araw = 0, braw = 0;
  gdn_prefetch(p, pf0, pf1, pf2, pf3, pf4, araw, braw, 0, b, d, h, vh);
#define GDN_GBETA(DST) do { \
    float g_ = Aneg * softplus(bf2f(araw) + dtb); const float beta_ = sigm(bf2f(braw)); \
    _Pragma("unroll") for (int o_ = 1; o_ < 64; o_ <<= 1) { const float n_ = __shfl_up(g_, o_); if (lane >= o_) g_ += n_; } \
    const float g63_ = __shfl(g_, 63); \
    (DST)[lane] = g_; (DST)[64 + lane] = beta_; (DST)[128 + lane] = __expf(g63_ - g_); (DST)[192 + lane] = __expf(g_); } while (0)
  if (wave == 1) GDN_GBETA(SMALL);
  __syncthreads();
#pragma unroll 1
  for (int step = 0; step < 68; ++step) {
    int rb, len, c; chunk_of_step(step, b, d, rb, len, c);
    float* Gs = SMALL + (step & 1) * 256; float* Bts = Gs + 64; float* EK = Bts + 64; float* EG = EK + 64;
    float* SMn = SMALL + ((step + 1) & 1) * 256;
    __builtin_amdgcn_s_waitcnt(0x0F70);
    {
      const int r = tid >> 4, g = tid & 15, i0 = d ? 63 - r : r, i1 = d ? 31 - r : r + 32;
      *(uint4*)(QN + i0 * LQ + g * 8) = pf0; *(uint4*)(QN + i1 * LQ + g * 8) = pf1;
      *(uint4*)(KN + i0 * LQ + g * 8) = pf2; *(uint4*)(KN + i1 * LQ + g * 8) = pf3;
    }
    {
      const int r = tid >> 3, g = tid & 7, i = d ? 63 - r : r;
      float y[8]; unpack8(pf4, y);
      const float bt = Bts[i];
      *(uint4*)(U0 + i * LB + g * 8) = make_uint4(pack2(y[0] * bt, y[1] * bt), pack2(y[2] * bt, y[3] * bt), pack2(y[4] * bt, y[5] * bt), pack2(y[6] * bt, y[7] * bt));
    }
    if (step > 0) {
      int rbp, lenp, cp; chunk_of_step(step - 1, b, d, rbp, lenp, cp);
      const int i = tid >> 3, c8 = (tid & 7) * 8, t = d ? 63 - i : i;
      *(uint4*)(p.O + (size_t)(rbp + cp * 64 + t) * OLD + d * 2048 + 3 * 512 + h * 128 + vh * 64 + c8) = *(const uint4*)(OST + i * LB + c8);
    }
    if (step + 1 < 68) gdn_prefetch(p, pf0, pf1, pf2, pf3, pf4, araw, braw, step + 1, b, d, h, vh);
    __syncthreads();
    {
      const int k = tid & 127, jq = (tid >> 7) * 16;
      float v[16];
#pragma unroll
      for (int q = 0; q < 16; ++q) v[q] = bf2f(KN[(jq + q) * LQ + k]) * EK[jq + q];
      *(uint4*)(KdT + k * LB + jq) = make_uint4(pack2(v[0], v[1]), pack2(v[2], v[3]), pack2(v[4], v[5]), pack2(v[6], v[7]));
      *(uint4*)(KdT + k * LB + jq + 8) = make_uint4(pack2(v[8], v[9]), pack2(v[10], v[11]), pack2(v[12], v[13]), pack2(v[14], v[15]));
    }
#pragma unroll 1
    for (int u = 0; u < 4; ++u) {
      const int id = 4 * wave + u;
      if (id < 16) {
        const int ti = id >> 2, tj = id & 3;
        if (tj <= ti) {
          const f32x4 a = mma16<4>(KN + ti * 16 * LQ, LQ, KN + tj * 16 * LQ, LQ, f32x4{0.f, 0.f, 0.f, 0.f});
#pragma unroll
          for (int r = 0; r < 4; ++r) {
            const int i = ti * 16 + (lane >> 4) * 4 + r, j = tj * 16 + (lane & 15);
            Lf[i * LF + j] = (j < i) ? a[r] * __expf(Gs[i] - Gs[j]) * Bts[i] : 0.f;
          }
        }
      } else {
        const int ti = (id - 16) >> 2, tj = (id - 16) & 3;
        f32x4 a = f32x4{0.f, 0.f, 0.f, 0.f};
        if (tj <= ti) a = mma16<4>(KN + tj * 16 * LQ, LQ, QN + ti * 16 * LQ, LQ, a);
        const int i = ti * 16 + (lane & 15), j0 = tj * 16 + (lane >> 4) * 4;
        float v4[4];
#pragma unroll
        for (int r = 0; r < 4; ++r) { const int j = j0 + r; v4[r] = (j <= i) ? a[r] * __expf(Gs[i] - Gs[j]) : 0.f; }
        *(uint2*)(ATm + i * LB + j0) = make_uint2(pack2(v4[0], v4[1]), pack2(v4[2], v4[3]));
      }
    }
    __syncthreads();
    f32x4 o1[4];
    if (wave == 1) { if (step + 1 < 68) GDN_GBETA(SMn); }
    else if (wave >= 4) {
#pragma unroll
      for (int u = 0; u < 4; ++u) {
        const int id = 4 * (wave - 4) + u, ti = id >> 2, tv = id & 3;
        const f32x4 y = mma16<4>(KN + ti * 16 * LQ, LQ, ST + tv * 16 * LQ, LQ, f32x4{0.f, 0.f, 0.f, 0.f});
        f32x4 q1 = mma16<4>(QN + ti * 16 * LQ, LQ, ST + tv * 16 * LQ, LQ, f32x4{0.f, 0.f, 0.f, 0.f});
        const int i0 = ti * 16 + (lane >> 4) * 4, v = tv * 16 + (lane & 15);
        float z[4];
#pragma unroll
        for (int r = 0; r < 4; ++r) { const int i = i0 + r; const float eg = EG[i]; z[r] = bf2f(U0[i * LB + v]) - Bts[i] * eg * y[r]; q1[r] *= eg; }
        o1[u] = q1;
        *(uint2*)(ZT + v * LB + i0) = make_uint2(pack2(z[0], z[1]), pack2(z[2], z[3]));
        asm volatile("" ::: "memory");
      }
    }
    if (wave == 0) {
      const int blk = lane >> 4, cc = lane & 15;
      float x[16];
#pragma unroll
      for (int i = 0; i < 16; ++i) x[i] = (i == cc) ? 1.f : 0.f;
#pragma unroll
      for (int i = 1; i < 16; ++i) {
        const float* lr = Lf + (16 * blk + i) * LF + 16 * blk;
#pragma unroll
        for (int j4 = 0; j4 < (i + 3) / 4; ++j4) {
          const float4 l4 = *(const float4*)(lr + 4 * j4);
          const float la[4] = {l4.x, l4.y, l4.z, l4.w};
#pragma unroll
          for (int e = 0; e < 4; ++e) if (4 * j4 + e < i) x[i] -= la[e] * x[4 * j4 + e];
        }
        asm volatile("" ::: "memory");
      }
#pragma unroll
      for (int i = 0; i < 16; ++i) Tf[(16 * blk + i) * LF + 16 * blk + cc] = x[i];
    }
    __syncthreads();
    if (wave < 3) {
      const int bi = wave + 1, bj = wave;
      f32x4 xa = bmm16(Lf + 16 * bi * LF + 16 * bj, LF, Tf + 16 * bj * LF + 16 * bj, LF, f32x4{0.f, 0.f, 0.f, 0.f});
      float* X = TMPX + wave * 256;
#pragma unroll
      for (int r = 0; r < 4; ++r) X[((lane >> 4) * 4 + r) * 16 + (lane & 15)] = xa[r];
      asm volatile("s_waitcnt lgkmcnt(0)" ::: "memory");
      const f32x4 ta = bmm16(Tf + 16 * bi * LF + 16 * bi, LF, X, 16, f32x4{0.f, 0.f, 0.f, 0.f});
#pragma unroll
      for (int r = 0; r < 4; ++r) Tf[(16 * bi + (lane >> 4) * 4 + r) * LF + 16 * bj + (lane & 15)] = -ta[r];
    }
    __syncthreads();
    if (wave < 2) {
      const int bi = wave + 2, bj = wave;
      f32x4 xa = bmm16(Lf + 16 * bi * LF + 16 * bj, LF, Tf + 16 * bj * LF + 16 * bj, LF, f32x4{0.f, 0.f, 0.f, 0.f});
      xa = bmm16(Lf + 16 * bi * LF + 16 * (bj + 1), LF, Tf + 16 * (bj + 1) * LF + 16 * bj, LF, xa);
      float* X = TMPX + (3 + wave) * 256;
#pragma unroll
      for (int r = 0; r < 4; ++r) X[((lane >> 4) * 4 + r) * 16 + (lane & 15)] = xa[r];
      asm volatile("s_waitcnt lgkmcnt(0)" ::: "memory");
      const f32x4 ta = bmm16(Tf + 16 * bi * LF + 16 * bi, LF, X, 16, f32x4{0.f, 0.f, 0.f, 0.f});
#pragma unroll
      for (int r = 0; r < 4; ++r) Tf[(16 * bi + (lane >> 4) * 4 + r) * LF + 16 * bj + (lane & 15)] = -ta[r];
    }
    __syncthreads();
    if (wave == 0) {
      f32x4 xa = bmm16(Lf + 48 * LF, LF, Tf, LF, f32x4{0.f, 0.f, 0.f, 0.f});
      xa = bmm16(Lf + 48 * LF + 16, LF, Tf + 16 * LF, LF, xa);
      xa = bmm16(Lf + 48 * LF + 32, LF, Tf + 32 * LF, LF, xa);
      float* X = TMPX + 5 * 256;
#pragma unroll
      for (int r = 0; r < 4; ++r) X[((lane >> 4) * 4 + r) * 16 + (lane & 15)] = xa[r];
      asm volatile("s_waitcnt lgkmcnt(0)" ::: "memory");
      const f32x4 ta = bmm16(Tf + 48 * LF + 48, LF, X, 16, f32x4{0.f, 0.f, 0.f, 0.f});
#pragma unroll
      for (int r = 0; r < 4; ++r) Tf[(48 + (lane >> 4) * 4 + r) * LF + (lane & 15)] = -ta[r];
    }
    __syncthreads();
    for (int idx = tid; idx < 64 * 16; idx += NTHR) {
      const int i = idx >> 4, j4 = (idx & 15) * 4;
      float tv[4];
#pragma unroll
      for (int e = 0; e < 4; ++e) tv[e] = ((j4 >> 4) <= (i >> 4)) ? Tf[i * LF + j4 + e] : 0.f;
      *(uint2*)(Tm + i * LB + j4) = make_uint2(pack2(tv[0], tv[1]), pack2(tv[2], tv[3]));
    }
    __syncthreads();
#pragma unroll
    for (int u = 0; u < 2; ++u) {
      const int id = 2 * wave + u, ti = id >> 2, tv = id & 3;
      const f32x4 vn = mma16<2>(Tm + ti * 16 * LB, LB, ZT + tv * 16 * LB, LB, f32x4{0.f, 0.f, 0.f, 0.f});
      *(uint2*)(VnT + (tv * 16 + (lane & 15)) * LB + ti * 16 + (lane >> 4) * 4) = make_uint2(pack2(vn[0], vn[1]), pack2(vn[2], vn[3]));
    }
    __syncthreads();
    {
      const float gl = __expf(Gs[63]);
      if (wave >= 4) {
#pragma unroll
        for (int u = 0; u < 4; ++u) {
          const int id = 4 * (wave - 4) + u, ti = id >> 2, tv = id & 3;
          const f32x4 o = mma16<2>(ATm + ti * 16 * LB, LB, VnT + tv * 16 * LB, LB, o1[u]);
#pragma unroll
          for (int r = 0; r < 4; ++r) OST[(ti * 16 + (lane >> 4) * 4 + r) * LB + tv * 16 + (lane & 15)] = f2bf(o[r]);
        }
      }
#pragma unroll
      for (int u = 0; u < 4; ++u) {
        const int id = 4 * wave + u, tk = id >> 2, tv = id & 3;
        Sm[u] = mma16<2>(KdT + tk * 16 * LB, LB, VnT + tv * 16 * LB, LB, Sm[u] * gl);
        *(uint2*)(ST + (tv * 16 + (lane & 15)) * LQ + tk * 16 + (lane >> 4) * 4) = make_uint2(pack2(Sm[u][0], Sm[u][1]), pack2(Sm[u][2], Sm[u][3]));
        asm volatile("" ::: "memory");
      }
    }
    __syncthreads();
  }
  {
    int rb, len, c; chunk_of_step(67, b, d, rb, len, c);
    const int i = tid >> 3, c8 = (tid & 7) * 8, t = d ? 63 - i : i;
    *(uint4*)(p.O + (size_t)(rb + c * 64 + t) * OLD + d * 2048 + 3 * 512 + h * 128 + vh * 64 + c8) = *(const uint4*)(OST + i * LB + c8);
  }
#undef GDN_GBETA
}

template <int L> DEVINL void phase_gproj(const Params& p, char* sm, int c);
template <int L>
DEVINL void phase_scans(const Params& p, char* sm) {
  const int it = blockIdx.x;
  if (it < 64) scan_rwkv3<L>(p, it, sm);
  else if (it < 128) scan_gdn2<L>(p, it - 64, sm);
  else if (it < 192) scan_ssm2<L>(p, it - 128, sm);
  else if (it < 224) scan_gla2<L>(p, it - 192, sm);
  else {
    phase_gproj<L>(p, sm, it - 224);
  }
}

template <int L>
DEVINL void phase_post2(const Params& p) {
  const int lane = threadIdx.x & 63, wave = threadIdx.x >> 6;
  const int nrows = (L == 1) ? TL : T;
  const int c8 = lane * 8;
  float pw_ssm[8], pw_gla[8], pw_lnw[8], pw_lnb[8], pw_gdn[8];
#pragma unroll
  for (int e = 0; e < 8; ++e) {
    pw_ssm[e] = p.ssm_norm[L * 512 + c8 + e]; pw_gla[e] = p.gla_norm[L * 128 + ((c8 + e) & 127)]; pw_lnw[e] = p.rwkv_ln_w[L * 512 + c8 + e];
    pw_lnb[e] = p.rwkv_ln_b[L * 512 + c8 + e]; pw_gdn[e] = p.gdn_norm[L * 128 + ((c8 + e) & 127)];
  }
  const float dssm = p.ssm_d[L * 8 + (lane >> 3)];
  for (int R = blockIdx.x * 8 + wave; R < nrows; R += gridDim.x * 8) {
    const bool lat = R < TL; const int vvb = lat ? (R >> 12) : 4;
    bfr* orow = p.O + (size_t)R * OLD; const bfr* prow = p.P + (size_t)R * NINP;
    uint4 of_[4], ob_[4];
#pragma unroll
    for (int m = 0; m < 4; ++m) { of_[m] = *(const uint4*)(orow + m * 512 + c8); ob_[m] = *(const uint4*)(orow + 2048 + m * 512 + c8); }
    const uint4 pxh = *(const uint4*)(prow + C_SSM + 512 + c8), pz = *(const uint4*)(prow + C_SSM + c8), prg = *(const uint4*)(prow + C_GLA + 1024 + c8);
    const uint4 pv = *(const uint4*)(prow + C_RWKV + 1024 + c8), pzg = *(const uint4*)(prow + C_GDN + 1536 + c8), pgg = *(const uint4*)(p.Gb + (size_t)R * 512 + c8);
    const int cr = lat ? canon_row(L, R) : R;
    const float* xp = lat ? p.out + (size_t)cr * D : p.xc + (size_t)(R - TL) * D;
    float4 xv[4];
#pragma unroll
    for (int q = 0; q < 4; ++q) xv[q] = *(const float4*)(xp + q * 256 + lane * 4);
    const float bsum = p.bon[((size_t)0 * T + R) * 8 + (lane >> 3)] + p.bon[((size_t)1 * T + R) * 8 + (lane >> 3)];
    float a[8], b[8], t1[8], t2[8];
    float y0[8]; float ss0 = 0.f;
    unpack8(of_[0], a); unpack8(ob_[0], b); unpack8(pxh, t1); unpack8(pz, t2);
#pragma unroll
    for (int e = 0; e < 8; ++e) { y0[e] = (a[e] + b[e] + dssm * t1[e]) * silu(t2[e]); ss0 += y0[e] * y0[e]; }
    ss0 = dpp_sum16(ss0); ss0 += __shfl_xor(ss0, 16);
    float y1[8]; float ss1 = 0.f;
    unpack8(of_[1], a); unpack8(ob_[1], b); unpack8(prg, t1);
#pragma unroll
    for (int e = 0; e < 8; ++e) { y1[e] = a[e] + b[e]; ss1 += y1[e] * y1[e]; }
    ss1 = dpp_sum16(ss1);
    const float r1 = __builtin_amdgcn_rsqf(ss1 * (1.f / 128.f) + EPS);
#pragma unroll
    for (int e = 0; e < 8; ++e) y1[e] = y1[e] * r1 * pw_gla[e] * silu(t1[e]);
    float y2[8]; float s2 = 0.f;
    unpack8(of_[2], a); unpack8(ob_[2], b); unpack8(pv, t1); unpack8(pgg, t2);
#pragma unroll
    for (int e = 0; e < 8; ++e) { y2[e] = a[e] + b[e]; s2 += y2[e]; }
    const float mu = dpp_sum8(s2) * (1.f / 64.f);
    float v2 = 0.f;
#pragma unroll
    for (int e = 0; e < 8; ++e) { y2[e] -= mu; v2 += y2[e] * y2[e]; }
    const float r2 = __builtin_amdgcn_rsqf(dpp_sum8(v2) * (1.f / 64.f) + 64e-5f);
#pragma unroll
    for (int e = 0; e < 8; ++e) y2[e] = (y2[e] * r2 * pw_lnw[e] + pw_lnb[e] + bsum * t1[e]) * t2[e];
    float y3[8]; float ss3 = 0.f;
    unpack8(of_[3], a); unpack8(ob_[3], b); unpack8(pzg, t1);
#pragma unroll
    for (int e = 0; e < 8; ++e) { y3[e] = a[e] + b[e]; ss3 += y3[e] * y3[e]; }
    ss3 = dpp_sum16(ss3);
    const float r3 = __builtin_amdgcn_rsqf(ss3 * (1.f / 128.f) + EPS);
#pragma unroll
    for (int e = 0; e < 8; ++e) y3[e] = y3[e] * r3 * pw_gdn[e] * silu(t1[e]);
    const float r0 = __builtin_amdgcn_rsqf(ss0 * (1.f / 256.f) + EPS);
#pragma unroll
    for (int e = 0; e < 8; ++e) y0[e] = y0[e] * r0 * pw_ssm[e];
    float xs = 0.f;
#pragma unroll
    for (int q = 0; q < 4; ++q) xs += xv[q].x * xv[q].x + xv[q].y * xv[q].y + xv[q].z * xv[q].z + xv[q].w * xv[q].w;
    xs = wave_sum(xs);
    const float rs = __builtin_amdgcn_rsqf(xs * (1.f / 1024.f) + EPS);
    const float* md = p.mod + ((size_t)L * 5 + vvb) * 6144;
    *(uint4*)(orow + 0 * 512 + c8) = make_uint4(pack2(y0[0], y0[1]), pack2(y0[2], y0[3]), pack2(y0[4], y0[5]), pack2(y0[6], y0[7]));
    *(uint4*)(orow + 1 * 512 + c8) = make_uint4(pack2(y1[0], y1[1]), pack2(y1[2], y1[3]), pack2(y1[4], y1[5]), pack2(y1[6], y1[7]));
    *(uint4*)(orow + 2 * 512 + c8) = make_uint4(pack2(y2[0], y2[1]), pack2(y2[2], y2[3]), pack2(y2[4], y2[5]), pack2(y2[6], y2[7]));
    *(uint4*)(orow + 3 * 512 + c8) = make_uint4(pack2(y3[0], y3[1]), pack2(y3[2], y3[3]), pack2(y3[4], y3[5]), pack2(y3[6], y3[7]));
#pragma unroll
    for (int q = 0; q < 4; ++q) {
      const int j = q * 256 + lane * 4;
      const float4 nw = *(const float4*)(p.norm_mix + L * D + j), sh = *(const float4*)(md + j), scl = *(const float4*)(md + 1024 + j);
      const float h0 = xv[q].x * rs * nw.x * (1.f + scl.x) + sh.x, h1 = xv[q].y * rs * nw.y * (1.f + scl.y) + sh.y;
      const float h2 = xv[q].z * rs * nw.z * (1.f + scl.z) + sh.z, h3 = xv[q].w * rs * nw.w * (1.f + scl.w) + sh.w;
      *(uint2*)(orow + 2048 + j) = make_uint2(pack2(h0, h1), pack2(h2, h3));
    }
  }
}

template <int L>
DEVINL void phase_route(const Params& p, char* sm) {
  const int tid = threadIdx.x, lane = tid & 63, wave = tid >> 6;
  float* rw = (float*)sm;
  __syncthreads();
  for (int i = tid; i < 1024 * 16; i += NTHR) rw[(i & 15) * 1024 + (i >> 4)] = p.router_w[i];
  __syncthreads();
  const int ntok = (L == 1) ? TL : T;
  for (int tk = blockIdx.x * 8 + wave; tk < ntok; tk += gridDim.x * 8) {
    const bool lat = tk < TL;
    const int vv = lat ? (tk >> 12) : 4;
    const float* xp = lat ? p.out + (size_t)tk * D : p.xc + (size_t)(tk - TL) * D;
    float ss = 0.f;
#pragma unroll
    for (int q = 0; q < 4; ++q) {
      const float4 xv = *(const float4*)(xp + q * 256 + lane * 4);
      ss += xv.x * xv.x + xv.y * xv.y + xv.z * xv.z + xv.w * xv.w;
    }
    ss = wave_sum(ss);
    const float rs = rsqrtf(ss * (1.f / 1024.f) + EPS);
    const float* md = p.mod + ((size_t)L * 5 + vv) * 6144;
    float lg[16];
#pragma unroll
    for (int e = 0; e < 16; ++e) lg[e] = 0.f;
#pragma unroll 1
    for (int q = 0; q < 4; ++q) {
      const int j = q * 256 + lane * 4;
      const float4 xv = *(const float4*)(xp + j);
      const float4 nw = *(const float4*)(p.norm_ffn + L * D + j), sh = *(const float4*)(md + 3 * 1024 + j), scl = *(const float4*)(md + 4 * 1024 + j);
      float hv[4];
      hv[0] = xv.x * rs * nw.x * (1.f + scl.x) + sh.x; hv[1] = xv.y * rs * nw.y * (1.f + scl.y) + sh.y;
      hv[2] = xv.z * rs * nw.z * (1.f + scl.z) + sh.z; hv[3] = xv.w * rs * nw.w * (1.f + scl.w) + sh.w;
      uint2 o; o.x = (unsigned)f2bf(hv[0]) | ((unsigned)f2bf(hv[1]) << 16); o.y = (unsigned)f2bf(hv[2]) | ((unsigned)f2bf(hv[3]) << 16);
      *(uint2*)(p.HF + (size_t)tk * D + j) = o;
#pragma unroll
      for (int e = 0; e < 16; ++e) {
        const float4 r4 = *(const float4*)&rw[e * 1024 + j];
        lg[e] += hv[0] * r4.x + hv[1] * r4.y + hv[2] * r4.z + hv[3] * r4.w;
      }
    }
    {
      float sel = 0.f;
#pragma unroll
      for (int e = 0; e < 16; ++e) { const float rsum = dpp_sum16(lg[e]); sel = ((lane & 15) == e) ? rsum : sel; }
      sel += __shfl_xor(sel, 16); sel += __shfl_xor(sel, 32);
#pragma unroll
      for (int e = 0; e < 16; ++e) lg[e] = __int_as_float(__builtin_amdgcn_readlane(__float_as_int(sel), e));
    }
    if (lane == 0) {
      float sc[16], sel[16];
#pragma unroll
      for (int e = 0; e < 16; ++e) { sc[e] = sigm(lg[e]); sel[e] = sc[e] + p.router_b[e]; }
      int bg = 0; float bgs = -1e30f;
#pragma unroll
      for (int g = 0; g < 4; ++g) {
        float m1 = -1e30f, m2 = -1e30f;
#pragma unroll
        for (int u = 0; u < 4; ++u) { const float s = sel[g * 4 + u]; if (s > m1) { m2 = m1; m1 = s; } else if (s > m2) m2 = s; }
        const float gs = m1 + m2;
        if (gs > bgs) { bgs = gs; bg = g; }
      }
      int i1 = 0, i2 = 0; float m1 = -1e30f, m2 = -1e30f;
#pragma unroll
      for (int u = 0; u < 4; ++u) {
        float s = 0.f, c2 = 0.f;
#pragma unroll
        for (int g = 0; g < 4; ++g) if (g == bg) { s = sel[g * 4 + u]; }
        (void)c2;
        if (s > m1) { m2 = m1; i2 = i1; m1 = s; i1 = u; } else if (s > m2) { m2 = s; i2 = u; }
      }
      const int e1 = bg * 4 + i1, e2 = bg * 4 + i2;
      float s1 = 0.f, s2 = 0.f;
#pragma unroll
      for (int e = 0; e < 16; ++e) { if (e == e1) s1 = sc[e]; if (e == e2) s2 = sc[e]; }
      const float inv = 1.f / (s1 + s2);
      const int p1 = atomicAdd(&p.cnt[L * 16 + e1], 1), p2 = atomicAdd(&p.cnt[L * 16 + e2], 1);
      p.list[(size_t)e1 * T + p1] = tk * 2; p.list[(size_t)e2 * T + p2] = tk * 2 + 1;
      p.gatew[tk * 2] = s1 * inv; p.gatew[tk * 2 + 1] = s2 * inv;
    }
  }
}

namespace g8 {
DEVINL uint4 pack8(const f32x4& a, const f32x4& b) { return make_uint4(pack2(a[0], a[1]), pack2(a[2], a[3]), pack2(b[0], b[1]), pack2(b[2], b[3])); }
struct EpiP {
  static constexpr bool PERM = true;
  bfr* C; int ldc; int act;
  DEVINL void operator()(const Acc& acc, const Unit& u, int wr, int wc, int fr, int fq) const {
    const int row0 = u.pm * 256 + wr * 64 + fr, col0 = u.pn * 256 + wc * 32 + 8 * fq;
#pragma unroll
    for (int ai = 0; ai < 2; ++ai)
#pragma unroll
      for (int m = 0; m < 4; ++m) {
        bfr* rowp = C + (size_t)(row0 + ai * 128 + m * 16) * ldc + col0;
#pragma unroll
        for (int bj = 0; bj < 2; ++bj) {
          f32x4 v0 = acc[ai][bj][m][0], v1 = acc[ai][bj][m][1];
          if (act) {
#pragma unroll
            for (int j = 0; j < 4; ++j) { v0[j] = sigm(v0[j]); v1[j] = sigm(v1[j]); }
          }
          *(uint4*)(rowp + bj * 128) = pack8(v0, v1);
        }
      }
  }
};
struct EpiBranch {
  static constexpr bool PERM = true;
  bfr* ACC; const bfr* GATES;
  DEVINL void operator()(const Acc& acc, const Unit& u, int wr, int wc, int fr, int fq) const {
    const int row0 = u.pm * 256 + wr * 64 + fr, col0 = u.pn * 256 + wc * 32 + 8 * fq;
#pragma unroll
    for (int ai = 0; ai < 2; ++ai) {
      uint4 gq[4][2], pq[4][2];
#pragma unroll
      for (int m = 0; m < 4; ++m)
#pragma unroll
        for (int bj = 0; bj < 2; ++bj) {
          const size_t row = (size_t)(row0 + ai * 128 + m * 16); const int col = col0 + bj * 128;
          gq[m][bj] = *(const uint4*)(GATES + row * 4096 + u.e * 1024 + col);
          pq[m][bj] = u.e ? *(const uint4*)(ACC + row * 1024 + col) : make_uint4(0, 0, 0, 0);
        }
#pragma unroll
      for (int m = 0; m < 4; ++m)
#pragma unroll
        for (int bj = 0; bj < 2; ++bj) {
          const size_t row = (size_t)(row0 + ai * 128 + m * 16); const int col = col0 + bj * 128;
          float gt[8], pv[8];
          unpack8(gq[m][bj], gt); unpack8(pq[m][bj], pv);
          f32x4 v0, v1;
#pragma unroll
          for (int j = 0; j < 4; ++j) { v0[j] = pv[j] + gt[j] * acc[ai][bj][m][0][j]; v1[j] = pv[4 + j] + gt[4 + j] * acc[ai][bj][m][1][j]; }
          *(uint4*)(ACC + row * 1024 + col) = pack8(v0, v1);
        }
    }
  }
};
struct EpiOut {
  static constexpr bool PERM = false;
  float* xlat; float* xctx; const float* mod; int layer;
  DEVINL void operator()(const Acc& acc, const Unit& u, int wr, int wc, int fr, int fq) const {
    const int row0 = u.pm * 256 + wr * 64 + fr, col0 = u.pn * 256 + wc * 32 + 4 * fq;
#pragma unroll
    for (int ai = 0; ai < 2; ++ai) {
      float4 xq[4][2][2];
      float* xpp[4];
      const float* m2p = nullptr;
#pragma unroll
      for (int m = 0; m < 4; ++m) {
        const int R = row0 + ai * 128 + m * 16;
        const bool lat = R < TL;
        xpp[m] = lat ? xlat + (size_t)canon_row(layer, R) * D : xctx + (size_t)(R - TL) * D;
        if (m == 0) m2p = mod + ((size_t)layer * 5 + (lat ? (R >> 12) : 4)) * 6144 + 2 * 1024;
#pragma unroll
        for (int bj = 0; bj < 2; ++bj)
#pragma unroll
          for (int n = 0; n < 2; ++n) xq[m][bj][n] = *(const float4*)(xpp[m] + col0 + bj * 128 + n * 16);
      }
      float4 mq[2][2];
#pragma unroll
      for (int bj = 0; bj < 2; ++bj)
#pragma unroll
        for (int n = 0; n < 2; ++n) mq[bj][n] = *(const float4*)(m2p + col0 + bj * 128 + n * 16);
#pragma unroll
      for (int m = 0; m < 4; ++m)
#pragma unroll
        for (int bj = 0; bj < 2; ++bj)
#pragma unroll
          for (int n = 0; n < 2; ++n) {
            float4 xv = xq[m][bj][n]; const float4 mv = mq[bj][n]; const f32x4 a = acc[ai][bj][m][n];
            xv.x += mv.x * a[0]; xv.y += mv.y * a[1]; xv.z += mv.z * a[2]; xv.w += mv.w * a[3];
            *(float4*)(xpp[m] + col0 + bj * 128 + n * 16) = xv;
          }
    }
  }
};
struct EpiMoeUp {
  static constexpr bool PERM = true;
  bfr* HB; const int* list; const int* cnt;
  DEVINL void operator()(const Acc& acc, const Unit& u, int wr, int wc, int fr, int fq) const {
    const int ce = cnt[u.e];
#pragma unroll
    for (int ai = 0; ai < 2; ++ai) {
      int en[4];
#pragma unroll
      for (int m = 0; m < 4; ++m) { const int ei = u.pm * 256 + ai * 128 + wr * 64 + m * 16 + fr; en[m] = ei < ce ? list[(size_t)u.e * T + ei] : -1; }
#pragma unroll
      for (int m = 0; m < 4; ++m) {
        if (en[m] >= 0) {
          f32x4 v0, v1;
#pragma unroll
          for (int j = 0; j < 4; ++j) { v0[j] = silu(acc[ai][0][m][0][j]) * acc[ai][1][m][0][j]; v1[j] = silu(acc[ai][0][m][1][j]) * acc[ai][1][m][1][j]; }
          *(uint4*)(HB + (size_t)en[m] * 512 + u.pn * 128 + wc * 32 + 8 * fq) = pack8(v0, v1);
        }
      }
    }
  }
};
struct EpiMoeDown {
  static constexpr bool PERM = true;
  bfr* YS; const int* list; const int* cnt; const float* gatew;
  DEVINL void operator()(const Acc& acc, const Unit& u, int wr, int wc, int fr, int fq) const {
    const int ce = cnt[u.e];
#pragma unroll
    for (int ai = 0; ai < 2; ++ai) {
      int en[4]; float gw[4];
#pragma unroll
      for (int m = 0; m < 4; ++m) { const int ei = u.pm * 256 + ai * 128 + wr * 64 + m * 16 + fr; en[m] = ei < ce ? list[(size_t)u.e * T + ei] : -1; }
#pragma unroll
      for (int m = 0; m < 4; ++m) gw[m] = en[m] >= 0 ? gatew[en[m]] : 0.f;
#pragma unroll
      for (int m = 0; m < 4; ++m) {
        if (en[m] >= 0) {
          bfr* yp = YS + (size_t)(en[m] & 1) * T * D + (size_t)(en[m] >> 1) * D + u.pn * 256 + wc * 32 + 8 * fq;
#pragma unroll
          for (int bj = 0; bj < 2; ++bj) *(uint4*)(yp + bj * 128) = pack8(acc[ai][bj][m][0] * gw[m], acc[ai][bj][m][1] * gw[m]);
        }
      }
    }
  }
};
}

template <int L>
DEVINL void phase_gproj(const Params& p, char* sm, int c) {
  g8::TileSched S; S.init(L == 1 ? 64 : 68, 2); S.G = 32; S.c = c;
  g8::EpiP E{p.Gb, 512, 0};
  g8::RowAddr aA{NINP, 0, 0u}, aB{256, 1, 0u};
  g8::gemm8((LAS unsigned char*)sm, (const char*)(p.P + C_RWKV + 1792), (const char*)p.g2T, 256, S, E, aA, aB);
}
template <int L>
DEVINL void phase_gemm_in8(const Params& p, char* sm) {
  g8::TileSched S; S.init(T / 256, NINP / 256);
  g8::EpiP E{p.P, NINP, 0};
  g8::RowAddr aA{OLD, 0, 0u}, aB{D, 1, 0u};
  g8::gemm8(( LAS unsigned char*)sm, (const char*)(p.O + 2048), (const char*)p.WinT, D, S, E, aA, aB);
  if (L == 0 && blockIdx.x >= 44) {
    __syncthreads();
    convert_range<false>(p, 0, 1728 + blockIdx.x - 44, CONV_L_ITEMS, gridDim.x - 44, sm);
  }
}
template <int L>
DEVINL void phase_gates8(const Params& p, char* sm) {
  g8::TileSched S; S.init(L == 1 ? 64 : 68, 16);
  g8::EpiP E{p.GATES, 4096, 1};
  g8::RowAddr aA{OLD, 0, 0u}, aB{D, 1, 0u};
  g8::gemm8((LAS unsigned char*)sm, (const char*)(p.O + 2048), (const char*)p.WgT, D, S, E, aA, aB);
  __syncthreads();
  if (L == 1) convert_range<true>(p, L, blockIdx.x, 2048, gridDim.x, sm);
}
template <int L>
DEVINL void phase_branch8(const Params& p, char* sm) {
  g8::MergeSched S; S.init(L == 1 ? 64 : 68);
  g8::EpiBranch E{p.ACC, p.GATES};
  g8::RowAddr aA{OLD, 0, 512u * 2u}, aB{512, 1, (unsigned)(D * 512 * 2)};
  g8::gemm8((LAS unsigned char*)sm, (const char*)p.O, (const char*)p.WbT, 512, S, E, aA, aB);
  __syncthreads();
  if (L == 1) convert_range<true>(p, L, 2048 + blockIdx.x, 4096, gridDim.x, sm);
  else if (blockIdx.x >= 16) convert_range<true>(p, L, blockIdx.x - 16, CONV_M_ITEMS, gridDim.x - 16, sm);
}
template <int L>
DEVINL void phase_out8(const Params& p, char* sm) {
  g8::TileSched S; S.init(L == 1 ? 64 : 68, 4);
  g8::EpiOut E{p.out, p.xc, p.mod, L};
  g8::RowAddr aA{D, 0, 0u}, aB{D, 1, 0u};
  g8::gemm8((LAS unsigned char*)sm, (const char*)p.ACC, (const char*)p.WoT, D, S, E, aA, aB);
  __syncthreads();
  if (L == 0 && blockIdx.x >= 16) convert_range<false>(p, 1, blockIdx.x - 16, 3264, gridDim.x - 16, sm);
}
template <int L>
DEVINL void phase_moe_up8(const Params& p, char* sm) {
  const int* cnt = p.cnt + L * 16;
  g8::MoeSched S{cnt, 4, (int)gridDim.x, (int)blockIdx.x, 0};
  g8::EpiMoeUp E{p.HB, p.list, cnt};
  g8::GatherAddr aA{p.list, cnt, D * 2, 1};
  g8::RowAddr aB{D, 1, (unsigned)(D * D * 2)};
  g8::gemm8((LAS unsigned char*)sm, (const char*)p.HF, (const char*)p.WmguT, D, S, E, aA, aB);
  {
    int U = 0;
#pragma unroll 1
    for (int e = 0; e < 16; ++e) U += ((cnt[e] + 255) >> 8) * 4;
    const int G = gridDim.x, r = U % G, nl = G - r, c = blockIdx.x;
    int rank = 0;
#pragma unroll 1
    for (int cc = 0; cc < c; ++cc) rank += (((cc & ~127) | ((cc & 7) << 4) | ((cc >> 3) & 15)) >= r) ? 1 : 0;
    const bool light = (((c & ~127) | ((c & 7) << 4) | ((c >> 3) & 15)) >= r);
    const int first = (nl >= 64) ? (light ? rank : -1) : c, stride = (nl >= 64) ? nl : G;
    __syncthreads();
    if (first >= 0) {
      if (L == 0) convert_range<false>(p, 1, 3264 + first, CONV_L_ITEMS, stride, sm);
      else convert_range<true>(p, L, 4096 + first, CONV_M_ITEMS, stride, sm);
    }
  }
}
template <int L>
DEVINL void phase_moe_down8(const Params& p, char* sm) {
  const int* cnt = p.cnt + L * 16;
  g8::MoeSched S{cnt, 4, (int)gridDim.x, (int)blockIdx.x, 0};
  g8::EpiMoeDown E{p.YS, p.list, cnt, p.gatew};
  g8::GatherAddr aA{p.list, cnt, 512 * 2, 0};
  g8::RowAddr aB{512, 1, (unsigned)(D * 512 * 2)};
  g8::gemm8((LAS unsigned char*)sm, (const char*)p.HB, (const char*)p.WmdT, 512, S, E, aA, aB);
}

DEVINL void phase_final(const Params& p) {
  const int lane = threadIdx.x & 63, wave = threadIdx.x >> 6;
  for (int tk = blockIdx.x * 8 + wave; tk < TL; tk += gridDim.x * 8) {
    float* xp = p.out + (size_t)tk * D;
    const int vv = tk >> 12;
    float v[16]; float ss = 0.f;
#pragma unroll
    for (int q = 0; q < 4; ++q) {
      const int j = q * 256 + lane * 4;
      float4 xv = *(const float4*)(xp + j);
      const float4 m5 = *(const float4*)(p.mod + ((size_t)1 * 5 + vv) * 6144 + 5 * 1024 + j);
      const uint2 y0 = *(const uint2*)(p.YS + (size_t)tk * D + j), y1 = *(const uint2*)(p.YS + (size_t)T * D + (size_t)tk * D + j);
      xv.x += m5.x * (bf2f(y0.x & 0xFFFF) + bf2f(y1.x & 0xFFFF)); xv.y += m5.y * (bf2f(y0.x >> 16) + bf2f(y1.x >> 16));
      xv.z += m5.z * (bf2f(y0.y & 0xFFFF) + bf2f(y1.y & 0xFFFF)); xv.w += m5.w * (bf2f(y0.y >> 16) + bf2f(y1.y >> 16));
      v[q * 4] = xv.x; v[q * 4 + 1] = xv.y; v[q * 4 + 2] = xv.z; v[q * 4 + 3] = xv.w;
      ss += xv.x * xv.x + xv.y * xv.y + xv.z * xv.z + xv.w * xv.w;
    }
    ss = wave_sum(ss);
    const float rs = rsqrtf(ss * (1.f / 1024.f) + EPS);
#pragma unroll
    for (int q = 0; q < 4; ++q) {
      const int j = q * 256 + lane * 4;
      const float4 fw = *(const float4*)(p.final_norm + j);
      *(float4*)(xp + j) = make_float4(v[q * 4] * rs * fw.x, v[q * 4 + 1] * rs * fw.y, v[q * 4 + 2] * rs * fw.z, v[q * 4 + 3] * rs * fw.w);
    }
  }
}

constexpr int NPHASE = 24;

template <int L>
DEVINL void layer_phases(const Params& p, const XcdBarrier& bar, char* sm, int ph0, int ph1) {
  constexpr int B0 = 1 + 11 * L;
#define PH(id, call) { if (ph0 <= (id) && (id) < ph1) { call; } if (ph0 <= (id) && (id) + 1 < ph1) xcd_barrier(bar); }
  PH(B0 + 0, phase_norm1<L>(p))
  PH(B0 + 1, phase_gemm_in8<L>(p, sm))
  PH(B0 + 2, phase_prep<L>(p, sm))
  PH(B0 + 3, phase_scans<L>(p, sm))
  PH(B0 + 4, phase_post2<L>(p))
  PH(B0 + 5, phase_gates8<L>(p, sm))
  PH(B0 + 6, phase_branch8<L>(p, sm))
  PH(B0 + 7, phase_out8<L>(p, sm))
  PH(B0 + 8, phase_route<L>(p, sm))
  PH(B0 + 9, phase_moe_up8<L>(p, sm))
  PH(B0 + 10, phase_moe_down8<L>(p, sm))
}

__global__ void __launch_bounds__(NTHR, 2) mega(Params p, unsigned* barw, int ph0, int ph1) {
  extern __shared__ __attribute__((aligned(16))) char smem[];
  if (threadIdx.x == 0) *(uint4*)smem = make_uint4(0u, 0u, 0u, 0u);
  __syncthreads();
  XcdBarrier bar = xcd_barrier_post(barw, (volatile LAS unsigned*)smem);
  char* sm = smem + 16;
  PH(0, phase_prologue(p, sm))
  layer_phases<0>(p, bar, sm, ph0, ph1);
  layer_phases<1>(p, bar, sm, ph0, ph1);
  if (ph0 <= 23 && 23 < ph1) phase_final(p);
}

}

extern "C" void kernel_launch(void* const* d_in, const int* in_sizes, int n_in, void* d_out, int out_size, void* d_ws, size_t ws_size, hipStream_t stream) {
  (void)in_sizes; (void)n_in; (void)out_size;
  static int inited = 0;
  if (!inited) {
    if (hipFuncSetAttribute((const void*)mega, hipFuncAttributeMaxDynamicSharedMemorySize, LDS_BYTES) != hipSuccess) fprintf(stderr, "hipFuncSetAttribute failed\n");
    int per_cu = 0;
    if (hipOccupancyMaxActiveBlocksPerMultiprocessor(&per_cu, (const void*)mega, NTHR, LDS_BYTES) != hipSuccess || per_cu < 1) fprintf(stderr, "occupancy query: %d\n", per_cu);
    inited = 1;
  }
  Params p{};
  const float** f = (const float**)&p;
  for (int i = 0; i < 42; ++i) f[i] = (const float*)d_in[i];
  p.out = (float*)d_out;
  char* w = (char*)d_ws;
  size_t off = 0;
  auto take = [&](size_t bytes) { char* r = w + off; off += (bytes + 255) & ~(size_t)255; return r; };
  unsigned* barw = (unsigned*)take(65536);
  p.cnt = (int*)(barw + 4 * XCD_BAR_WORDS);
  p.xc = (float*)take((size_t)TC * D * 4);
  p.mod = (float*)take((size_t)2 * 5 * 6144 * 4);
  p.bon = (float*)take((size_t)2 * T * 8 * 4);
  p.list = (int*)take((size_t)16 * T * 4);
  p.gatew = (float*)take((size_t)2 * T * 4);
  p.WinT = (bfr*)take((size_t)NINP * D * 2);
  p.WgT = (bfr*)take((size_t)4 * D * D * 2);
  p.WbT = (bfr*)take((size_t)4 * D * 512 * 2);
  p.WoT = (bfr*)take((size_t)D * D * 2);
  p.Gb = (bfr*)take((size_t)T * 512 * 2);
  p.g2T = (bfr*)take((size_t)512 * 256 * 2);
  p.O = (bfr*)take((size_t)T * OLD * 2);
  p.P = (bfr*)take((size_t)T * NINP * 2);
  {
    bfr* q = p.P;
    p.ACC = q; q += (size_t)T * D;
    p.GATES = q;
    p.HF = q; q += (size_t)T * D;
    p.HB = q; q += (size_t)2 * T * 512;
    p.YS = q; q += (size_t)2 * T * D;
    p.WmguT = q; q += (size_t)16 * D * D;
    p.WmdT = q; q += (size_t)16 * D * 512;
  }
  if (off > ws_size) { fprintf(stderr, "workspace too small: need %zu have %zu\n", off, ws_size); return; }
  hipMemsetAsync(barw, 0, 65536, stream);
#if MK_SINGLE
  hipLaunchKernelGGL(mega, dim3(256), dim3(NTHR), LDS_BYTES, stream, p, barw, 0, NPHASE);
#else
  for (int ph = 0; ph < NPHASE; ++ph) hipLaunchKernelGGL(mega, dim3(256), dim3(NTHR), LDS_BYTES, stream, p, barw, ph, ph + 1);
#endif
}
```

```cpp
#include <hip/hip_runtime.h>
#include <stdint.h>
#include <cstdio>

#ifndef MK_SINGLE
#define MK_SINGLE 1
#endif

namespace {

typedef unsigned short bfr;
typedef short bf16x8 __attribute__((ext_vector_type(8)));
typedef float f32x4 __attribute__((ext_vector_type(4)));
typedef float f32x2 __attribute__((ext_vector_type(2)));
typedef __bf16 bf16x2v __attribute__((ext_vector_type(2)));
#define DEVINL __device__ __forceinline__
#define LAS __attribute__((address_space(3)))

constexpr int D = 1024, NB = 4, SEQ = 4096, CTXL = 256;
constexpr int TL = NB * SEQ, TC = NB * CTXL, T = TL + TC;
constexpr int NIN = 6848, NINP = 6912, OLD = 4096;
constexpr int C_SSM = 0, C_GLA = 1296, C_RWKV = 2864, C_GDN = 4784;
constexpr int NTHR = 512;
constexpr int LDS_BYTES = 155648;
constexpr float EPS = 1e-6f;

struct Params {
  const float *x, *c, *ctx, *c_ctx, *ada_w, *ada_b, *norm_mix, *norm_ffn, *w_in, *w_gate, *w_branch, *w_out;
  const float *ssm_conv_w, *ssm_conv_b, *ssm_a_log, *ssm_dt_bias, *ssm_d, *ssm_norm;
  const float *gla_w2, *gla_b, *gla_norm;
  const float *rwkv_mu, *rwkv_w0, *rwkv_w2, *rwkv_a0, *rwkv_a2, *rwkv_g2, *rwkv_k_k, *rwkv_k_a, *rwkv_r_k, *rwkv_ln_w, *rwkv_ln_b;
  const float *gdn_conv_w, *gdn_a_log, *gdn_dt_bias, *gdn_norm;
  const float *router_w, *router_b, *moe_w_gate, *moe_w_up, *moe_w_down, *final_norm;
  float* out;
  float* xc;
  float* mod;
  bfr* O;
  bfr* P;
  bfr *WinT, *WgT, *WbT, *WoT;
  float* bon;
  int* cnt;
  int* list;
  float* gatew;
  bfr *ACC, *GATES, *HF, *HB, *YS, *WmguT, *WmdT, *ACC2;
  bfr *Gb, *g2T;
};

DEVINL float bf2f(bfr v) { return __uint_as_float(((unsigned)v) << 16); }
DEVINL bfr f2bf(float f) { return __builtin_bit_cast(bfr, (__bf16)f); }
DEVINL unsigned pack2(float a, float b) { f32x2 v = {a, b}; return __builtin_bit_cast(unsigned, __builtin_convertvector(v, bf16x2v)); }
DEVINL float sigm(float x) { return __builtin_amdgcn_rcpf(1.f + __expf(-x)); }
DEVINL float silu(float x) { return x * __builtin_amdgcn_rcpf(1.f + __expf(-x)); }
DEVINL float softplus(float x) { return fmaxf(x, 0.f) + __logf(1.f + __expf(-fabsf(x))); }
DEVINL float dpp_sum16(float v) {
  v += __int_as_float(__builtin_amdgcn_update_dpp(0, __float_as_int(v), 0xB1, 0xF, 0xF, true));
  v += __int_as_float(__builtin_amdgcn_update_dpp(0, __float_as_int(v), 0x4E, 0xF, 0xF, true));
  v += __int_as_float(__builtin_amdgcn_update_dpp(0, __float_as_int(v), 0x141, 0xF, 0xF, true));
  v += __int_as_float(__builtin_amdgcn_update_dpp(0, __float_as_int(v), 0x140, 0xF, 0xF, true));
  return v;
}
DEVINL float dpp_sum8(float v) {
  v += __int_as_float(__builtin_amdgcn_update_dpp(0, __float_as_int(v), 0xB1, 0xF, 0xF, true));
  v += __int_as_float(__builtin_amdgcn_update_dpp(0, __float_as_int(v), 0x4E, 0xF, 0xF, true));
  v += __int_as_float(__builtin_amdgcn_update_dpp(0, __float_as_int(v), 0x141, 0xF, 0xF, true));
  return v;
}
DEVINL float wave_sum(float v) { v = dpp_sum16(v); v += __shfl_xor(v, 16); v += __shfl_xor(v, 32); return v; }
template <int W> DEVINL float group_sum(float v) {
#pragma unroll
  for (int o = W / 2; o > 0; o >>= 1) v += __shfl_xor(v, o);
  return v;
}

#define XB_TMO      128
#define XB_XCNT(j)  (256  + 64 * (j))
#define XB_XSUB(j)  (1280 + 64 * (j))
#define XB_XGEN(j)  (2304 + 64 * (j))
#define XB_TOP      3328
#define XB_TOPGEN   3392
#define XCD_BAR_WORDS 3456
#define XB_SPIN_CAP (1u << 18)

DEVINL unsigned xb_ld(unsigned* p)              { return __hip_atomic_load(p, __ATOMIC_RELAXED, __HIP_MEMORY_SCOPE_AGENT); }
DEVINL unsigned xb_add(unsigned* p, unsigned v) { return __hip_atomic_fetch_add(p, v, __ATOMIC_RELAXED, __HIP_MEMORY_SCOPE_AGENT); }
DEVINL unsigned xb_xcc_id() { return (unsigned)__builtin_amdgcn_s_getreg((3 << 11) | 20) & 0xFu; }
#define XB_SPIN(cond, bar) do { unsigned _sp = 0; while (cond) { __builtin_amdgcn_s_sleep(1); \
    if ((++_sp & 255u) == 0u) { if (xb_ld(&(bar)[XB_TMO])) break; if (_sp > XB_SPIN_CAP) { atomicAdd(&(bar)[XB_TMO], 1u); break; } } } } while (0)

struct XcdBarrier { unsigned* bar; unsigned x; volatile LAS unsigned* st; };

DEVINL XcdBarrier xcd_barrier_post(unsigned* bar, volatile LAS unsigned* st) {
    XcdBarrier b; b.bar = bar; b.x = xb_xcc_id(); b.st = st;
    if (threadIdx.x == 0) (void)xb_add(&bar[XB_XCNT(b.x)], 1u);
    return b;
}
DEVINL void xcd_barrier_complete(unsigned* bar, unsigned x, unsigned& nloc, unsigned& nx) {
    const unsigned G = gridDim.x * gridDim.y * gridDim.z;
    unsigned sum, cnt, mine, sp = 0u;
    for (;;) {
        sum = 0u; cnt = 0u; mine = 0u;
#pragma unroll
        for (unsigned j = 0; j < 16; ++j) { const unsigned c = xb_ld(&bar[XB_XCNT(j)]); sum += c; cnt += (c > 0u) ? 1u : 0u; mine = (j == x) ? c : mine; }
        if (sum == G) break;
        __builtin_amdgcn_s_sleep(1);
        if ((++sp & 255u) == 0u) { if (xb_ld(&bar[XB_TMO])) break; if (sp > XB_SPIN_CAP) { atomicAdd(&bar[XB_TMO], 1u); break; } }
    }
    nloc = mine > 0u ? mine : 1u; nx = cnt > 0u ? cnt : 1u;
}
DEVINL void xcd_barrier(const XcdBarrier& b) {
    asm volatile("s_waitcnt vmcnt(0)" ::: "memory");
    __syncthreads();
    if (threadIdx.x == 0) {
        unsigned* bar = b.bar;
        __builtin_amdgcn_s_waitcnt(0);
        unsigned nloc = b.st[0], nx = b.st[1];
        if (nloc == 0u) { xcd_barrier_complete(bar, b.x, nloc, nx); b.st[0] = nloc; b.st[1] = nx; }
        const unsigned old = xb_add(&bar[XB_XSUB(b.x)], 1u);
        const unsigned gen = old / nloc;
        if (old + 1u == (gen + 1u) * nloc) {
            __builtin_amdgcn_fence(__ATOMIC_RELEASE, "agent");
            asm volatile("s_waitcnt vmcnt(0)" ::: "memory");
            const unsigned og = xb_add(&bar[XB_TOP], 1u);
            const unsigned tg = og / nx;
            if (og + 1u == (tg + 1u) * nx) xb_add(&bar[XB_TOPGEN], 1u);
            else XB_SPIN(xb_ld(&bar[XB_TOPGEN]) == tg, bar);
            __builtin_amdgcn_fence(__ATOMIC_ACQUIRE, "agent");
            xb_add(&bar[XB_XGEN(b.x)], 1u);
            asm volatile("s_waitcnt vmcnt(0)" ::: "memory");
        } else {
            XB_SPIN(xb_ld(&bar[XB_XGEN(b.x)]) == gen, bar);
            __builtin_amdgcn_fence(__ATOMIC_ACQUIRE, "agent");
            asm volatile("s_waitcnt vmcnt(0)" ::: "memory");
        }
    }
    __syncthreads();
}

namespace g8 {
constexpr int BM = 256, BK = 64, HALF = 128, HTB = HALF * BK * 2, NXCD = 8, WGM = 8;
DEVINL int lds_byte(int r, int c) { const int st = (r >> 4) * 2 + (c >> 5), rr = r & 15, cc = c & 31, ob = rr * 64 + cc * 2; return st * 1024 + (ob ^ (((ob >> 9) & 1) << 5)); }
DEVINL void stage_rc(int b, int& R, int& C) { const int st = b / 1024, sb = b % 1024, swz = sb ^ (((sb >> 9) & 1) << 5); R = (st >> 1) * 16 + swz / 64; C = (st & 1) * 32 + (swz % 64) / 2; }
DEVINL int perm32(int rho) { const int n = rho >> 4, i = rho & 15; return 8 * (i >> 2) + 4 * n + (i & 3); }
struct Unit { int pm, pn, e; };
typedef f32x4 Acc[2][2][4][2];

struct TileSched {
  int nM, nN, nwg, G, c;
  DEVINL void init(int nM_, int nN_) { nM = nM_; nN = nN_; nwg = nM * nN; G = gridDim.x; c = blockIdx.x; }
  DEVINL bool next(int i, Unit& u) const {
    const long L = (long)i * G + c; if (L >= nwg) return false;
    int wgid = (int)L; { const int q = nwg / NXCD, r = nwg % NXCD, xcd = wgid % NXCD, off = wgid / NXCD; wgid = (xcd < r ? xcd * (q + 1) : r * (q + 1) + (xcd - r) * q) + off; }
    const int nig = WGM * nN, gid = wgid / nig, fm = gid * WGM, gsz = (nM - fm) < WGM ? (nM - fm) : WGM;
    u.pm = fm + ((wgid % nig) % gsz); u.pn = (wgid % nig) / gsz; u.e = 0; return true;
  }
};
struct MergeSched {
  int nM, G, c;
  DEVINL void init(int nM_) { nM = nM_; G = gridDim.x; c = blockIdx.x; }
  DEVINL bool next(int i, Unit& u) const {
    const int hi = i >> 2;
    if (hi && (nM <= 64 || c >= 32 || i >= 6)) return false;
    const int tile = hi ? (c >> 1) : c, x = tile & 7, idx = tile >> 3;
    u.pm = hi ? 64 + (x >> 1) : x * 8 + (idx >> 2); u.pn = hi ? (x & 1) * 2 + idx : (idx & 3); u.e = hi ? (c & 1) * 2 + (i & 1) : i; return true;
  }
};
struct MoeSched {
  const int* cnt; int npn, G, c, skip;
  DEVINL bool next(int i, Unit& u) const {
    int g = i * G + c - skip; if (g < 0) return false;
    g = (g & ~127) | ((g & 7) << 4) | ((g >> 3) & 15);
    int base = 0;
#pragma unroll 1
    for (int e = 0; e < 16; ++e) { const int n = ((cnt[e] + 255) >> 8) * npn; if (g < base + n) { const int r = g - base; u.e = e; u.pm = r / npn; u.pn = r % npn; return true; } base += n; }
    return false;
  }
};
struct RowAddr {
  int ld; int sel; unsigned estride;
  DEVINL unsigned operator()(const Unit& u, int r) const { return (unsigned)(((sel ? u.pn : u.pm) * 256 + r) * ld) * 2u + (unsigned)u.e * estride; }
};
struct GatherAddr {
  const int* list; const int* cnt; int rowbytes; int shift;
  DEVINL unsigned operator()(const Unit& u, int r) const {
    const int ce = cnt[u.e]; int ei = u.pm * 256 + r; ei = ei < ce ? ei : ce - 1;
    return (unsigned)(list[(size_t)u.e * T + ei] >> shift) * (unsigned)rowbytes;
  }
};

template <class Epi, class Sched, class AA, class AB>
DEVINL void gemm8(LAS unsigned char* lds, const char* Abase, const char* Bbase, int K, const Sched& S, const Epi& E, const AA& aA, const AB& aB) {
  const int tid = threadIdx.x, wid = __builtin_amdgcn_readfirstlane(tid >> 6), lane = tid & 63, wr = wid >> 2, wc = wid & 3, fr = lane & 15, fq = lane >> 4;
  const int nt = K / BK;
  int Rr[2], Cc[2], Rb[2];
#pragma unroll
  for (int i = 0; i < 2; ++i) { stage_rc(tid * 16 + i * 8192, Rr[i], Cc[i]); Rb[i] = Epi::PERM ? ((Rr[i] & ~31) + perm32(Rr[i] & 31)) : Rr[i]; }
  const unsigned ldsw = (unsigned)wid * 1024u;
  const int aoff = lds_byte(wr * 64 + fr, fq * 8), boff = lds_byte(wc * 32 + fr, fq * 8);
#define G8_SA(b, h) (((b) * 2 + (h)) * HTB)
#define G8_SB(b, h) ((4 + (b) * 2 + (h)) * HTB)
#define G8_STAGE(bufoff, base, kb, o) do { \
    __builtin_amdgcn_global_load_lds((const unsigned*)((base) + (o)[0] + (kb)), (LAS unsigned*)(lds + (bufoff) + ldsw), 16, 0, 0); \
    __builtin_amdgcn_global_load_lds((const unsigned*)((base) + (o)[1] + (kb)), (LAS unsigned*)(lds + (bufoff) + ldsw + 8192), 16, 0, 0); } while (0)
#define G8_LDA(dst, b, h) do { _Pragma("unroll") for (int m = 0; m < 4; ++m) _Pragma("unroll") for (int k = 0; k < 2; ++k) dst[m][k] = *(const LAS bf16x8*)(lds + G8_SA(b, h) + aoff + m * 2048 + k * 1024); } while (0)
#define G8_LDB(dst, b, h) do { _Pragma("unroll") for (int n = 0; n < 2; ++n) _Pragma("unroll") for (int k = 0; k < 2; ++k) dst[n][k] = *(const LAS bf16x8*)(lds + G8_SB(b, h) + boff + n * 2048 + k * 1024); } while (0)
#define G8_MMA(ai, bj, At, Bt) do { __builtin_amdgcn_s_setprio(1); _Pragma("unroll") for (int m = 0; m < 4; ++m) _Pragma("unroll") for (int n = 0; n < 2; ++n) _Pragma("unroll") for (int k = 0; k < 2; ++k) \
    acc[ai][bj][m][n] = __builtin_amdgcn_mfma_f32_16x16x32_bf16(Bt[n][k], At[m][k], acc[ai][bj][m][n], 0, 0, 0); __builtin_amdgcn_s_setprio(0); } while (0)
#define G8_WAIT_V(n) asm volatile("s_waitcnt vmcnt(" #n ")" ::: "memory")
#define G8_WAIT_L(n) asm volatile("s_waitcnt lgkmcnt(" #n ")" ::: "memory")
#define G8_BAR __builtin_amdgcn_s_barrier()
#define G8_SCHED __builtin_amdgcn_sched_barrier(0)
  Unit cur, nxt; int ui = 0;
  if (!S.next(0, cur)) return;
  Acc acc;
#pragma unroll
  for (int a = 0; a < 2; ++a)
#pragma unroll
    for (int b = 0; b < 2; ++b)
#pragma unroll
      for (int m = 0; m < 4; ++m)
#pragma unroll
        for (int n = 0; n < 2; ++n) acc[a][b][m][n] = f32x4{0.f, 0.f, 0.f, 0.f};
  bf16x8 At[4][2], B0[2][2], B1[2][2];
  unsigned oAc[2][2], oBc[2][2], oAn[2][2], oBn[2][2];
#pragma unroll
  for (int h = 0; h < 2; ++h)
#pragma unroll
    for (int i = 0; i < 2; ++i) { oAc[h][i] = aA(cur, h * 128 + Rr[i]) + Cc[i] * 2; oBc[h][i] = aB(cur, h * 128 + Rb[i]) + Cc[i] * 2; oAn[h][i] = oAc[h][i]; oBn[h][i] = oBc[h][i]; }
  G8_STAGE(G8_SB(0, 0), Bbase, 0, oBc[0]); G8_STAGE(G8_SA(0, 0), Abase, 0, oAc[0]); G8_STAGE(G8_SB(0, 1), Bbase, 0, oBc[1]); G8_STAGE(G8_SA(0, 1), Abase, 0, oAc[1]);
  if (wr == 1) G8_BAR;
  G8_WAIT_V(4); G8_BAR;
  G8_STAGE(G8_SB(1, 0), Bbase, 128, oBc[0]); G8_STAGE(G8_SA(1, 0), Abase, 128, oAc[0]); G8_STAGE(G8_SB(1, 1), Bbase, 128, oBc[1]);
  G8_WAIT_V(6); G8_BAR;
  for (;;) {
    const bool has_next = S.next(ui + 1, nxt);
    if (has_next) {
#pragma unroll
      for (int h = 0; h < 2; ++h)
#pragma unroll
        for (int i = 0; i < 2; ++i) { oAn[h][i] = aA(nxt, h * 128 + Rr[i]) + Cc[i] * 2; oBn[h][i] = aB(nxt, h * 128 + Rb[i]) + Cc[i] * 2; }
    } else {
#pragma unroll
      for (int h = 0; h < 2; ++h)
#pragma unroll
        for (int i = 0; i < 2; ++i) { oAn[h][i] = oAc[h][i]; oBn[h][i] = oBc[h][i]; }
    }
    for (int t = 0; t < nt; t += 2) {
      const bool last = (t == nt - 2);
      const int k1 = (t + 1) * 128, k2 = last ? 0 : (t + 2) * 128, k3 = k2 + 128;
      unsigned a2[2][2], b2[2][2];
#pragma unroll
      for (int h = 0; h < 2; ++h)
#pragma unroll
        for (int i = 0; i < 2; ++i) { a2[h][i] = last ? oAn[h][i] : oAc[h][i]; b2[h][i] = last ? oBn[h][i] : oBc[h][i]; }
      G8_LDB(B0, 0, 0); G8_SCHED; G8_LDA(At, 0, 0); G8_STAGE(G8_SA(1, 1), Abase, k1, oAc[1]);
      G8_WAIT_L(8); G8_BAR; G8_WAIT_L(0); G8_MMA(0, 0, At, B0); G8_BAR; G8_SCHED;
      G8_LDB(B1, 0, 1); G8_STAGE(G8_SB(0, 0), Bbase, k2, b2[0]);
      G8_BAR; G8_WAIT_L(0); G8_MMA(0, 1, At, B1); G8_BAR;
      G8_LDA(At, 0, 1); G8_STAGE(G8_SA(0, 0), Abase, k2, a2[0]);
      G8_BAR; G8_WAIT_L(0); G8_MMA(1, 0, At, B0); G8_BAR; G8_SCHED;
      G8_STAGE(G8_SB(0, 1), Bbase, k2, b2[1]);
      G8_WAIT_V(6); G8_BAR; G8_MMA(1, 1, At, B1); G8_BAR;
      G8_LDB(B0, 1, 0); G8_SCHED; G8_LDA(At, 1, 0); G8_STAGE(G8_SA(0, 1), Abase, k2, a2[1]);
      G8_WAIT_L(8); G8_BAR; G8_WAIT_L(0); G8_MMA(0, 0, At, B0); G8_BAR; G8_SCHED;
      G8_LDB(B1, 1, 1); G8_STAGE(G8_SB(1, 0), Bbase, k3, b2[0]);
      G8_BAR; G8_WAIT_L(0); G8_MMA(0, 1, At, B1); G8_BAR;
      G8_LDA(At, 1, 1); G8_STAGE(G8_SA(1, 0), Abase, k3, a2[0]);
      G8_BAR; G8_WAIT_L(0); G8_MMA(1, 0, At, B0); G8_BAR; G8_SCHED;
      G8_STAGE(G8_SB(1, 1), Bbase, k3, b2[1]);
      G8_WAIT_V(6); G8_BAR; G8_MMA(1, 1, At, B1); G8_BAR;
    }
    E(acc, cur, wr, wc, fr, fq);
    if (!has_next) break;
#pragma unroll
    for (int a = 0; a < 2; ++a)
#pragma unroll
      for (int b = 0; b < 2; ++b)
#pragma unroll
        for (int m = 0; m < 4; ++m)
#pragma unroll
          for (int n = 0; n < 2; ++n) acc[a][b][m][n] = f32x4{0.f, 0.f, 0.f, 0.f};
    cur = nxt; ++ui;
#pragma unroll
    for (int h = 0; h < 2; ++h)
#pragma unroll
      for (int i = 0; i < 2; ++i) { oAc[h][i] = oAn[h][i]; oBc[h][i] = oBn[h][i]; }
  }
  G8_WAIT_V(0);
  if (wr == 0) G8_BAR;
  G8_BAR;
#undef G8_SA
#undef G8_SB
#undef G8_STAGE
#undef G8_LDA
#undef G8_LDB
#undef G8_MMA
#undef G8_WAIT_V
#undef G8_WAIT_L
#undef G8_BAR
#undef G8_SCHED
}
}

#define CONV_ARGS(x) const float* x##src, bfr* x##dst, int x##N, int x##Kd, int x##kt, int x##nt, int x##drow0
#define CONV_REFS(x) const float*& x##src, bfr*& x##dst, int& x##N, int& x##Kd, int& x##kt, int& x##nt, int& x##drow0
#define CONV_PASS(x) x##src, x##dst, x##N, x##Kd, x##kt, x##nt, x##drow0
DEVINL void conv_load(CONV_ARGS(d_), f32x4& v0, f32x4& v1) {
  const int tid = threadIdx.x, r = tid >> 4, c4 = (tid & 15) * 4;
  (void)d_dst; (void)d_Kd; (void)d_drow0;
  if (d_src) {
    const float* s = d_src + (size_t)(d_kt * 64 + r) * d_N + d_nt * 64 + c4;
    v0 = *(const f32x4*)s; v1 = *(const f32x4*)(s + (size_t)32 * d_N);
  } else { v0 = f32x4{0.f, 0.f, 0.f, 0.f}; v1 = v0; }
}
DEVINL void conv_store(CONV_ARGS(d_), const f32x4& v0, const f32x4& v1, char* sm) {
  float* tile = (float*)sm;
  const int tid = threadIdx.x, r = tid >> 4, c4 = (tid & 15) * 4;
  (void)d_src; (void)d_N; (void)d_nt;
  __syncthreads();
  tile[r * 65 + c4] = v0[0]; tile[r * 65 + c4 + 1] = v0[1]; tile[r * 65 + c4 + 2] = v0[2]; tile[r * 65 + c4 + 3] = v0[3];
  tile[(r + 32) * 65 + c4] = v1[0]; tile[(r + 32) * 65 + c4 + 1] = v1[1]; tile[(r + 32) * 65 + c4 + 2] = v1[2]; tile[(r + 32) * 65 + c4 + 3] = v1[3];
  __syncthreads();
  const int n = tid >> 3, k8 = (tid & 7) * 8;
  float y[8];
#pragma unroll
  for (int j = 0; j < 8; ++j) y[j] = tile[(k8 + j) * 65 + n];
  *(uint4*)(d_dst + (size_t)(d_drow0 + n) * d_Kd + d_kt * 64 + k8) = make_uint4(pack2(y[0], y[1]), pack2(y[2], y[3]), pack2(y[4], y[5]), pack2(y[6], y[7]));
}
constexpr int CONV_L_ITEMS = 1712 + 16 + 1024 + 512 + 256;
DEVINL void conv_layer_desc(const Params& p, int l, int it, CONV_REFS(d_)) {
  if (it < 1712) { d_src = p.w_in + (size_t)l * D * NIN; d_dst = p.WinT; d_N = NIN; d_Kd = D; d_kt = it / 107; d_nt = it % 107; }
  else if (it < 1728) { d_src = nullptr; d_dst = p.WinT; d_N = 0; d_Kd = D; d_kt = it - 1712; d_nt = 107; }
  else if (it < 2752) { const int g = (it - 1728) >> 8, r = (it - 1728) & 255; d_src = p.w_gate + ((size_t)l * 4 + g) * D * D; d_dst = p.WgT + (size_t)g * D * D; d_N = D; d_Kd = D; d_kt = r >> 4; d_nt = r & 15; }
  else if (it < 3264) { const int g = (it - 2752) >> 7, r = (it - 2752) & 127; d_src = p.w_branch + ((size_t)l * 4 + g) * 512 * D; d_dst = p.WbT + (size_t)g * D * 512; d_N = D; d_Kd = 512; d_kt = r >> 4; d_nt = r & 15; }
  else { const int r = it - 3264; d_src = p.w_out + (size_t)l * D * D; d_dst = p.WoT; d_N = D; d_Kd = D; d_kt = r >> 4; d_nt = r & 15; }
  d_drow0 = d_nt * 64;
}
constexpr int CONV_M_ITEMS = 6144;
DEVINL void conv_moe_desc(const Params& p, int l, int it, CONV_REFS(d_)) {
  const int which = it / 2048, r = it % 2048, e = r >> 7, tt = r & 127;
  const size_t eo = ((size_t)l * 16 + e) * (size_t)D * 512;
  if (which < 2) { d_src = (which ? p.moe_w_up : p.moe_w_gate) + eo; d_dst = p.WmguT + (size_t)e * D * D; d_N = 512; d_Kd = D; d_kt = tt >> 3; d_nt = tt & 7; d_drow0 = ((tt & 7) >> 1) * 256 + which * 128 + ((tt & 7) & 1) * 64; }
  else { d_src = p.moe_w_down + eo; d_dst = p.WmdT + (size_t)e * D * 512; d_N = D; d_Kd = 512; d_kt = tt >> 4; d_nt = tt & 15; d_drow0 = (tt & 15) * 64; }
}
template <bool MOE>
DEVINL void convert_range(const Params& p, int l, int start, int end, int stride, char* sm) {
  if (start >= end) return;
  const float* c_src; bfr* c_dst; int c_N, c_Kd, c_kt, c_nt, c_drow0;
  if (MOE) conv_moe_desc(p, l, start, CONV_PASS(c_)); else conv_layer_desc(p, l, start, CONV_PASS(c_));
  f32x4 v0, v1; conv_load(CONV_PASS(c_), v0, v1);
#pragma unroll 1
  for (int it = start; it < end; it += stride) {
    const int itn = (it + stride < end) ? it + stride : it;
    const float* n_src; bfr* n_dst; int n_N, n_Kd, n_kt, n_nt, n_drow0;
    if (MOE) conv_moe_desc(p, l, itn, CONV_PASS(n_)); else conv_layer_desc(p, l, itn, CONV_PASS(n_));
    f32x4 n0, n1; conv_load(CONV_PASS(n_), n0, n1);
    conv_store(CONV_PASS(c_), v0, v1, sm);
    c_src = n_src; c_dst = n_dst; c_N = n_N; c_Kd = n_Kd; c_kt = n_kt; c_nt = n_nt; c_drow0 = n_drow0; v0 = n0; v1 = n1;
  }
}
#undef CONV_ARGS
#undef CONV_REFS
#undef CONV_PASS

DEVINL void adaln_item(const Params& p, int it, char* sm) {
  const int l = it / 96, jb = it % 96, tid = threadIdx.x, c = tid & 63, ks = tid >> 6;
  float* sc = (float*)sm;
  float* red = sc + 5 * 1024;
  __syncthreads();
  for (int i = tid; i < 5 * 1024; i += NTHR) { const int v = i >> 10, k = i & 1023; const float cv = v < 4 ? p.c[v * 1024 + k] : p.c_ctx[k]; sc[i] = silu(cv); }
  __syncthreads();
  const int j = jb * 64 + c;
  float a[5] = {0.f, 0.f, 0.f, 0.f, 0.f};
  const float* w = p.ada_w + (size_t)l * D * 6144 + j;
#pragma unroll 16
  for (int k = ks * 128; k < ks * 128 + 128; ++k) {
    const float wv = w[(size_t)k * 6144];
#pragma unroll
    for (int v = 0; v < 5; ++v) a[v] += sc[v * 1024 + k] * wv;
  }
#pragma unroll
  for (int v = 0; v < 5; ++v) red[(ks * 5 + v) * 64 + c] = a[v];
  __syncthreads();
  if (tid < 320) {
    const int v = tid >> 6;
    float sum = 0.f;
#pragma unroll
    for (int q = 0; q < 8; ++q) sum += red[(q * 5 + v) * 64 + c];
    p.mod[((size_t)l * 5 + v) * 6144 + j] = sum + p.ada_b[l * 6144 + j];
  }
}
DEVINL void phase_prologue(const Params& p, char* sm) {
  if (blockIdx.x < 192) adaln_item(p, blockIdx.x, sm);
  convert_range<false>(p, 0, blockIdx.x, 1728, gridDim.x, sm);
}

DEVINL int canon_row(int L, int R) {
  if (L & 1) { const int b = R >> 12, s = R & 4095; return (b << 12) | ((s & 63) << 6) | (s >> 6); }
  return R;
}
template <int L>
DEVINL void phase_norm1(const Params& p) {
  const int lane = threadIdx.x & 63, wave = threadIdx.x >> 6;
  for (int R = blockIdx.x * 8 + wave; R < T; R += gridDim.x * 8) {
    const bool lat = R < TL;
    const int cr = lat ? canon_row(L, R) : R;
    const int vv = lat ? (R >> 12) : 4;
    float* xp = lat ? p.out + (size_t)cr * D : p.xc + (size_t)(R - TL) * D;
    const float* src = lat ? p.x + (size_t)cr * D : p.ctx + (size_t)(R - TL) * D;
    float4 xq[4]; uint2 y0q[4], y1q[4]; float4 m5q[4];
#pragma unroll
    for (int q = 0; q < 4; ++q) {
      const int j = q * 256 + lane * 4;
      if (L == 0) xq[q] = *(const float4*)(src + j);
      else {
        xq[q] = *(const float4*)(xp + j);
        m5q[q] = *(const float4*)(p.mod + ((size_t)(L - 1) * 5 + vv) * 6144 + 5 * 1024 + j);
        y0q[q] = *(const uint2*)(p.YS + (size_t)cr * D + j); y1q[q] = *(const uint2*)(p.YS + (size_t)T * D + (size_t)cr * D + j);
      }
    }
    float v[16]; float ss = 0.f;
#pragma unroll
    for (int q = 0; q < 4; ++q) {
      const int j = q * 256 + lane * 4;
      float4 xv = xq[q];
      if (L != 0) {
        const float4 m5 = m5q[q]; const uint2 y0 = y0q[q], y1 = y1q[q];
        xv.x += m5.x * (bf2f(y0.x & 0xFFFF) + bf2f(y1.x & 0xFFFF)); xv.y += m5.y * (bf2f(y0.x >> 16) + bf2f(y1.x >> 16));
        xv.z += m5.z * (bf2f(y0.y & 0xFFFF) + bf2f(y1.y & 0xFFFF)); xv.w += m5.w * (bf2f(y0.y >> 16) + bf2f(y1.y >> 16));
      }
      *(float4*)(xp + j) = xv;
      v[q * 4] = xv.x; v[q * 4 + 1] = xv.y; v[q * 4 + 2] = xv.z; v[q * 4 + 3] = xv.w;
      ss += xv.x * xv.x + xv.y * xv.y + xv.z * xv.z + xv.w * xv.w;
    }
    ss = wave_sum(ss);
    const float rs = rsqrtf(ss * (1.f / 1024.f) + EPS);
    const float* md = p.mod + ((size_t)L * 5 + vv) * 6144;
    float4 nwq[4], shq[4], sclq[4];
#pragma unroll
    for (int q = 0; q < 4; ++q) { const int j = q * 256 + lane * 4; nwq[q] = *(const float4*)(p.norm_mix + L * D + j); shq[q] = *(const float4*)(md + j); sclq[q] = *(const float4*)(md + 1024 + j); }
#pragma unroll
    for (int q = 0; q < 4; ++q) {
      const int j = q * 256 + lane * 4;
      const float4 nw = nwq[q], sh = shq[q], scl = sclq[q];
      const float h0 = v[q * 4] * rs * nw.x * (1.f + scl.x) + sh.x, h1 = v[q * 4 + 1] * rs * nw.y * (1.f + scl.y) + sh.y;
      const float h2 = v[q * 4 + 2] * rs * nw.z * (1.f + scl.z) + sh.z, h3 = v[q * 4 + 3] * rs * nw.w * (1.f + scl.w) + sh.w;
      *(uint2*)(p.O + (size_t)R * OLD + 2048 + j) = make_uint2(pack2(h0, h1), pack2(h2, h3));
    }
  }
}

DEVINL void chunk_of_step(int step, int b, int d, int& rb, int& len, int& c) {
  const int seg = step >= 4, cc = seg ? step - 4 : step, nch = seg ? 64 : 4;
  c = d ? nch - 1 - cc : cc; len = seg ? SEQ : CTXL; rb = seg ? b * SEQ : TL + b * CTXL;
}
template <int KS>
DEVINL f32x4 mma16(const bfr* A, int lda, const bfr* Bt, int ldb, f32x4 acc) {
  const int lane = threadIdx.x & 63;
  const bfr* ap = A + (lane & 15) * lda + (lane >> 4) * 8;
  const bfr* bp = Bt + (lane & 15) * ldb + (lane >> 4) * 8;
#pragma unroll
  for (int ks = 0; ks < KS; ++ks) acc = __builtin_amdgcn_mfma_f32_16x16x32_bf16(*(const bf16x8*)(ap + 32 * ks), *(const bf16x8*)(bp + 32 * ks), acc, 0, 0, 0);
  return acc;
}
DEVINL void unpack8(const uint4 v, float (&o)[8]) {
  o[0] = __uint_as_float(v.x << 16); o[1] = __uint_as_float(v.x & 0xFFFF0000u); o[2] = __uint_as_float(v.y << 16); o[3] = __uint_as_float(v.y & 0xFFFF0000u);
  o[4] = __uint_as_float(v.z << 16); o[5] = __uint_as_float(v.z & 0xFFFF0000u); o[6] = __uint_as_float(v.w << 16); o[7] = __uint_as_float(v.w & 0xFFFF0000u);
}
DEVINL void unpack4(const uint2 v, float (&o)[4]) {
  o[0] = __uint_as_float(v.x << 16); o[1] = __uint_as_float(v.x & 0xFFFF0000u); o[2] = __uint_as_float(v.y << 16); o[3] = __uint_as_float(v.y & 0xFFFF0000u);
}


template <int W8>
DEVINL void prep_item(const Params& p, int b, int col0, const float* t0g, const float* t1g, const float* t2g, const float* bg, bool shiftmode, int act, bool norm, float nscale, char* sm) {
  constexpr int W = W8 * 8, RS = 256, NV = (RS + 1) * W8, NPF = (NV + NTHR - 1) / NTHR, G = W8 / 8;
  const int tid = threadIdx.x;
  bfr* RAWP = (bfr*)sm;
  float* PT = (float*)(RAWP + (RS + 2) * W);
  __syncthreads();
  for (int c = tid; c < W; c += NTHR) {
    if (shiftmode) { const float mu = t0g[c]; PT[c] = 0.5f * mu; PT[W + c] = 1.f - mu; PT[2 * W + c] = 0.5f * mu; PT[3 * W + c] = 0.f; }
    else { PT[c] = t0g[c]; PT[W + c] = t1g[c]; PT[2 * W + c] = t2g[c]; PT[3 * W + c] = bg ? bg[c] : 0.f; }
  }
  uint4 pf[NPF];
  auto prefetch = [&](int step) {
    const int seg = step >= 1, cc = seg ? step - 1 : 0, len = seg ? SEQ : CTXL, rb = seg ? b * SEQ : TL + b * CTXL;
#pragma unroll
    for (int q = 0; q < NPF; ++q) {
      const int idx = tid + NTHR * q;
      uint4 v = make_uint4(0, 0, 0, 0);
      if (idx < NV) { const int r = idx / W8, g = idx % W8, t = cc * RS + r; if (t < len) v = *(const uint4*)(p.P + (size_t)(rb + t) * NINP + col0 + g * 8); }
      pf[q] = v;
    }
  };
  prefetch(0);
#pragma unroll 1
  for (int step = 0; step < 17; ++step) {
    const int seg = step >= 1, cc = seg ? step - 1 : 0, rb = seg ? b * SEQ : TL + b * CTXL;
    __syncthreads();
    if (tid < W8) *(uint4*)(RAWP + tid * 8) = (cc == 0) ? make_uint4(0, 0, 0, 0) : *(const uint4*)(RAWP + RS * W + tid * 8);
    __syncthreads();
#pragma unroll
    for (int q = 0; q < NPF; ++q) { const int idx = tid + NTHR * q; if (idx < NV) *(uint4*)(RAWP + (1 + idx / W8) * W + (idx % W8) * 8) = pf[q]; }
    __syncthreads();
    if (step + 1 < 17) prefetch(step + 1);
#pragma unroll 1
    for (int rep = 0; rep < 4; ++rep) {
      const int i = rep * 64 + (tid >> 3);
      float ssq = 0.f; float y[G][8];
#pragma unroll
      for (int gq = 0; gq < G; ++gq) {
        const int cbase = ((tid & 7) * G + gq) * 8;
        float x0[8], x1[8], x2[8];
        unpack8(*(const uint4*)(RAWP + i * W + cbase), x0); unpack8(*(const uint4*)(RAWP + (i + 1) * W + cbase), x1); unpack8(*(const uint4*)(RAWP + (i + 2) * W + cbase), x2);
#pragma unroll
        for (int e = 0; e < 8; ++e) {
          float v = PT[cbase + e] * x0[e] + PT[W + cbase + e] * x1[e] + PT[2 * W + cbase + e] * x2[e] + PT[3 * W + cbase + e];
          if (act == 1) v = silu(v); else if (act == 2) v = 1.f - 2.f * __builtin_amdgcn_rcpf(1.f + __expf(2.f * v)); else if (act == 3) v = sigm(v);
          y[gq][e] = v; ssq += v * v;
        }
      }
      float sc = 1.f;
      if (norm) { ssq = dpp_sum8(ssq); sc = __builtin_amdgcn_rsqf(ssq + EPS) * nscale; }
#pragma unroll
      for (int gq = 0; gq < G; ++gq) {
        const int cbase = ((tid & 7) * G + gq) * 8;
        *(uint4*)(p.P + (size_t)(rb + cc * RS + i) * NINP + col0 + cbase) =
            make_uint4(pack2(y[gq][0] * sc, y[gq][1] * sc), pack2(y[gq][2] * sc, y[gq][3] * sc), pack2(y[gq][4] * sc, y[gq][5] * sc), pack2(y[gq][6] * sc, y[gq][7] * sc));
      }
    }
  }
}
template <int L>
DEVINL void phase_prep(const Params& p, char* sm) {
  const int it = blockIdx.x;
  if (it >= 232) {
    for (int idx = (it - 232) * NTHR + threadIdx.x; idx < 512 * 256; idx += 24 * NTHR) { const int c = idx >> 8, k = idx & 255; p.g2T[idx] = k < 128 ? f2bf(p.rwkv_g2[((size_t)L * 128 + k) * 512 + c]) : (bfr)0; }
    return;
  }
  if (it < 32) {
    const int b = it >> 3, r = it & 7, isk = r >> 2, h = r & 3, ch = isk * 512 + h * 128;
    const float* cw = p.gdn_conv_w + (size_t)L * 3 * 1536 + ch;
    prep_item<16>(p, b, C_GDN + ch, cw, cw + 1536, cw + 3072, nullptr, false, 1, true, isk ? 1.f : 0.08838834764831845f, sm);
    return;
  }
  const int j = it - 32, b = j / 50, r = j % 50;
  if (r < 12) {
    const int ch = r * 64; const float* cw = p.ssm_conv_w + (size_t)L * 3 * 768 + ch;
    prep_item<8>(p, b, C_SSM + 512 + ch, cw, cw + 768, cw + 1536, p.ssm_conv_b + L * 768 + ch, false, 1, false, 1.f, sm);
  } else if (r < 20) {
    const int ch = 1024 + (r - 12) * 64; const float* cw = p.gdn_conv_w + (size_t)L * 3 * 1536 + ch;
    prep_item<8>(p, b, C_GDN + ch, cw, cw + 1536, cw + 3072, nullptr, false, 1, false, 1.f, sm);
  } else {
    const int ch = (r - 20) * 64; const float* mu = p.rwkv_mu + L * 1920 + ch;
    const int act = (ch >= 1536 && ch < 1664) ? 2 : (ch >= 1792 ? 3 : 0);
    prep_item<8>(p, b, C_RWKV + ch, mu, mu, mu, nullptr, true, act, false, 1.f, sm);
  }
}

DEVINL int rwkv_colbase(int g, int h, int d) { return g == 0 ? h * 64 : g == 1 ? 512 + h * 64 : g == 2 ? 1024 + h * 64 : g == 3 ? 1536 + d * 64 : 1664 + d * 64; }
DEVINL f32x4 bmm16(const float* A, int lda, const float* B, int ldb, f32x4 acc) {
  const int lane = threadIdx.x & 63;
#pragma unroll
  for (int s2 = 0; s2 < 4; ++s2) {
    const float a = A[(lane & 15) * lda + 4 * s2 + (lane >> 4)], b = B[(4 * s2 + (lane >> 4)) * ldb + (lane & 15)];
    acc = __builtin_amdgcn_mfma_f32_16x16x4f32(a, b, acc, 0, 0, 0);
  }
  asm volatile("" ::: "memory");
  return acc;
}
DEVINL void chunk32_of_step(int step, int b, int d, int& rb, int& c) {
  const int seg = step >= 8, cc = seg ? step - 8 : step, nch = seg ? 128 : 8;
  c = d ? nch - 1 - cc : cc; rb = seg ? b * SEQ : TL + b * CTXL;
}
DEVINL void rwkv3_prefetch(const Params& p, uint4& pfA, uint4& pfB, uint4 (&fw)[2], int step, int b, int d, int h) {
  int rb, c; chunk32_of_step(step, b, d, rb, c);
  const int tid = threadIdx.x, lane = tid & 63, ti = (tid >> 7) & 1, mat = (tid >> 6) & 1;
  const bfr* base = p.P + (size_t)(rb + c * 32) * NINP + C_RWKV;
  { const int r = tid >> 4, g = tid & 15; pfA = *(const uint4*)(base + (size_t)r * NINP + (g < 8 ? rwkv_colbase(0, h, d) + g * 8 : rwkv_colbase(1, h, d) + (g - 8) * 8)); }
  if (tid < 256) { const int r = tid >> 3, g = tid & 7; pfB = *(const uint4*)(base + (size_t)r * NINP + rwkv_colbase(2, h, d) + g * 8); }
  {
    const int i = ti * 16 + (lane & 15), r = d ? 31 - i : i;
    const bfr* rowp = base + (size_t)r * NINP + (lane >> 4) * 8;
    const int cb = mat ? rwkv_colbase(4, h, d) : rwkv_colbase(3, h, d);
    fw[0] = *(const uint4*)(rowp + cb); fw[1] = *(const uint4*)(rowp + cb + 32);
  }
}
template <int L>
DEVINL void scan_rwkv3(const Params& p, int item, char* sm) {
  const int d = item & 1, h = (item >> 1) & 7, b = item >> 4;
  const int tid = threadIdx.x, lane = tid & 63, wave = __builtin_amdgcn_readfirstlane(tid >> 6);
  constexpr int LK = 72, LJ = 40, LFS = 36, NCH = 136;
  bfr* w2T = (bfr*)sm; bfr* a2T = w2T + 64 * LK; bfr* RK = a2T + 64 * LK; bfr* BR = RK + 32 * 128; bfr* KR = BR + 32 * LK;
  float* Gf = (float*)(KR + 32 * LK); float* LWf = Gf + 2048; float* ARf = LWf + 2048;
  bfr* KH = (bfr*)(ARf + 2048); bfr* RH = KH + 32 * LK; bfr* BC = RH + 32 * LK; bfr* KC = BC + 32 * LK;
  bfr* BTt = KC + 32 * LK; bfr* KTt = BTt + 64 * LJ; bfr* VT0 = KTt + 64 * LJ; bfr* VT1 = VT0 + 64 * LJ;
  float* Lf = (float*)(VT1 + 64 * LJ); float* Tf = Lf + 32 * LFS;
  bfr* Tm = (bfr*)(Tf + 32 * LFS); bfr* Aak = Tm + 32 * LJ; bfr* Arb = Aak + 32 * LJ; bfr* Ark = Arb + 32 * LJ;
  bfr* ZT = Ark + 32 * LJ; bfr* UT = ZT + 64 * LJ; bfr* S0b = UT + 64 * LJ; bfr* OST = S0b + 64 * LK; bfr* VR = OST + 32 * LK;
  float* GC0 = (float*)(VR + 32 * LK); float* GC1 = GC0 + 64; float* TMPX = GC1 + 64; float* BONL = TMPX + 256;
  for (int i = tid; i < 4096; i += NTHR) {
    const int r = i >> 6, c = i & 63;
    w2T[c * LK + r] = f2bf(p.rwkv_w2[((size_t)(L * 2 + d) * 64 + r) * 512 + h * 64 + c]);
    a2T[c * LK + r] = f2bf(p.rwkv_a2[((size_t)(L * 2 + d) * 64 + r) * 512 + h * 64 + c]);
  }
  for (int i = tid; i < 64 * LK; i += NTHR) S0b[i] = 0;
  const int c4 = (tid & 15) * 4;
  const float4 a0v = *(const float4*)(p.rwkv_a0 + (L * 2 + d) * 512 + h * 64 + c4);
  const float4 kkv = *(const float4*)(p.rwkv_k_k + L * 512 + h * 64 + c4), kav = *(const float4*)(p.rwkv_k_a + L * 512 + h * 64 + c4), rkv = *(const float4*)(p.rwkv_r_k + L * 512 + h * 64 + c4);
  const int lr_mat = wave & 1, lr_ti = (wave >> 1) & 1, lr_tj = (wave >> 2) * 2;
  const float w0c0 = p.rwkv_w0[(L * 2 + d) * 512 + h * 64 + lr_tj * 16 + (lane & 15)], w0c1 = p.rwkv_w0[(L * 2 + d) * 512 + h * 64 + lr_tj * 16 + 16 + (lane & 15)];
  f32x4 Sm[4];
#pragma unroll
  for (int u = 0; u < 4; ++u) Sm[u] = f32x4{0.f, 0.f, 0.f, 0.f};
  uint4 pfA, pfB = make_uint4(0, 0, 0, 0), fw[2];
  const int tv = wave & 3;
  f32x4 p1[2], p2[2];
#define RW3_STAGE_LOWRANK() do { \
    { const int r_ = tid >> 4, g_ = tid & 15, i_ = d ? 31 - r_ : r_; *(uint4*)(RK + i_ * 128 + g_ * 8) = pfA; } \
    if (tid < 256) { const int r_ = tid >> 3, g_ = tid & 7, i_ = d ? 31 - r_ : r_; *(uint4*)(VR + i_ * LK + g_ * 8) = pfB; } \
    { const bfr* bm_ = (lr_mat ? a2T : w2T) + (lr_tj * 16 + (lane & 15)) * LK + (lane >> 4) * 8; \
      _Pragma("unroll") for (int q_ = 0; q_ < 2; ++q_) { \
        f32x4 cw_ = f32x4{0.f, 0.f, 0.f, 0.f}; \
        _Pragma("unroll") for (int ks_ = 0; ks_ < 2; ++ks_) \
          cw_ = __builtin_amdgcn_mfma_f32_16x16x32_bf16(__builtin_bit_cast(bf16x8, fw[ks_]), *(const bf16x8*)(bm_ + q_ * 16 * LK + 32 * ks_), cw_, 0, 0, 0); \
        _Pragma("unroll") for (int r_ = 0; r_ < 4; ++r_) { const int i_ = lr_ti * 16 + (lane >> 4) * 4 + r_, cc_ = (lr_tj + q_) * 16 + (lane & 15); \
          if (lr_mat) ARf[i_ * 64 + cc_] = cw_[r_]; else LWf[i_ * 64 + cc_] = -0.6065306597f * sigm(cw_[r_] + (q_ ? w0c1 : w0c0)); } } } } while (0)
#define RW3_VT(VTn, tl) do { const int v_ = (tl) & 63, iq_ = ((tl) >> 6) * 8; unsigned w_[4]; \
    _Pragma("unroll") for (int e_ = 0; e_ < 4; ++e_) w_[e_] = (unsigned)VR[(iq_ + 2 * e_) * LK + v_] | ((unsigned)VR[(iq_ + 2 * e_ + 1) * LK + v_] << 16); \
    *(uint4*)((VTn) + v_ * LJ + iq_) = make_uint4(w_[0], w_[1], w_[2], w_[3]); } while (0)
#define RW3_CUMSUM_TILE(GCn, id_) do { const int ti_ = (id_) >> 2, tj_ = (id_) & 3; \
      f32x4 gacc_ = f32x4{0.f, 0.f, 0.f, 0.f}; \
      _Pragma("unroll") for (int kb_ = 0; kb_ < 2; ++kb_) { if (kb_ <= ti_) { \
        _Pragma("unroll") for (int s4_ = 0; s4_ < 4; ++s4_) { const int kk2_ = 4 * s4_ + (lane >> 4); \
          const float av_ = (kb_ < ti_ || kk2_ <= (lane & 15)) ? 1.f : 0.f; const float bv_ = LWf[(kb_ * 16 + kk2_) * 64 + tj_ * 16 + (lane & 15)]; \
          gacc_ = __builtin_amdgcn_mfma_f32_16x16x4f32(av_, bv_, gacc_, 0, 0, 0); } } } \
      _Pragma("unroll") for (int r_ = 0; r_ < 4; ++r_) Gf[(ti_ * 16 + (lane >> 4) * 4 + r_) * 64 + tj_ * 16 + (lane & 15)] = gacc_[r_]; \
      if (ti_ == 1 && (lane >> 4) == 3) (GCn)[tj_ * 16 + (lane & 15)] = gacc_[3]; } while (0)
  rwkv3_prefetch(p, pfA, pfB, fw, 0, b, d, h);
  __syncthreads();
  RW3_STAGE_LOWRANK();
  rwkv3_prefetch(p, pfA, pfB, fw, 1, b, d, h);
  __syncthreads();
  RW3_CUMSUM_TILE(GC0, wave);
  if (wave >= 4) RW3_VT(VT0, tid - 256);
  __syncthreads();
  {
    int rb0, c0; chunk32_of_step(0, b, d, rb0, c0);
#define EW_I (tid >> 4)
#define EW_GC GC0
#define EW_RB rb0
#define EW_C c0
    {
      const int i = EW_I, t = d ? 31 - i : i;
      float rr[4], kk_[4];
      unpack4(*(const uint2*)(RK + i * 128 + c4), rr); unpack4(*(const uint2*)(RK + i * 128 + 64 + c4), kk_);
      const float4 g4 = *(const float4*)&Gf[i * 64 + c4], l4 = *(const float4*)&LWf[i * 64 + c4], ar4 = *(const float4*)&ARf[i * 64 + c4], gc4 = *(const float4*)&EW_GC[c4];
      const float gA[4] = {g4.x, g4.y, g4.z, g4.w}, lA[4] = {l4.x, l4.y, l4.z, l4.w}, arA[4] = {ar4.x, ar4.y, ar4.z, ar4.w}, gcA[4] = {gc4.x, gc4.y, gc4.z, gc4.w};
      const float a0A[4] = {a0v.x, a0v.y, a0v.z, a0v.w}, kkA[4] = {kkv.x, kkv.y, kkv.z, kkv.w}, kaA[4] = {kav.x, kav.y, kav.z, kav.w}, rkA[4] = {rkv.x, rkv.y, rkv.z, rkv.w};
      float a_[4], kraw[4], kd_[4]; float ss = 0.f;
#pragma unroll
      for (int e = 0; e < 4; ++e) { a_[e] = sigm(arA[e] + a0A[e]); kraw[e] = kk_[e] * kkA[e]; ss += kraw[e] * kraw[e]; kd_[e] = kk_[e] * (1.f + (a_[e] - 1.f) * kaA[e]); }
      ss = dpp_sum16(ss);
      const float rn = __builtin_amdgcn_rsqf(ss + EPS);
      float khv[4], rhv[4], bcv[4], kcv[4], btv[4], ktv[4]; float sb = 0.f;
#pragma unroll
      for (int e = 0; e < 4; ++e) {
        const float kn = kraw[e] * rn, bb = kn * a_[e];
        const float eI = __expf(gA[e]), eIm1 = __expf(gA[e] - lA[e]), eInv = __expf(-gA[e]), eC = __expf(gcA[e] - gA[e]);
        khv[e] = kn * eIm1; rhv[e] = rr[e] * eI; bcv[e] = bb * eInv; kcv[e] = kd_[e] * eInv;
        btv[e] = bb * eC; ktv[e] = kd_[e] * eC;
        sb += rr[e] * kd_[e] * rkA[e];
      }
      sb = dpp_sum16(sb);
      *(uint2*)(KH + i * LK + c4) = make_uint2(pack2(khv[0], khv[1]), pack2(khv[2], khv[3]));
      *(uint2*)(RH + i * LK + c4) = make_uint2(pack2(rhv[0], rhv[1]), pack2(rhv[2], rhv[3]));
      *(uint2*)(BC + i * LK + c4) = make_uint2(pack2(bcv[0], bcv[1]), pack2(bcv[2], bcv[3]));
      *(uint2*)(KC + i * LK + c4) = make_uint2(pack2(kcv[0], kcv[1]), pack2(kcv[2], kcv[3]));
      *(uint2*)(BR + i * LK + c4) = make_uint2(pack2(btv[0], btv[1]), pack2(btv[2], btv[3]));
      *(uint2*)(KR + i * LK + c4) = make_uint2(pack2(ktv[0], ktv[1]), pack2(ktv[2], ktv[3]));
      if ((tid & 15) == 0) p.bon[((size_t)d * T + EW_RB + EW_C * 32 + t) * 8 + h] = sb;
    }
#undef EW_I
#undef EW_GC
#undef EW_RB
#undef EW_C
  }
  __syncthreads();
#pragma unroll 1
  for (int step = 0; step < NCH; ++step) {
    int rb, c; chunk32_of_step(step, b, d, rb, c);
    bfr* VTc = (step & 1) ? VT1 : VT0; bfr* VTn = (step & 1) ? VT0 : VT1;
    float* GCc = (step & 1) ? GC1 : GC0; float* GCn = (step & 1) ? GC0 : GC1;
    const bool more = step + 1 < NCH;
    __builtin_amdgcn_s_waitcnt(0x0F70);
    if (more) RW3_STAGE_LOWRANK();
    if (step > 0 && lr_mat) {
      int rbp, cp; chunk32_of_step(step - 1, b, d, rbp, cp);
      const int tl = (wave >> 1) * 64 + lane, i = tl >> 3, c8 = (tl & 7) * 8, t = d ? 31 - i : i;
      *(uint4*)(p.O + (size_t)(rbp + cp * 32 + t) * OLD + d * 2048 + 2 * 512 + h * 64 + c8) = *(const uint4*)(OST + i * LK + c8);
      if (tl < 32) p.bon[((size_t)d * T + rb + c * 32 + tl) * 8 + h] = BONL[tl];
    }
    if (step + 2 < NCH) rwkv3_prefetch(p, pfA, pfB, fw, step + 2, b, d, h);
    __syncthreads();
    if (wave == 0) {
#pragma unroll
      for (int q = 0; q < 3; ++q) {
        const int ta = q >> 1 | (q & 1), tb = q >> 1;
        const f32x4 a = mma16<2>(KH + ta * 16 * LK, LK, BC + tb * 16 * LK, LK, f32x4{0.f, 0.f, 0.f, 0.f});
#pragma unroll
        for (int r = 0; r < 4; ++r) { const int t = ta * 16 + (lane >> 4) * 4 + r, j = tb * 16 + (lane & 15); Lf[t * LFS + j] = (j < t) ? a[r] : 0.f; }
      }
      asm volatile("s_waitcnt lgkmcnt(0)" ::: "memory");
      if (lane < 32) {
        const int blk = lane >> 4, cc = lane & 15;
        float x[16];
#pragma unroll
        for (int i = 0; i < 16; ++i) x[i] = (i == cc) ? 1.f : 0.f;
#pragma unroll
        for (int i = 1; i < 16; ++i) {
          const float* lr = Lf + (16 * blk + i) * LFS + 16 * blk;
#pragma unroll
          for (int j4 = 0; j4 < (i + 3) / 4; ++j4) {
            const float4 l4 = *(const float4*)(lr + 4 * j4);
            const float la[4] = {l4.x, l4.y, l4.z, l4.w};
#pragma unroll
            for (int e = 0; e < 4; ++e) if (4 * j4 + e < i) x[i] -= la[e] * x[4 * j4 + e];
          }
          asm volatile("" ::: "memory");
        }
#pragma unroll
        for (int i = 0; i < 16; ++i) Tf[(16 * blk + i) * LFS + 16 * blk + cc] = x[i];
      }
      asm volatile("s_waitcnt lgkmcnt(0)" ::: "memory");
      {
        const f32x4 xa = bmm16(Lf + 16 * LFS, LFS, Tf, LFS, f32x4{0.f, 0.f, 0.f, 0.f});
#pragma unroll
        for (int r = 0; r < 4; ++r) TMPX[((lane >> 4) * 4 + r) * 16 + (lane & 15)] = xa[r];
        asm volatile("s_waitcnt lgkmcnt(0)" ::: "memory");
        const f32x4 ta2 = bmm16(Tf + 16 * LFS + 16, LFS, TMPX, 16, f32x4{0.f, 0.f, 0.f, 0.f});
#pragma unroll
        for (int r = 0; r < 4; ++r) Tf[(16 + (lane >> 4) * 4 + r) * LFS + (lane & 15)] = -ta2[r];
      }
      asm volatile("s_waitcnt lgkmcnt(0)" ::: "memory");
#pragma unroll
      for (int q = 0; q < 4; ++q) {
        const int idx = lane + 64 * q, i = idx >> 3, j4 = (idx & 7) * 4;
        float tvv[4];
#pragma unroll
        for (int e = 0; e < 4; ++e) tvv[e] = ((j4 >> 4) <= (i >> 4)) ? Tf[i * LFS + j4 + e] : 0.f;
        *(uint2*)(Tm + i * LJ + j4) = make_uint2(pack2(tvv[0], tvv[1]), pack2(tvv[2], tvv[3]));
      }
    } else if (wave < 4) {
#pragma unroll
      for (int u = 0; u < 4; ++u) {
        const int id = (wave - 1) * 4 + u, prod = 1 + (id >> 2), ta = (id >> 1) & 1, tb = id & 1;
        f32x4 a = f32x4{0.f, 0.f, 0.f, 0.f};
        const bfr* Aop = (prod == 2) ? BC : KC; const bfr* Bop = (prod == 1) ? KH : RH;
        if (tb <= ta) a = mma16<2>(Aop + tb * 16 * LK, LK, Bop + ta * 16 * LK, LK, a);
        const int t = ta * 16 + (lane & 15), j0 = tb * 16 + (lane >> 4) * 4;
        float v4[4];
#pragma unroll
        for (int r = 0; r < 4; ++r) { const int j = j0 + r; v4[r] = ((prod == 1) ? (j < t) : (j <= t)) ? a[r] : 0.f; }
        bfr* Dst = (prod == 1) ? Aak : (prod == 2 ? Arb : Ark);
        *(uint2*)(Dst + t * LJ + j0) = make_uint2(pack2(v4[0], v4[1]), pack2(v4[2], v4[3]));
      }
    } else {
      {
        const int tl = tid - 256, k = tl & 63, iq = (tl >> 6) * 8;
        unsigned bw[4], kw[4];
#pragma unroll
        for (int e = 0; e < 4; ++e) {
          bw[e] = (unsigned)BR[(iq + 2 * e) * LK + k] | ((unsigned)BR[(iq + 2 * e + 1) * LK + k] << 16);
          kw[e] = (unsigned)KR[(iq + 2 * e) * LK + k] | ((unsigned)KR[(iq + 2 * e + 1) * LK + k] << 16);
        }
        *(uint4*)(BTt + k * LJ + iq) = make_uint4(bw[0], bw[1], bw[2], bw[3]);
        *(uint4*)(KTt + k * LJ + iq) = make_uint4(kw[0], kw[1], kw[2], kw[3]);
      }
#pragma unroll
      for (int ti = 0; ti < 2; ++ti) {
        p1[ti] = mma16<2>(KH + ti * 16 * LK, LK, S0b + tv * 16 * LK, LK, f32x4{0.f, 0.f, 0.f, 0.f});
        p2[ti] = mma16<2>(RH + ti * 16 * LK, LK, S0b + tv * 16 * LK, LK, f32x4{0.f, 0.f, 0.f, 0.f});
      }
    }
    if (more) {
      if (wave >= 1 && wave < 4) { RW3_CUMSUM_TILE(GCn, wave - 1); RW3_CUMSUM_TILE(GCn, wave + 2); if (wave < 3) RW3_CUMSUM_TILE(GCn, wave + 5); }
      if (wave >= 4) RW3_VT(VTn, tid - 256);
    }
    __syncthreads();
    if (wave >= 4) {
      const int vrow = (tv * 16 + (lane & 15)) * LJ + (lane >> 4) * 4;
#pragma unroll
      for (int ti = 0; ti < 2; ++ti) {
        const f32x4 z = mma16<1>(Aak + ti * 16 * LJ, LJ, VTc + tv * 16 * LJ, LJ, p1[ti]);
        *(uint2*)(ZT + vrow + ti * 16) = make_uint2(pack2(-z[0], -z[1]), pack2(-z[2], -z[3]));
      }
#pragma unroll
      for (int ti = 0; ti < 2; ++ti) {
        const f32x4 uu = mma16<1>(Tm + ti * 16 * LJ, LJ, ZT + tv * 16 * LJ, LJ, f32x4{0.f, 0.f, 0.f, 0.f});
        *(uint2*)(UT + vrow + ti * 16) = make_uint2(pack2(uu[0], uu[1]), pack2(uu[2], uu[3]));
      }
#pragma unroll
      for (int ti = 0; ti < 2; ++ti) {
        f32x4 o = mma16<1>(Arb + ti * 16 * LJ, LJ, UT + tv * 16 * LJ, LJ, p2[ti]);
        o = mma16<1>(Ark + ti * 16 * LJ, LJ, VTc + tv * 16 * LJ, LJ, o);
#pragma unroll
        for (int r = 0; r < 4; ++r) OST[(ti * 16 + (lane >> 4) * 4 + r) * LK + tv * 16 + (lane & 15)] = f2bf(o[r]);
      }
#pragma unroll
      for (int sk = 0; sk < 4; ++sk) {
        const float gcx = __expf(GCc[sk * 16 + (lane & 15)]);
        f32x4 sn = Sm[sk] * gcx;
        sn = mma16<1>(UT + tv * 16 * LJ, LJ, BTt + sk * 16 * LJ, LJ, sn);
        sn = mma16<1>(VTc + tv * 16 * LJ, LJ, KTt + sk * 16 * LJ, LJ, sn);
        Sm[sk] = sn;
#pragma unroll
        for (int r = 0; r < 4; ++r) S0b[(tv * 16 + (lane >> 4) * 4 + r) * LK + sk * 16 + (lane & 15)] = f2bf(sn[r]);
      }
    }
    if (wave < 4 && more) {
      int rbn, cn; chunk32_of_step(step + 1, b, d, rbn, cn);
#pragma unroll 1
      for (int pass = 0; pass < 2; ++pass) {
#define EW_I ((tid >> 4) + 16 * pass)
#define EW_GC GCn
#define EW_RB rbn
#define EW_C cn
    {
      const int i = EW_I, t = d ? 31 - i : i;
      float rr[4], kk_[4];
      unpack4(*(const uint2*)(RK + i * 128 + c4), rr); unpack4(*(const uint2*)(RK + i * 128 + 64 + c4), kk_);
      const float4 g4 = *(const float4*)&Gf[i * 64 + c4], l4 = *(const float4*)&LWf[i * 64 + c4], ar4 = *(const float4*)&ARf[i * 64 + c4], gc4 = *(const float4*)&EW_GC[c4];
      const float gA[4] = {g4.x, g4.y, g4.z, g4.w}, lA[4] = {l4.x, l4.y, l4.z, l4.w}, arA[4] = {ar4.x, ar4.y, ar4.z, ar4.w}, gcA[4] = {gc4.x, gc4.y, gc4.z, gc4.w};
      const float a0A[4] = {a0v.x, a0v.y, a0v.z, a0v.w}, kkA[4] = {kkv.x, kkv.y, kkv.z, kkv.w}, kaA[4] = {kav.x, kav.y, kav.z, kav.w}, rkA[4] = {rkv.x, rkv.y, rkv.z, rkv.w};
      float a_[4], kraw[4], kd_[4]; float ss = 0.f;
#pragma unroll
      for (int e = 0; e < 4; ++e) { a_[e] = sigm(arA[e] + a0A[e]); kraw[e] = kk_[e] * kkA[e]; ss += kraw[e] * kraw[e]; kd_[e] = kk_[e] * (1.f + (a_[e] - 1.f) * kaA[e]); }
      ss = dpp_sum16(ss);
      const float rn = __builtin_amdgcn_rsqf(ss + EPS);
      float khv[4], rhv[4], bcv[4], kcv[4], btv[4], ktv[4]; float sb = 0.f;
#pragma unroll
      for (int e = 0; e < 4; ++e) {
        const float kn = kraw[e] * rn, bb = kn * a_[e];
        const float eI = __expf(gA[e]), eIm1 = __expf(gA[e] - lA[e]), eInv = __expf(-gA[e]), eC = __expf(gcA[e] - gA[e]);
        khv[e] = kn * eIm1; rhv[e] = rr[e] * eI; bcv[e] = bb * eInv; kcv[e] = kd_[e] * eInv;
        btv[e] = bb * eC; ktv[e] = kd_[e] * eC;
        sb += rr[e] * kd_[e] * rkA[e];
      }
      sb = dpp_sum16(sb);
      *(uint2*)(KH + i * LK + c4) = make_uint2(pack2(khv[0], khv[1]), pack2(khv[2], khv[3]));
      *(uint2*)(RH + i * LK + c4) = make_uint2(pack2(rhv[0], rhv[1]), pack2(rhv[2], rhv[3]));
      *(uint2*)(BC + i * LK + c4) = make_uint2(pack2(bcv[0], bcv[1]), pack2(bcv[2], bcv[3]));
      *(uint2*)(KC + i * LK + c4) = make_uint2(pack2(kcv[0], kcv[1]), pack2(kcv[2], kcv[3]));
      *(uint2*)(BR + i * LK + c4) = make_uint2(pack2(btv[0], btv[1]), pack2(btv[2], btv[3]));
      *(uint2*)(KR + i * LK + c4) = make_uint2(pack2(ktv[0], ktv[1]), pack2(ktv[2], ktv[3]));
      if ((tid & 15) == 0) BONL[t] = sb;
    }
#undef EW_I
#undef EW_GC
#undef EW_RB
#undef EW_C
      }
    }
    __syncthreads();
  }
  if (tid < 256) {
    int rb, c; chunk32_of_step(NCH - 1, b, d, rb, c);
    const int i = tid >> 3, c8 = (tid & 7) * 8, t = d ? 31 - i : i;
    *(uint4*)(p.O + (size_t)(rb + c * 32 + t) * OLD + d * 2048 + 2 * 512 + h * 64 + c8) = *(const uint4*)(OST + i * LK + c8);
  }
#undef RW3_STAGE_LOWRANK
#undef RW3_CUMSUM_TILE
#undef RW3_VT
}

DEVINL void ssm_prefetch(const Params& p, uint4& pf0, uint4& pf1, uint4& pf2, float& dtraw, int step, int b, int d, int h) {
  int rb, len, c; chunk_of_step(step, b, d, rb, len, c);
  const int tid = threadIdx.x, r = tid >> 3, g8 = (tid & 7) * 8, gq = h >> 2;
  const bfr* base = p.P + (size_t)(rb + c * 64 + r) * NINP + C_SSM + 512 + g8;
  pf0 = *(const uint4*)(base + h * 64); pf1 = *(const uint4*)(base + 512 + gq * 64); pf2 = *(const uint4*)(base + 640 + gq * 64);
  if (tid < 64) { const int t = c * 64 + (d ? 63 - tid : tid); dtraw = bf2f(p.P[(size_t)(rb + t) * NINP + C_SSM + 1280 + d * 8 + h]); }
}
template <int L>
DEVINL void scan_ssm2(const Params& p, int item, char* sm) {
  const int d = item & 1, h = (item >> 1) & 7, b = item >> 4;
  const int tid = threadIdx.x, lane = tid & 63, wave = tid >> 6;
  constexpr int LB = 72;
  bfr* Qm = (bfr*)sm; bfr* Qg = Qm + 64 * LB; bfr* Km = Qg + 64 * LB; bfr* K2T = Km + 64 * LB; bfr* VT = K2T + 64 * LB; bfr* SCm = VT + 64 * LB; bfr* ST = SCm + 64 * LB; bfr* OST = ST + 64 * LB;
  float* gsv = (float*)(OST + 64 * LB); float* dtv = gsv + 64;
  for (int i = tid; i < 64 * LB; i += NTHR) ST[i] = 0;
  const float dtb = p.ssm_dt_bias[L * 16 + d * 8 + h], Aneg = -__expf(p.ssm_a_log[L * 16 + d * 8 + h]);
  f32x4 Sm[2] = {f32x4{0.f, 0.f, 0.f, 0.f}, f32x4{0.f, 0.f, 0.f, 0.f}};
  uint4 pf0, pf1, pf2; float dtraw = 0.f;
  ssm_prefetch(p, pf0, pf1, pf2, dtraw, 0, b, d, h);
#pragma unroll 1
  for (int step = 0; step < 68; ++step) {
    int rb, len, c; chunk_of_step(step, b, d, rb, len, c);
    __syncthreads();
    if (tid < 64) {
      const float dt = softplus(dtraw + dtb);
      float la = dt * Aneg;
#pragma unroll
      for (int o = 1; o < 64; o <<= 1) { const float n = __shfl_up(la, o); if (tid >= o) la += n; }
      gsv[tid] = la; dtv[tid] = dt;
    }
    __syncthreads();
    const float g63 = gsv[63];
    {
      const int r = tid >> 3, g = tid & 7, i = d ? 63 - r : r;
      float y[8];
      unpack8(pf0, y);
#pragma unroll
      for (int e = 0; e < 8; ++e) VT[(g * 8 + e) * LB + i] = f2bf(y[e]);
      unpack8(pf1, y);
      const float dt = dtv[i], e2 = __expf(g63 - gsv[i]);
#pragma unroll
      for (int e = 0; e < 8; ++e) y[e] *= dt;
      *(uint4*)(Km + i * LB + g * 8) = make_uint4(pack2(y[0], y[1]), pack2(y[2], y[3]), pack2(y[4], y[5]), pack2(y[6], y[7]));
#pragma unroll
      for (int e = 0; e < 8; ++e) K2T[(g * 8 + e) * LB + i] = f2bf(y[e] * e2);
      unpack8(pf2, y);
      const float eg = __expf(gsv[i]);
      *(uint4*)(Qm + i * LB + g * 8) = pf2;
      *(uint4*)(Qg + i * LB + g * 8) = make_uint4(pack2(y[0] * eg, y[1] * eg), pack2(y[2] * eg, y[3] * eg), pack2(y[4] * eg, y[5] * eg), pack2(y[6] * eg, y[7] * eg));
    }
    __syncthreads();
    if (step + 1 < 68) ssm_prefetch(p, pf0, pf1, pf2, dtraw, step + 1, b, d, h);
#pragma unroll
    for (int u = 0; u < 2; ++u) {
      const int id = 2 * wave + u, ti = id >> 2, tj = id & 3;
      f32x4 a = f32x4{0.f, 0.f, 0.f, 0.f};
      if (tj <= ti) a = mma16<2>(Qm + ti * 16 * LB, LB, Km + tj * 16 * LB, LB, a);
#pragma unroll
      for (int r = 0; r < 4; ++r) {
        const int i = ti * 16 + (lane >> 4) * 4 + r, j = tj * 16 + (lane & 15);
        SCm[i * LB + j] = (j <= i) ? f2bf(a[r] * __expf(gsv[i] - gsv[j])) : (bfr)0;
      }
    }
    __syncthreads();
    const float sd = __expf(g63);
#pragma unroll
    for (int u = 0; u < 2; ++u) {
      const int id = 2 * wave + u, ti = id >> 2, tp = id & 3;
      f32x4 o = mma16<2>(SCm + ti * 16 * LB, LB, VT + tp * 16 * LB, LB, f32x4{0.f, 0.f, 0.f, 0.f});
      o = mma16<2>(Qg + ti * 16 * LB, LB, ST + tp * 16 * LB, LB, o);
#pragma unroll
      for (int r = 0; r < 4; ++r) OST[(ti * 16 + (lane >> 4) * 4 + r) * LB + tp * 16 + (lane & 15)] = f2bf(o[r]);
      Sm[u] = mma16<2>(K2T + ti * 16 * LB, LB, VT + tp * 16 * LB, LB, Sm[u] * sd);
    }
    __syncthreads();
#pragma unroll
    for (int u = 0; u < 2; ++u) {
      const int id = 2 * wave + u, tn = id >> 2, tp = id & 3;
      *(uint2*)(ST + (tp * 16 + (lane & 15)) * LB + tn * 16 + (lane >> 4) * 4) = make_uint2(pack2(Sm[u][0], Sm[u][1]), pack2(Sm[u][2], Sm[u][3]));
    }
    {
      const int i = tid >> 3, c8 = (tid & 7) * 8, t = d ? 63 - i : i;
      *(uint4*)(p.O + (size_t)(rb + c * 64 + t) * OLD + d * 2048 + 0 * 512 + h * 64 + c8) = *(const uint4*)(OST + i * LB + c8);
    }
  }
}

DEVINL void gla_prefetch(const Params& p, uint4 (&pf)[5], int step, int b, int d, int h) {
  int rb, len, c; chunk_of_step(step, b, d, rb, len, c);
#pragma unroll
  for (int q = 0; q < 5; ++q) {
    const int idx = threadIdx.x + NTHR * q;
    uint4 v = make_uint4(0, 0, 0, 0);
    if (idx < 64 * 34) {
      const int r = idx / 34, qq = idx % 34;
      const int col = qq < 8 ? h * 64 + qq * 8 : (qq < 16 ? 256 + h * 64 + (qq - 8) * 8 : (qq < 32 ? 512 + h * 128 + (qq - 16) * 8 : 1536 + d * 16 + (qq - 32) * 8));
      v = *(const uint4*)(p.P + (size_t)(rb + c * 64 + r) * NINP + C_GLA + col);
    }
    pf[q] = v;
  }
}
template <int L>
DEVINL void scan_gla2(const Params& p, int item, char* sm) {
  const int d = item & 1, h = (item >> 1) & 3, b = item >> 3;
  const int tid = threadIdx.x, lane = tid & 63, wave = tid >> 6;
  constexpr int LB = 72, LO = 136, LR = 272;
  bfr* Qg = (bfr*)sm; bfr* Kn = Qg + 64 * LB; bfr* K2T = Kn + 64 * LB; bfr* SCm = K2T + 64 * LB; bfr* VT = SCm + 64 * LB; bfr* ST = VT + 128 * LB; bfr* OST = ST + 128 * LB;
  bfr* RAWG = OST + 64 * LO;
  float* SEG = (float*)(RAWG + 64 * LR);
  float* sdec = SEG + 512;
  for (int i = tid; i < 128 * LB; i += NTHR) ST[i] = 0;
  float w2r[16];
  const int kch = tid & 63;
#pragma unroll
  for (int r = 0; r < 16; ++r) w2r[r] = p.gla_w2[((size_t)(L * 2 + d) * 16 + r) * 256 + h * 64 + kch];
  const float bk = p.gla_b[(L * 2 + d) * 256 + h * 64 + kch];
  f32x4 Sm[4];
#pragma unroll
  for (int u = 0; u < 4; ++u) Sm[u] = f32x4{0.f, 0.f, 0.f, 0.f};
  uint4 pf[5];
  gla_prefetch(p, pf, 0, b, d, h);
#pragma unroll 1
  for (int step = 0; step < 68; ++step) {
    int rb, len, c; chunk_of_step(step, b, d, rb, len, c);
    __syncthreads();
#pragma unroll
    for (int q = 0; q < 5; ++q) { const int idx = tid + NTHR * q; if (idx < 64 * 34) *(uint4*)(RAWG + (idx / 34) * LR + (idx % 34) * 8) = pf[q]; }
    __syncthreads();
    if (step + 1 < 68) gla_prefetch(p, pf, step + 1, b, d, h);
    float gl[8];
    {
      float run = 0.f;
#pragma unroll
      for (int q = 0; q < 8; ++q) {
        const int i = 8 * wave + q, t = d ? 63 - i : i;
        float gr[8]; float lg = bk;
        unpack8(*(const uint4*)(RAWG + t * LR + 256), gr);
#pragma unroll
        for (int r = 0; r < 8; ++r) lg += gr[r] * w2r[r];
        unpack8(*(const uint4*)(RAWG + t * LR + 264), gr);
#pragma unroll
        for (int r = 0; r < 8; ++r) lg += gr[r] * w2r[8 + r];
        run += -softplus(-lg) * (1.f / 16.f);
        gl[q] = run;
      }
      SEG[wave * 64 + kch] = run;
    }
    __syncthreads();
    {
      float pre = 0.f, tot = 0.f;
#pragma unroll
      for (int w = 0; w < 8; ++w) { const float sv = SEG[w * 64 + kch]; tot += sv; if (w < wave) pre += sv; }
      float k2v[8];
#pragma unroll
      for (int q = 0; q < 8; ++q) {
        const int i = 8 * wave + q, t = d ? 63 - i : i;
        const float gg = gl[q] + pre;
        const float qv = bf2f(RAWG[t * LR + kch]), kv = bf2f(RAWG[t * LR + 64 + kch]);
        Qg[i * LB + kch] = f2bf(qv * 0.125f * __expf(gg)); Kn[i * LB + kch] = f2bf(kv * __expf(-gg)); k2v[q] = kv * __expf(tot - gg);
      }
      *(uint4*)(K2T + kch * LB + 8 * wave) = make_uint4(pack2(k2v[0], k2v[1]), pack2(k2v[2], k2v[3]), pack2(k2v[4], k2v[5]), pack2(k2v[6], k2v[7]));
      if (wave == 0) sdec[kch] = __expf(tot);
      const int pp = tid & 127, i0 = (tid >> 7) * 16;
      float vv[16];
#pragma unroll
      for (int q = 0; q < 16; ++q) { const int i = i0 + q, t = d ? 63 - i : i; vv[q] = bf2f(RAWG[t * LR + 128 + pp]); }
      *(uint4*)(VT + pp * LB + i0) = make_uint4(pack2(vv[0], vv[1]), pack2(vv[2], vv[3]), pack2(vv[4], vv[5]), pack2(vv[6], vv[7]));
      *(uint4*)(VT + pp * LB + i0 + 8) = make_uint4(pack2(vv[8], vv[9]), pack2(vv[10], vv[11]), pack2(vv[12], vv[13]), pack2(vv[14], vv[15]));
    }
    __syncthreads();
#pragma unroll
    for (int u = 0; u < 2; ++u) {
      const int id = 2 * wave + u, ti = id >> 2, tj = id & 3;
      f32x4 a = f32x4{0.f, 0.f, 0.f, 0.f};
      if (tj <= ti) a = mma16<2>(Qg + ti * 16 * LB, LB, Kn + tj * 16 * LB, LB, a);
#pragma unroll
      for (int r = 0; r < 4; ++r) {
        const int i = ti * 16 + (lane >> 4) * 4 + r, j = tj * 16 + (lane & 15);
        SCm[i * LB + j] = (j <= i) ? f2bf(a[r]) : (bfr)0;
      }
    }
    __syncthreads();
#pragma unroll
    for (int u = 0; u < 4; ++u) {
      const int id = 4 * wave + u, ti = id >> 3, tp = id & 7;
      f32x4 o = mma16<2>(SCm + ti * 16 * LB, LB, VT + tp * 16 * LB, LB, f32x4{0.f, 0.f, 0.f, 0.f});
      o = mma16<2>(Qg + ti * 16 * LB, LB, ST + tp * 16 * LB, LB, o);
#pragma unroll
      for (int r = 0; r < 4; ++r) OST[(ti * 16 + (lane >> 4) * 4 + r) * LO + tp * 16 + (lane & 15)] = f2bf(o[r]);
      f32x4 sdv;
#pragma unroll
      for (int r = 0; r < 4; ++r) sdv[r] = sdec[ti * 16 + (lane >> 4) * 4 + r];
      Sm[u] = mma16<2>(K2T + ti * 16 * LB, LB, VT + tp * 16 * LB, LB, Sm[u] * sdv);
    }
    __syncthreads();
#pragma unroll
    for (int u = 0; u < 4; ++u) {
      const int id = 4 * wave + u, tk = id >> 3, tp = id & 7;
      *(uint2*)(ST + (tp * 16 + (lane & 15)) * LB + tk * 16 + (lane >> 4) * 4) = make_uint2(pack2(Sm[u][0], Sm[u][1]), pack2(Sm[u][2], Sm[u][3]));
    }
    {
      const int i = tid >> 3, t = d ? 63 - i : i;
#pragma unroll
      for (int q = 0; q < 2; ++q) {
        const int c8 = (tid & 7) * 8 + q * 64;
        *(uint4*)(p.O + (size_t)(rb + c * 64 + t) * OLD + d * 2048 + 1 * 512 + h * 128 + c8) = *(const uint4*)(OST + i * LO + c8);
      }
    }
  }
}


DEVINL void gdn_prefetch(const Params& p, uint4& pf0, uint4& pf1, uint4& pf2, uint4& pf3, uint4& pf4, bfr& araw, bfr& braw, int step, int b, int d, int h, int vh) {
  int rb, len, c; chunk_of_step(step, b, d, rb, len, c);
  const int tid = threadIdx.x;
  const bfr* base = p.P + (size_t)(rb + c * 64) * NINP + C_GDN;
  { const int r = tid >> 4, g = tid & 15;
    pf0 = *(const uint4*)(base + (size_t)r * NINP + h * 128 + g * 8); pf1 = *(const uint4*)(base + (size_t)(r + 32) * NINP + h * 128 + g * 8);
    pf2 = *(const uint4*)(base + (size_t)r * NINP + 512 + h * 128 + g * 8); pf3 = *(const uint4*)(base + (size_t)(r + 32) * NINP + 512 + h * 128 + g * 8); }
  { const int r = tid >> 3, g = tid & 7; pf4 = *(const uint4*)(base + (size_t)r * NINP + 1024 + h * 128 + vh * 64 + g * 8); }
  if (tid >= 64 && tid < 128) {
    const int tl = tid - 64, t = c * 64 + (d ? 63 - tl : tl);
    const bfr* pr = p.P + (size_t)(rb + t) * NINP + C_GDN;
    araw = pr[2048 + d * 4 + h]; braw = pr[2056 + d * 4 + h];
  }
}
template <int L>
DEVINL void scan_gdn2(const Params& p, int item, char* sm) {
  const int vh = item & 1, d = (item >> 1) & 1, h = (item >> 2) & 3, b = item >> 4;
  const int tid = threadIdx.x, lane = tid & 63, wave = __builtin_amdgcn_readfirstlane(tid >> 6);
  constexpr int LQ = 136, LB = 72, LF = 68;
  bfr* QN = (bfr*)sm; bfr* KN = QN + 64 * LQ; bfr* U0 = KN + 64 * LQ; bfr* KdT = U0 + 64 * LB; bfr* Tm = KdT + 128 * LB; bfr* ATm = Tm + 64 * LB; bfr* ST = ATm + 64 * LB;
  float* SMALL = (float*)(ST + 64 * LQ);
  float* TMPX = SMALL + 512;
  bfr* ZT = (bfr*)(TMPX + 6 * 256);
  char* REG = (char*)(ZT + 64 * LB);
  float* Lf = (float*)REG; float* Tf = Lf + 64 * LF;
  bfr* VnT = (bfr*)REG; bfr* OST = VnT + 64 * LB;
  for (int i = tid; i < 64 * LQ; i += NTHR) ST[i] = 0;
  const float Aneg = -__expf(p.gdn_a_log[L * 8 + d * 4 + h]), dtb = p.gdn_dt_bias[L * 8 + d * 4 + h];
  f32x4 Sm[4];
#pragma unroll
  for (int u = 0; u < 4; ++u) Sm[u] = f32x4{0.f, 0.f, 0.f, 0.f};
  uint4 pf0, pf1, pf2, pf3, pf4; bfr araw = 0, braw = 0;
  gdn_prefetch(p, pf0, pf1, pf2, pf3, pf4, araw, braw, 0, b, d, h, vh);
#define GDN_GBETA(DST) do { \
    float g_ = Aneg * softplus(bf2f(araw) + dtb); const float beta_ = sigm(bf2f(braw)); \
    _Pragma("unroll") for (int o_ = 1; o_ < 64; o_ <<= 1) { const float n_ = __shfl_up(g_, o_); if (lane >= o_) g_ += n_; } \
    const float g63_ = __shfl(g_, 63); \
    (DST)[lane] = g_; (DST)[64 + lane] = beta_; (DST)[128 + lane] = __expf(g63_ - g_); (DST)[192 + lane] = __expf(g_); } while (0)
  if (wave == 1) GDN_GBETA(SMALL);
  __syncthreads();
#pragma unroll 1
  for (int step = 0; step < 68; ++step) {
    int rb, len, c; chunk_of_step(step, b, d, rb, len, c);
    float* Gs = SMALL + (step & 1) * 256; float* Bts = Gs + 64; float* EK = Bts + 64; float* EG = EK + 64;
    float* SMn = SMALL + ((step + 1) & 1) * 256;
    __builtin_amdgcn_s_waitcnt(0x0F70);
    {
      const int r = tid >> 4, g = tid & 15, i0 = d ? 63 - r : r, i1 = d ? 31 - r : r + 32;
      *(uint4*)(QN + i0 * LQ + g * 8) = pf0; *(uint4*)(QN + i1 * LQ + g * 8) = pf1;
      *(uint4*)(KN + i0 * LQ + g * 8) = pf2; *(uint4*)(KN + i1 * LQ + g * 8) = pf3;
    }
    {
      const int r = tid >> 3, g = tid & 7, i = d ? 63 - r : r;
      float y[8]; unpack8(pf4, y);
      const float bt = Bts[i];
      *(uint4*)(U0 + i * LB + g * 8) = make_uint4(pack2(y[0] * bt, y[1] * bt), pack2(y[2] * bt, y[3] * bt), pack2(y[4] * bt, y[5] * bt), pack2(y[6] * bt, y[7] * bt));
    }
    if (step > 0) {
      int rbp, lenp, cp; chunk_of_step(step - 1, b, d, rbp, lenp, cp);
      const int i = tid >> 3, c8 = (tid & 7) * 8, t = d ? 63 - i : i;
      *(uint4*)(p.O + (size_t)(rbp + cp * 64 + t) * OLD + d * 2048 + 3 * 512 + h * 128 + vh * 64 + c8) = *(const uint4*)(OST + i * LB + c8);
    }
    if (step + 1 < 68) gdn_prefetch(p, pf0, pf1, pf2, pf3, pf4, araw, braw, step + 1, b, d, h, vh);
    __syncthreads();
    {
      const int k = tid & 127, jq = (tid >> 7) * 16;
      float v[16];
#pragma unroll
      for (int q = 0; q < 16; ++q) v[q] = bf2f(KN[(jq + q) * LQ + k]) * EK[jq + q];
      *(uint4*)(KdT + k * LB + jq) = make_uint4(pack2(v[0], v[1]), pack2(v[2], v[3]), pack2(v[4], v[5]), pack2(v[6], v[7]));
      *(uint4*)(KdT + k * LB + jq + 8) = make_uint4(pack2(v[8], v[9]), pack2(v[10], v[11]), pack2(v[12], v[13]), pack2(v[14], v[15]));
    }
#pragma unroll 1
    for (int u = 0; u < 4; ++u) {
      const int id = 4 * wave + u;
      if (id < 16) {
        const int ti = id >> 2, tj = id & 3;
        if (tj <= ti) {
          const f32x4 a = mma16<4>(KN + ti * 16 * LQ, LQ, KN + tj * 16 * LQ, LQ, f32x4{0.f, 0.f, 0.f, 0.f});
#pragma unroll
          for (int r = 0; r < 4; ++r) {
            const int i = ti * 16 + (lane >> 4) * 4 + r, j = tj * 16 + (lane & 15);
            Lf[i * LF + j] = (j < i) ? a[r] * __expf(Gs[i] - Gs[j]) * Bts[i] : 0.f;
          }
        }
      } else {
        const int ti = (id - 16) >> 2, tj = (id - 16) & 3;
        f32x4 a = f32x4{0.f, 0.f, 0.f, 0.f};
        if (tj <= ti) a = mma16<4>(KN + tj * 16 * LQ, LQ, QN + ti * 16 * LQ, LQ, a);
        const int i = ti * 16 + (lane & 15), j0 = tj * 16 + (lane >> 4) * 4;
        float v4[4];
#pragma unroll
        for (int r = 0; r < 4; ++r) { const int j = j0 + r; v4[r] = (j <= i) ? a[r] * __expf(Gs[i] - Gs[j]) : 0.f; }
        *(uint2*)(ATm + i * LB + j0) = make_uint2(pack2(v4[0], v4[1]), pack2(v4[2], v4[3]));
      }
    }
    __syncthreads();
    f32x4 o1[4];
    if (wave == 1) { if (step + 1 < 68) GDN_GBETA(SMn); }
    else if (wave >= 4) {
#pragma unroll
      for (int u = 0; u < 4; ++u) {
        const int id = 4 * (wave - 4) + u, ti = id >> 2, tv = id & 3;
        const f32x4 y = mma16<4>(KN + ti * 16 * LQ, LQ, ST + tv * 16 * LQ, LQ, f32x4{0.f, 0.f, 0.f, 0.f});
        f32x4 q1 = mma16<4>(QN + ti * 16 * LQ, LQ, ST + tv * 16 * LQ, LQ, f32x4{0.f, 0.f, 0.f, 0.f});
        const int i0 = ti * 16 + (lane >> 4) * 4, v = tv * 16 + (lane & 15);
        float z[4];
#pragma unroll
        for (int r = 0; r < 4; ++r) { const int i = i0 + r; const float eg = EG[i]; z[r] = bf2f(U0[i * LB + v]) - Bts[i] * eg * y[r]; q1[r] *= eg; }
        o1[u] = q1;
        *(uint2*)(ZT + v * LB + i0) = make_uint2(pack2(z[0], z[1]), pack2(z[2], z[3]));
        asm volatile("" ::: "memory");
      }
    }
    if (wave == 0) {
      const int blk = lane >> 4, cc = lane & 15;
      float x[16];
#pragma unroll
      for (int i = 0; i < 16; ++i) x[i] = (i == cc) ? 1.f : 0.f;
#pragma unroll
      for (int i = 1; i < 16; ++i) {
        const float* lr = Lf + (16 * blk + i) * LF + 16 * blk;
#pragma unroll
        for (int j4 = 0; j4 < (i + 3) / 4; ++j4) {
          const float4 l4 = *(const float4*)(lr + 4 * j4);
          const float la[4] = {l4.x, l4.y, l4.z, l4.w};
#pragma unroll
          for (int e = 0; e < 4; ++e) if (4 * j4 + e < i) x[i] -= la[e] * x[4 * j4 + e];
        }
        asm volatile("" ::: "memory");
      }
#pragma unroll
      for (int i = 0; i < 16; ++i) Tf[(16 * blk + i) * LF + 16 * blk + cc] = x[i];
    }
    __syncthreads();
    if (wave < 3) {
      const int bi = wave + 1, bj = wave;
      f32x4 xa = bmm16(Lf + 16 * bi * LF + 16 * bj, LF, Tf + 16 * bj * LF + 16 * bj, LF, f32x4{0.f, 0.f, 0.f, 0.f});
      float* X = TMPX + wave * 256;
#pragma unroll
      for (int r = 0; r < 4; ++r) X[((lane >> 4) * 4 + r) * 16 + (lane & 15)] = xa[r];
      asm volatile("s_waitcnt lgkmcnt(0)" ::: "memory");
      const f32x4 ta = bmm16(Tf + 16 * bi * LF + 16 * bi, LF, X, 16, f32x4{0.f, 0.f, 0.f, 0.f});
#pragma unroll
      for (int r = 0; r < 4; ++r) Tf[(16 * bi + (lane >> 4) * 4 + r) * LF + 16 * bj + (lane & 15)] = -ta[r];
    }
    __syncthreads();
    if (wave < 2) {
      const int bi = wave + 2, bj = wave;
      f32x4 xa = bmm16(Lf + 16 * bi * LF + 16 * bj, LF, Tf + 16 * bj * LF + 16 * bj, LF, f32x4{0.f, 0.f, 0.f, 0.f});
      xa = bmm16(Lf + 16 * bi * LF + 16 * (bj + 1), LF, Tf + 16 * (bj + 1) * LF + 16 * bj, LF, xa);
      float* X = TMPX + (3 + wave) * 256;
#pragma unroll
      for (int r = 0; r < 4; ++r) X[((lane >> 4) * 4 + r) * 16 + (lane & 15)] = xa[r];
      asm volatile("s_waitcnt lgkmcnt(0)" ::: "memory");
      const f32x4 ta = bmm16(Tf + 16 * bi * LF + 16 * bi, LF, X, 16, f32x4{0.f, 0.f, 0.f, 0.f});
#pragma unroll
      for (int r = 0; r < 4; ++r) Tf[(16 * bi + (lane >> 4) * 4 + r) * LF + 16 * bj + (lane & 15)] = -ta[r];
    }
    __syncthreads();
    if (wave == 0) {
      f32x4 xa = bmm16(Lf + 48 * LF, LF, Tf, LF, f32x4{0.f, 0.f, 0.f, 0.f});
      xa = bmm16(Lf + 48 * LF + 16, LF, Tf + 16 * LF, LF, xa);
      xa = bmm16(Lf + 48 * LF + 32, LF, Tf + 32 * LF, LF, xa);
      float* X = TMPX + 5 * 256;
#pragma unroll
      for (int r = 0; r < 4; ++r) X[((lane >> 4) * 4 + r) * 16 + (lane & 15)] = xa[r];
      asm volatile("s_waitcnt lgkmcnt(0)" ::: "memory");
      const f32x4 ta = bmm16(Tf + 48 * LF + 48, LF, X, 16, f32x4{0.f, 0.f, 0.f, 0.f});
#pragma unroll
      for (int r = 0; r < 4; ++r) Tf[(48 + (lane >> 4) * 4 + r) * LF + (lane & 15)] = -ta[r];
    }
    __syncthreads();
    for (int idx = tid; idx < 64 * 16; idx += NTHR) {
      const int i = idx >> 4, j4 = (idx & 15) * 4;
      float tv[4];
#pragma unroll
      for (int e = 0; e < 4; ++e) tv[e] = ((j4 >> 4) <= (i >> 4)) ? Tf[i * LF + j4 + e] : 0.f;
      *(uint2*)(Tm + i * LB + j4) = make_uint2(pack2(tv[0], tv[1]), pack2(tv[2], tv[3]));
    }
    __syncthreads();
#pragma unroll
    for (int u = 0; u < 2; ++u) {
      const int id = 2 * wave + u, ti = id >> 2, tv = id & 3;
      const f32x4 vn = mma16<2>(Tm + ti * 16 * LB, LB, ZT + tv * 16 * LB, LB, f32x4{0.f, 0.f, 0.f, 0.f});
      *(uint2*)(VnT + (tv * 16 + (lane & 15)) * LB + ti * 16 + (lane >> 4) * 4) = make_uint2(pack2(vn[0], vn[1]), pack2(vn[2], vn[3]));
    }
    __syncthreads();
    {
      const float gl = __expf(Gs[63]);
      if (wave >= 4) {
#pragma unroll
        for (int u = 0; u < 4; ++u) {
          const int id = 4 * (wave - 4) + u, ti = id >> 2, tv = id & 3;
          const f32x4 o = mma16<2>(ATm + ti * 16 * LB, LB, VnT + tv * 16 * LB, LB, o1[u]);
#pragma unroll
          for (int r = 0; r < 4; ++r) OST[(ti * 16 + (lane >> 4) * 4 + r) * LB + tv * 16 + (lane & 15)] = f2bf(o[r]);
        }
      }
#pragma unroll
      for (int u = 0; u < 4; ++u) {
        const int id = 4 * wave + u, tk = id >> 2, tv = id & 3;
        Sm[u] = mma16<2>(KdT + tk * 16 * LB, LB, VnT + tv * 16 * LB, LB, Sm[u] * gl);
        *(uint2*)(ST + (tv * 16 + (lane & 15)) * LQ + tk * 16 + (lane >> 4) * 4) = make_uint2(pack2(Sm[u][0], Sm[u][1]), pack2(Sm[u][2], Sm[u][3]));
        asm volatile("" ::: "memory");
      }
    }
    __syncthreads();
  }
  {
    int rb, len, c; chunk_of_step(67, b, d, rb, len, c);
    const int i = tid >> 3, c8 = (tid & 7) * 8, t = d ? 63 - i : i;
    *(uint4*)(p.O + (size_t)(rb + c * 64 + t) * OLD + d * 2048 + 3 * 512 + h * 128 + vh * 64 + c8) = *(const uint4*)(OST + i * LB + c8);
  }
#undef GDN_GBETA
}

template <int L> DEVINL void phase_gproj(const Params& p, char* sm, int c);
template <int L>
DEVINL void phase_scans(const Params& p, char* sm) {
  const int it = blockIdx.x;
  if (it < 64) scan_rwkv3<L>(p, it, sm);
  else if (it < 128) scan_gdn2<L>(p, it - 64, sm);
  else if (it < 192) scan_ssm2<L>(p, it - 128, sm);
  else if (it < 224) scan_gla2<L>(p, it - 192, sm);
  else {
    phase_gproj<L>(p, sm, it - 224);
  }
}

template <int L>
DEVINL void phase_post2(const Params& p) {
  const int lane = threadIdx.x & 63, wave = threadIdx.x >> 6;
  const int nrows = (L == 1) ? TL : T;
  const int c8 = lane * 8;
  float pw_ssm[8], pw_gla[8], pw_lnw[8], pw_lnb[8], pw_gdn[8];
#pragma unroll
  for (int e = 0; e < 8; ++e) {
    pw_ssm[e] = p.ssm_norm[L * 512 + c8 + e]; pw_gla[e] = p.gla_norm[L * 128 + ((c8 + e) & 127)]; pw_lnw[e] = p.rwkv_ln_w[L * 512 + c8 + e];
    pw_lnb[e] = p.rwkv_ln_b[L * 512 + c8 + e]; pw_gdn[e] = p.gdn_norm[L * 128 + ((c8 + e) & 127)];
  }
  const float dssm = p.ssm_d[L * 8 + (lane >> 3)];
  for (int R = blockIdx.x * 8 + wave; R < nrows; R += gridDim.x * 8) {
    const bool lat = R < TL; const int vvb = lat ? (R >> 12) : 4;
    bfr* orow = p.O + (size_t)R * OLD; const bfr* prow = p.P + (size_t)R * NINP;
    uint4 of_[4], ob_[4];
#pragma unroll
    for (int m = 0; m < 4; ++m) { of_[m] = *(const uint4*)(orow + m * 512 + c8); ob_[m] = *(const uint4*)(orow + 2048 + m * 512 + c8); }
    const uint4 pxh = *(const uint4*)(prow + C_SSM + 512 + c8), pz = *(const uint4*)(prow + C_SSM + c8), prg = *(const uint4*)(prow + C_GLA + 1024 + c8);
    const uint4 pv = *(const uint4*)(prow + C_RWKV + 1024 + c8), pzg = *(const uint4*)(prow + C_GDN + 1536 + c8), pgg = *(const uint4*)(p.Gb + (size_t)R * 512 + c8);
    const int cr = lat ? canon_row(L, R) : R;
    const float* xp = lat ? p.out + (size_t)cr * D : p.xc + (size_t)(R - TL) * D;
    float4 xv[4];
#pragma unroll
    for (int q = 0; q < 4; ++q) xv[q] = *(const float4*)(xp + q * 256 + lane * 4);
    const float bsum = p.bon[((size_t)0 * T + R) * 8 + (lane >> 3)] + p.bon[((size_t)1 * T + R) * 8 + (lane >> 3)];
    float a[8], b[8], t1[8], t2[8];
    float y0[8]; float ss0 = 0.f;
    unpack8(of_[0], a); unpack8(ob_[0], b); unpack8(pxh, t1); unpack8(pz, t2);
#pragma unroll
    for (int e = 0; e < 8; ++e) { y0[e] = (a[e] + b[e] + dssm * t1[e]) * silu(t2[e]); ss0 += y0[e] * y0[e]; }
    ss0 = dpp_sum16(ss0); ss0 += __shfl_xor(ss0, 16);
    float y1[8]; float ss1 = 0.f;
    unpack8(of_[1], a); unpack8(ob_[1], b); unpack8(prg, t1);
#pragma unroll
    for (int e = 0; e < 8; ++e) { y1[e] = a[e] + b[e]; ss1 += y1[e] * y1[e]; }
    ss1 = dpp_sum16(ss1);
    const float r1 = __builtin_amdgcn_rsqf(ss1 * (1.f / 128.f) + EPS);
#pragma unroll
    for (int e = 0; e < 8; ++e) y1[e] = y1[e] * r1 * pw_gla[e] * silu(t1[e]);
    float y2[8]; float s2 = 0.f;
    unpack8(of_[2], a); unpack8(ob_[2], b); unpack8(pv, t1); unpack8(pgg, t2);
#pragma unroll
    for (int e = 0; e < 8; ++e) { y2[e] = a[e] + b[e]; s2 += y2[e]; }
    const float mu = dpp_sum8(s2) * (1.f / 64.f);
    float v2 = 0.f;
#pragma unroll
    for (int e = 0; e < 8; ++e) { y2[e] -= mu; v2 += y2[e] * y2[e]; }
    const float r2 = __builtin_amdgcn_rsqf(dpp_sum8(v2) * (1.f / 64.f) + 64e-5f);
#pragma unroll
    for (int e = 0; e < 8; ++e) y2[e] = (y2[e] * r2 * pw_lnw[e] + pw_lnb[e] + bsum * t1[e]) * t2[e];
    float y3[8]; float ss3 = 0.f;
    unpack8(of_[3], a); unpack8(ob_[3], b); unpack8(pzg, t1);
#pragma unroll
    for (int e = 0; e < 8; ++e) { y3[e] = a[e] + b[e]; ss3 += y3[e] * y3[e]; }
    ss3 = dpp_sum16(ss3);
    const float r3 = __builtin_amdgcn_rsqf(ss3 * (1.f / 128.f) + EPS);
#pragma unroll
    for (int e = 0; e < 8; ++e) y3[e] = y3[e] * r3 * pw_gdn[e] * silu(t1[e]);
    const float r0 = __builtin_amdgcn_rsqf(ss0 * (1.f / 256.f) + EPS);
#pragma unroll
    for (int e = 0; e < 8; ++e) y0[e] = y0[e] * r0 * pw_ssm[e];
    float xs = 0.f;
#pragma unroll
    for (int q = 0; q < 4; ++q) xs += xv[q].x * xv[q].x + xv[q].y * xv[q].y + xv[q].z * xv[q].z + xv[q].w * xv[q].w;
    xs = wave_sum(xs);
    const float rs = __builtin_amdgcn_rsqf(xs * (1.f / 1024.f) + EPS);
    const float* md = p.mod + ((size_t)L * 5 + vvb) * 6144;
    *(uint4*)(orow + 0 * 512 + c8) = make_uint4(pack2(y0[0], y0[1]), pack2(y0[2], y0[3]), pack2(y0[4], y0[5]), pack2(y0[6], y0[7]));
    *(uint4*)(orow + 1 * 512 + c8) = make_uint4(pack2(y1[0], y1[1]), pack2(y1[2], y1[3]), pack2(y1[4], y1[5]), pack2(y1[6], y1[7]));
    *(uint4*)(orow + 2 * 512 + c8) = make_uint4(pack2(y2[0], y2[1]), pack2(y2[2], y2[3]), pack2(y2[4], y2[5]), pack2(y2[6], y2[7]));
    *(uint4*)(orow + 3 * 512 + c8) = make_uint4(pack2(y3[0], y3[1]), pack2(y3[2], y3[3]), pack2(y3[4], y3[5]), pack2(y3[6], y3[7]));
#pragma unroll
    for (int q = 0; q < 4; ++q) {
      const int j = q * 256 + lane * 4;
      const float4 nw = *(const float4*)(p.norm_mix + L * D + j), sh = *(const float4*)(md + j), scl = *(const float4*)(md + 1024 + j);
      const float h0 = xv[q].x * rs * nw.x * (1.f + scl.x) + sh.x, h1 = xv[q].y * rs * nw.y * (1.f + scl.y) + sh.y;
      const float h2 = xv[q].z * rs * nw.z * (1.f + scl.z) + sh.z, h3 = xv[q].w * rs * nw.w * (1.f + scl.w) + sh.w;
      *(uint2*)(orow + 2048 + j) = make_uint2(pack2(h0, h1), pack2(h2, h3));
    }
  }
}

template <int L>
DEVINL void phase_route(const Params& p, char* sm) {
  const int tid = threadIdx.x, lane = tid & 63, wave = tid >> 6;
  float* rw = (float*)sm;
  __syncthreads();
  for (int i = tid; i < 1024 * 16; i += NTHR) rw[(i & 15) * 1024 + (i >> 4)] = p.router_w[i];
  __syncthreads();
  const int ntok = (L == 1) ? TL : T;
  for (int tk = blockIdx.x * 8 + wave; tk < ntok; tk += gridDim.x * 8) {
    const bool lat = tk < TL;
    const int vv = lat ? (tk >> 12) : 4;
    const float* xp = lat ? p.out + (size_t)tk * D : p.xc + (size_t)(tk - TL) * D;
    float ss = 0.f;
#pragma unroll
    for (int q = 0; q < 4; ++q) {
      const float4 xv = *(const float4*)(xp + q * 256 + lane * 4);
      ss += xv.x * xv.x + xv.y * xv.y + xv.z * xv.z + xv.w * xv.w;
    }
    ss = wave_sum(ss);
    const float rs = rsqrtf(ss * (1.f / 1024.f) + EPS);
    const float* md = p.mod + ((size_t)L * 5 + vv) * 6144;
    float lg[16];
#pragma unroll
    for (int e = 0; e < 16; ++e) lg[e] = 0.f;
#pragma unroll 1
    for (int q = 0; q < 4; ++q) {
      const int j = q * 256 + lane * 4;
      const float4 xv = *(const float4*)(xp + j);
      const float4 nw = *(const float4*)(p.norm_ffn + L * D + j), sh = *(const float4*)(md + 3 * 1024 + j), scl = *(const float4*)(md + 4 * 1024 + j);
      float hv[4];
      hv[0] = xv.x * rs * nw.x * (1.f + scl.x) + sh.x; hv[1] = xv.y * rs * nw.y * (1.f + scl.y) + sh.y;
      hv[2] = xv.z * rs * nw.z * (1.f + scl.z) + sh.z; hv[3] = xv.w * rs * nw.w * (1.f + scl.w) + sh.w;
      uint2 o; o.x = (unsigned)f2bf(hv[0]) | ((unsigned)f2bf(hv[1]) << 16); o.y = (unsigned)f2bf(hv[2]) | ((unsigned)f2bf(hv[3]) << 16);
      *(uint2*)(p.HF + (size_t)tk * D + j) = o;
#pragma unroll
      for (int e = 0; e < 16; ++e) {
        const float4 r4 = *(const float4*)&rw[e * 1024 + j];
        lg[e] += hv[0] * r4.x + hv[1] * r4.y + hv[2] * r4.z + hv[3] * r4.w;
      }
    }
    {
      float sel = 0.f;
#pragma unroll
      for (int e = 0; e < 16; ++e) { const float rsum = dpp_sum16(lg[e]); sel = ((lane & 15) == e) ? rsum : sel; }
      sel += __shfl_xor(sel, 16); sel += __shfl_xor(sel, 32);
#pragma unroll
      for (int e = 0; e < 16; ++e) lg[e] = __int_as_float(__builtin_amdgcn_readlane(__float_as_int(sel), e));
    }
    if (lane == 0) {
      float sc[16], sel[16];
#pragma unroll
      for (int e = 0; e < 16; ++e) { sc[e] = sigm(lg[e]); sel[e] = sc[e] + p.router_b[e]; }
      int bg = 0; float bgs = -1e30f;
#pragma unroll
      for (int g = 0; g < 4; ++g) {
        float m1 = -1e30f, m2 = -1e30f;
#pragma unroll
        for (int u = 0; u < 4; ++u) { const float s = sel[g * 4 + u]; if (s > m1) { m2 = m1; m1 = s; } else if (s > m2) m2 = s; }
        const float gs = m1 + m2;
        if (gs > bgs) { bgs = gs; bg = g; }
      }
      int i1 = 0, i2 = 0; float m1 = -1e30f, m2 = -1e30f;
#pragma unroll
      for (int u = 0; u < 4; ++u) {
        float s = 0.f, c2 = 0.f;
#pragma unroll
        for (int g = 0; g < 4; ++g) if (g == bg) { s = sel[g * 4 + u]; }
        (void)c2;
        if (s > m1) { m2 = m1; i2 = i1; m1 = s; i1 = u; } else if (s > m2) { m2 = s; i2 = u; }
      }
      const int e1 = bg * 4 + i1, e2 = bg * 4 + i2;
      float s1 = 0.f, s2 = 0.f;
#pragma unroll
      for (int e = 0; e < 16; ++e) { if (e == e1) s1 = sc[e]; if (e == e2) s2 = sc[e]; }
      const float inv = 1.f / (s1 + s2);
      const int p1 = atomicAdd(&p.cnt[L * 16 + e1], 1), p2 = atomicAdd(&p.cnt[L * 16 + e2], 1);
      p.list[(size_t)e1 * T + p1] = tk * 2; p.list[(size_t)e2 * T + p2] = tk * 2 + 1;
      p.gatew[tk * 2] = s1 * inv; p.gatew[tk * 2 + 1] = s2 * inv;
    }
  }
}

namespace g8 {
DEVINL uint4 pack8(const f32x4& a, const f32x4& b) { return make_uint4(pack2(a[0], a[1]), pack2(a[2], a[3]), pack2(b[0], b[1]), pack2(b[2], b[3])); }
struct EpiP {
  static constexpr bool PERM = true;
  bfr* C; int ldc; int act;
  DEVINL void operator()(const Acc& acc, const Unit& u, int wr, int wc, int fr, int fq) const {
    const int row0 = u.pm * 256 + wr * 64 + fr, col0 = u.pn * 256 + wc * 32 + 8 * fq;
#pragma unroll
    for (int ai = 0; ai < 2; ++ai)
#pragma unroll
      for (int m = 0; m < 4; ++m) {
        bfr* rowp = C + (size_t)(row0 + ai * 128 + m * 16) * ldc + col0;
#pragma unroll
        for (int bj = 0; bj < 2; ++bj) {
          f32x4 v0 = acc[ai][bj][m][0], v1 = acc[ai][bj][m][1];
          if (act) {
#pragma unroll
            for (int j = 0; j < 4; ++j) { v0[j] = sigm(v0[j]); v1[j] = sigm(v1[j]); }
          }
          *(uint4*)(rowp + bj * 128) = pack8(v0, v1);
        }
      }
  }
};
struct EpiBranch {
  static constexpr bool PERM = true;
  bfr* ACC; const bfr* GATES; bfr* ACC2;
  DEVINL void operator()(const Acc& acc, const Unit& u, int wr, int wc, int fr, int fq) const {
    const int row0 = u.pm * 256 + wr * 64 + fr, col0 = u.pn * 256 + wc * 32 + 8 * fq;
    const bool alt = u.pm >= 64 && u.e >= 2, first = alt ? (u.e == 2) : (u.e == 0);
    bfr* const dstb = alt ? ACC2 - (size_t)TL * 1024 : ACC;
#pragma unroll
    for (int ai = 0; ai < 2; ++ai) {
      uint4 gq[4][2], pq[4][2];
#pragma unroll
      for (int m = 0; m < 4; ++m)
#pragma unroll
        for (int bj = 0; bj < 2; ++bj) {
          const size_t row = (size_t)(row0 + ai * 128 + m * 16); const int col = col0 + bj * 128;
          gq[m][bj] = *(const uint4*)(GATES + row * 4096 + u.e * 1024 + col);
          pq[m][bj] = first ? make_uint4(0, 0, 0, 0) : *(const uint4*)(dstb + row * 1024 + col);
        }
#pragma unroll
      for (int m = 0; m < 4; ++m)
#pragma unroll
        for (int bj = 0; bj < 2; ++bj) {
          const size_t row = (size_t)(row0 + ai * 128 + m * 16); const int col = col0 + bj * 128;
          float gt[8], pv[8];
          unpack8(gq[m][bj], gt); unpack8(pq[m][bj], pv);
          f32x4 v0, v1;
#pragma unroll
          for (int j = 0; j < 4; ++j) { v0[j] = pv[j] + gt[j] * acc[ai][bj][m][0][j]; v1[j] = pv[4 + j] + gt[4 + j] * acc[ai][bj][m][1][j]; }
          *(uint4*)(dstb + row * 1024 + col) = pack8(v0, v1);
        }
    }
  }
};
struct EpiOut {
  static constexpr bool PERM = false;
  float* xlat; float* xctx; const float* mod; int layer;
  DEVINL void operator()(const Acc& acc, const Unit& u, int wr, int wc, int fr, int fq) const {
    const int row0 = u.pm * 256 + wr * 64 + fr, col0 = u.pn * 256 + wc * 32 + 4 * fq;
#pragma unroll
    for (int ai = 0; ai < 2; ++ai) {
      float4 xq[4][2][2];
      float* xpp[4];
      const float* m2p = nullptr;
#pragma unroll
      for (int m = 0; m < 4; ++m) {
        const int R = row0 + ai * 128 + m * 16;
        const bool lat = R < TL;
        xpp[m] = lat ? xlat + (size_t)canon_row(layer, R) * D : xctx + (size_t)(R - TL) * D;
        if (m == 0) m2p = mod + ((size_t)layer * 5 + (lat ? (R >> 12) : 4)) * 6144 + 2 * 1024;
#pragma unroll
        for (int bj = 0; bj < 2; ++bj)
#pragma unroll
          for (int n = 0; n < 2; ++n) xq[m][bj][n] = *(const float4*)(xpp[m] + col0 + bj * 128 + n * 16);
      }
      float4 mq[2][2];
#pragma unroll
      for (int bj = 0; bj < 2; ++bj)
#pragma unroll
        for (int n = 0; n < 2; ++n) mq[bj][n] = *(const float4*)(m2p + col0 + bj * 128 + n * 16);
#pragma unroll
      for (int m = 0; m < 4; ++m)
#pragma unroll
        for (int bj = 0; bj < 2; ++bj)
#pragma unroll
          for (int n = 0; n < 2; ++n) {
            float4 xv = xq[m][bj][n]; const float4 mv = mq[bj][n]; const f32x4 a = acc[ai][bj][m][n];
            xv.x += mv.x * a[0]; xv.y += mv.y * a[1]; xv.z += mv.z * a[2]; xv.w += mv.w * a[3];
            *(float4*)(xpp[m] + col0 + bj * 128 + n * 16) = xv;
          }
    }
  }
};
struct EpiMoeUp {
  static constexpr bool PERM = true;
  bfr* HB; const int* list; const int* cnt;
  DEVINL void operator()(const Acc& acc, const Unit& u, int wr, int wc, int fr, int fq) const {
    const int ce = cnt[u.e];
#pragma unroll
    for (int ai = 0; ai < 2; ++ai) {
      int en[4];
#pragma unroll
      for (int m = 0; m < 4; ++m) { const int ei = u.pm * 256 + ai * 128 + wr * 64 + m * 16 + fr; en[m] = ei < ce ? list[(size_t)u.e * T + ei] : -1; }
#pragma unroll
      for (int m = 0; m < 4; ++m) {
        if (en[m] >= 0) {
          f32x4 v0, v1;
#pragma unroll
          for (int j = 0; j < 4; ++j) { v0[j] = silu(acc[ai][0][m][0][j]) * acc[ai][1][m][0][j]; v1[j] = silu(acc[ai][0][m][1][j]) * acc[ai][1][m][1][j]; }
          *(uint4*)(HB + (size_t)en[m] * 512 + u.pn * 128 + wc * 32 + 8 * fq) = pack8(v0, v1);
        }
      }
    }
  }
};
struct EpiMoeDown {
  static constexpr bool PERM = true;
  bfr* YS; const int* list; const int* cnt; const float* gatew;
  DEVINL void operator()(const Acc& acc, const Unit& u, int wr, int wc, int fr, int fq) const {
    const int ce = cnt[u.e];
#pragma unroll
    for (int ai = 0; ai < 2; ++ai) {
      int en[4]; float gw[4];
#pragma unroll
      for (int m = 0; m < 4; ++m) { const int ei = u.pm * 256 + ai * 128 + wr * 64 + m * 16 + fr; en[m] = ei < ce ? list[(size_t)u.e * T + ei] : -1; }
#pragma unroll
      for (int m = 0; m < 4; ++m) gw[m] = en[m] >= 0 ? gatew[en[m]] : 0.f;
#pragma unroll
      for (int m = 0; m < 4; ++m) {
        if (en[m] >= 0) {
          bfr* yp = YS + (size_t)(en[m] & 1) * T * D + (size_t)(en[m] >> 1) * D + u.pn * 256 + wc * 32 + 8 * fq;
#pragma unroll
          for (int bj = 0; bj < 2; ++bj) *(uint4*)(yp + bj * 128) = pack8(acc[ai][bj][m][0] * gw[m], acc[ai][bj][m][1] * gw[m]);
        }
      }
    }
  }
};
}

template <int L>
DEVINL void phase_gproj(const Params& p, char* sm, int c) {
  g8::TileSched S; S.init(L == 1 ? 64 : 68, 2); S.G = 32; S.c = c;
  g8::EpiP E{p.Gb, 512, 0};
  g8::RowAddr aA{NINP, 0, 0u}, aB{256, 1, 0u};
  g8::gemm8((LAS unsigned char*)sm, (const char*)(p.P + C_RWKV + 1792), (const char*)p.g2T, 256, S, E, aA, aB);
}
template <int L>
DEVINL void phase_gemm_in8(const Params& p, char* sm) {
  g8::TileSched S; S.init(T / 256, NINP / 256);
  g8::EpiP E{p.P, NINP, 0};
  g8::RowAddr aA{OLD, 0, 0u}, aB{D, 1, 0u};
  g8::gemm8(( LAS unsigned char*)sm, (const char*)(p.O + 2048), (const char*)p.WinT, D, S, E, aA, aB);
  if (L == 0 && blockIdx.x >= 44) {
    __syncthreads();
    convert_range<false>(p, 0, 1728 + blockIdx.x - 44, CONV_L_ITEMS, gridDim.x - 44, sm);
  }
}
template <int L>
DEVINL void phase_gates8(const Params& p, char* sm) {
  g8::TileSched S; S.init(L == 1 ? 64 : 68, 16);
  g8::EpiP E{p.GATES, 4096, 1};
  g8::RowAddr aA{OLD, 0, 0u}, aB{D, 1, 0u};
  g8::gemm8((LAS unsigned char*)sm, (const char*)(p.O + 2048), (const char*)p.WgT, D, S, E, aA, aB);
  __syncthreads();
  if (L == 1) convert_range<true>(p, L, blockIdx.x, 2048, gridDim.x, sm);
}
template <int L>
DEVINL void phase_branch8(const Params& p, char* sm) {
  g8::MergeSched S; S.init(L == 1 ? 64 : 68);
  g8::EpiBranch E{p.ACC, p.GATES, p.ACC2};
  g8::RowAddr aA{OLD, 0, 512u * 2u}, aB{512, 1, (unsigned)(D * 512 * 2)};
  g8::gemm8((LAS unsigned char*)sm, (const char*)p.O, (const char*)p.WbT, 512, S, E, aA, aB);
  __syncthreads();
  if (L == 1) convert_range<true>(p, L, 2048 + blockIdx.x, 4096, gridDim.x, sm);
  else if (blockIdx.x >= 32) convert_range<true>(p, L, blockIdx.x - 32, CONV_M_ITEMS, gridDim.x - 32, sm);
}
struct OutSched0 {
  int n, pmA, pnA, pmB, pnB, eB;
  DEVINL void init() {
    const int c = blockIdx.x; const bool ctx = c >= 240;
    const int t0 = ctx ? c - 240 : c, t1 = 240 + c;
    pmA = ctx ? 64 + (t0 >> 2) : (t0 & 7) * 8 + (t0 >> 5); pnA = ctx ? (t0 & 3) : ((t0 >> 3) & 3);
    pmB = ctx ? pmA : (t1 & 7) * 8 + (t1 >> 5); pnB = ctx ? pnA : ((t1 >> 3) & 3); eB = ctx ? 1 : 0;
    n = (ctx || c < 16) ? 2 : 1;
  }
  DEVINL bool next(int i, g8::Unit& u) const { if (i >= n) return false; u.pm = i ? pmB : pmA; u.pn = i ? pnB : pnA; u.e = i ? eB : 0; return true; }
};
template <int L>
DEVINL void phase_out8(const Params& p, char* sm) {
  g8::EpiOut E{p.out, p.xc, p.mod, L};
  if (L == 0) {
    OutSched0 S; S.init();
    g8::RowAddr aA{D, 0, (unsigned)((const char*)p.ACC2 - (const char*)p.ACC) - (unsigned)TL * 1024u * 2u}, aB{D, 1, 0u};
    g8::gemm8((LAS unsigned char*)sm, (const char*)p.ACC, (const char*)p.WoT, D, S, E, aA, aB);
    __syncthreads();
    if (blockIdx.x >= 16 && blockIdx.x < 240) convert_range<false>(p, 1, blockIdx.x - 16, 3264, 224, sm);
  } else {
    g8::TileSched S; S.init(64, 4);
    g8::RowAddr aA{D, 0, 0u}, aB{D, 1, 0u};
    g8::gemm8((LAS unsigned char*)sm, (const char*)p.ACC, (const char*)p.WoT, D, S, E, aA, aB);
    __syncthreads();
  }
}
template <int L>
DEVINL void phase_moe_up8(const Params& p, char* sm) {
  const int* cnt = p.cnt + L * 16;
  g8::MoeSched S{cnt, 4, (int)gridDim.x, (int)blockIdx.x, 0};
  g8::EpiMoeUp E{p.HB, p.list, cnt};
  g8::GatherAddr aA{p.list, cnt, D * 2, 1};
  g8::RowAddr aB{D, 1, (unsigned)(D * D * 2)};
  g8::gemm8((LAS unsigned char*)sm, (const char*)p.HF, (const char*)p.WmguT, D, S, E, aA, aB);
  {
    int U = 0;
#pragma unroll 1
    for (int e = 0; e < 16; ++e) U += ((cnt[e] + 255) >> 8) * 4;
    const int G = gridDim.x, r = U % G, nl = G - r, c = blockIdx.x;
    int rank = 0;
#pragma unroll 1
    for (int cc = 0; cc < c; ++cc) rank += (((cc & ~127) | ((cc & 7) << 4) | ((cc >> 3) & 15)) >= r) ? 1 : 0;
    const bool light = (((c & ~127) | ((c & 7) << 4) | ((c >> 3) & 15)) >= r);
    const int first = (nl >= 64) ? (light ? rank : -1) : c, stride = (nl >= 64) ? nl : G;
    __syncthreads();
    if (first >= 0) {
      if (L == 0) convert_range<false>(p, 1, 3264 + first, CONV_L_ITEMS, stride, sm);
      else convert_range<true>(p, L, 4096 + first, CONV_M_ITEMS, stride, sm);
    }
  }
}
template <int L>
DEVINL void phase_moe_down8(const Params& p, char* sm) {
  const int* cnt = p.cnt + L * 16;
  g8::MoeSched S{cnt, 4, (int)gridDim.x, (int)blockIdx.x, 0};
  g8::EpiMoeDown E{p.YS, p.list, cnt, p.gatew};
  g8::GatherAddr aA{p.list, cnt, 512 * 2, 0};
  g8::RowAddr aB{512, 1, (unsigned)(D * 512 * 2)};
  g8::gemm8((LAS unsigned char*)sm, (const char*)p.HB, (const char*)p.WmdT, 512, S, E, aA, aB);
}

DEVINL void phase_final(const Params& p) {
  const int lane = threadIdx.x & 63, wave = threadIdx.x >> 6;
  for (int tk = blockIdx.x * 8 + wave; tk < TL; tk += gridDim.x * 8) {
    float* xp = p.out + (size_t)tk * D;
    const int vv = tk >> 12;
    float v[16]; float ss = 0.f;
#pragma unroll
    for (int q = 0; q < 4; ++q) {
      const int j = q * 256 + lane * 4;
      float4 xv = *(const float4*)(xp + j);
      const float4 m5 = *(const float4*)(p.mod + ((size_t)1 * 5 + vv) * 6144 + 5 * 1024 + j);
      const uint2 y0 = *(const uint2*)(p.YS + (size_t)tk * D + j), y1 = *(const uint2*)(p.YS + (size_t)T * D + (size_t)tk * D + j);
      xv.x += m5.x * (bf2f(y0.x & 0xFFFF) + bf2f(y1.x & 0xFFFF)); xv.y += m5.y * (bf2f(y0.x >> 16) + bf2f(y1.x >> 16));
      xv.z += m5.z * (bf2f(y0.y & 0xFFFF) + bf2f(y1.y & 0xFFFF)); xv.w += m5.w * (bf2f(y0.y >> 16) + bf2f(y1.y >> 16));
      v[q * 4] = xv.x; v[q * 4 + 1] = xv.y; v[q * 4 + 2] = xv.z; v[q * 4 + 3] = xv.w;
      ss += xv.x * xv.x + xv.y * xv.y + xv.z * xv.z + xv.w * xv.w;
    }
    ss = wave_sum(ss);
    const float rs = rsqrtf(ss * (1.f / 1024.f) + EPS);
#pragma unroll
    for (int q = 0; q < 4; ++q) {
      const int j = q * 256 + lane * 4;
      const float4 fw = *(const float4*)(p.final_norm + j);
      *(float4*)(xp + j) = make_float4(v[q * 4] * rs * fw.x, v[q * 4 + 1] * rs * fw.y, v[q * 4 + 2] * rs * fw.z, v[q * 4 + 3] * rs * fw.w);
    }
  }
}

constexpr int NPHASE = 24;

template <int L>
DEVINL void layer_phases(const Params& p, const XcdBarrier& bar, char* sm, int ph0, int ph1) {
  constexpr int B0 = 1 + 11 * L;
#define PH(id, call) { if (ph0 <= (id) && (id) < ph1) { call; } if (ph0 <= (id) && (id) + 1 < ph1) xcd_barrier(bar); }
  PH(B0 + 0, phase_norm1<L>(p))
  PH(B0 + 1, phase_gemm_in8<L>(p, sm))
  PH(B0 + 2, phase_prep<L>(p, sm))
  PH(B0 + 3, phase_scans<L>(p, sm))
  PH(B0 + 4, phase_post2<L>(p))
  PH(B0 + 5, phase_gates8<L>(p, sm))
  PH(B0 + 6, phase_branch8<L>(p, sm))
  PH(B0 + 7, phase_out8<L>(p, sm))
  PH(B0 + 8, phase_route<L>(p, sm))
  PH(B0 + 9, phase_moe_up8<L>(p, sm))
  PH(B0 + 10, phase_moe_down8<L>(p, sm))
}

__global__ void __launch_bounds__(NTHR, 2) mega(Params p, unsigned* barw, int ph0, int ph1) {
  extern __shared__ __attribute__((aligned(16))) char smem[];
  if (threadIdx.x == 0) *(uint4*)smem = make_uint4(0u, 0u, 0u, 0u);
  __syncthreads();
  XcdBarrier bar = xcd_barrier_post(barw, (volatile LAS unsigned*)smem);
  char* sm = smem + 16;
  PH(0, phase_prologue(p, sm))
  layer_phases<0>(p, bar, sm, ph0, ph1);
  layer_phases<1>(p, bar, sm, ph0, ph1);
  if (ph0 <= 23 && 23 < ph1) phase_final(p);
}

}

extern "C" void kernel_launch(void* const* d_in, const int* in_sizes, int n_in, void* d_out, int out_size, void* d_ws, size_t ws_size, hipStream_t stream) {
  (void)in_sizes; (void)n_in; (void)out_size;
  static int inited = 0;
  if (!inited) {
    if (hipFuncSetAttribute((const void*)mega, hipFuncAttributeMaxDynamicSharedMemorySize, LDS_BYTES) != hipSuccess) fprintf(stderr, "hipFuncSetAttribute failed\n");
    int per_cu = 0;
    if (hipOccupancyMaxActiveBlocksPerMultiprocessor(&per_cu, (const void*)mega, NTHR, LDS_BYTES) != hipSuccess || per_cu < 1) fprintf(stderr, "occupancy query: %d\n", per_cu);
    inited = 1;
  }
  Params p{};
  const float** f = (const float**)&p;
  for (int i = 0; i < 42; ++i) f[i] = (const float*)d_in[i];
  p.out = (float*)d_out;
  char* w = (char*)d_ws;
  size_t off = 0;
  auto take = [&](size_t bytes) { char* r = w + off; off += (bytes + 255) & ~(size_t)255; return r; };
  unsigned* barw = (unsigned*)take(65536);
  p.cnt = (int*)(barw + 4 * XCD_BAR_WORDS);
  p.xc = (float*)take((size_t)TC * D * 4);
  p.mod = (float*)take((size_t)2 * 5 * 6144 * 4);
  p.bon = (float*)take((size_t)2 * T * 8 * 4);
  p.list = (int*)take((size_t)16 * T * 4);
  p.gatew = (float*)take((size_t)2 * T * 4);
  p.WinT = (bfr*)take((size_t)NINP * D * 2);
  p.WgT = (bfr*)take((size_t)4 * D * D * 2);
  p.WbT = (bfr*)take((size_t)4 * D * 512 * 2);
  p.WoT = (bfr*)take((size_t)D * D * 2);
  p.Gb = (bfr*)take((size_t)T * 512 * 2);
  p.g2T = (bfr*)take((size_t)512 * 256 * 2);
  p.O = (bfr*)take((size_t)T * OLD * 2);
  p.P = (bfr*)take((size_t)T * NINP * 2);
  {
    bfr* q = p.P;
    p.ACC = q; q += (size_t)T * D;
    p.GATES = q;
    p.HF = q; q += (size_t)T * D;
    p.HB = q; q += (size_t)2 * T * 512;
    p.YS = q; q += (size_t)2 * T * D;
    p.WmguT = q; q += (size_t)16 * D * D;
    p.WmdT = q; q += (size_t)16 * D * 512;
    p.ACC2 = q; q += (size_t)TC * D;
  }
  if (off > ws_size) { fprintf(stderr, "workspace too small: need %zu have %zu\n", off, ws_size); return; }
  hipMemsetAsync(barw, 0, 65536, stream);
#if MK_SINGLE
  hipLaunchKernelGGL(mega, dim3(256), dim3(NTHR), LDS_BYTES, stream, p, barw, 0, NPHASE);
#else
  for (int ph = 0; ph < NPHASE; ++ph) hipLaunchKernelGGL(mega, dim3(256), dim3(NTHR), LDS_BYTES, stream, p, barw, ph, ph + 1);
#endif
}
```

```cpp
#include <hip/hip_runtime.h>
#include <stdint.h>
#include <cstdio>

#ifndef MK_SINGLE
#define MK_SINGLE 1
#endif

namespace {

typedef unsigned short bfr;
typedef short bf16x8 __attribute__((ext_vector_type(8)));
typedef float f32x4 __attribute__((ext_vector_type(4)));
typedef float f32x2 __attribute__((ext_vector_type(2)));
typedef __bf16 bf16x2v __attribute__((ext_vector_type(2)));
#define DEVINL __device__ __forceinline__
#define LAS __attribute__((address_space(3)))

constexpr int D = 1024, NB = 4, SEQ = 4096, CTXL = 256;
constexpr int TL = NB * SEQ, TC = NB * CTXL, T = TL + TC;
constexpr int NIN = 6848, NINP = 6912, OLD = 4096;
constexpr int C_SSM = 0, C_GLA = 1296, C_RWKV = 2864, C_GDN = 4784;
constexpr int NTHR = 512;
constexpr int LDS_BYTES = 155648;
constexpr float EPS = 1e-6f;

struct Params {
  const float *x, *c, *ctx, *c_ctx, *ada_w, *ada_b, *norm_mix, *norm_ffn, *w_in, *w_gate, *w_branch, *w_out;
  const float *ssm_conv_w, *ssm_conv_b, *ssm_a_log, *ssm_dt_bias, *ssm_d, *ssm_norm;
  const float *gla_w2, *gla_b, *gla_norm;
  const float *rwkv_mu, *rwkv_w0, *rwkv_w2, *rwkv_a0, *rwkv_a2, *rwkv_g2, *rwkv_k_k, *rwkv_k_a, *rwkv_r_k, *rwkv_ln_w, *rwkv_ln_b;
  const float *gdn_conv_w, *gdn_a_log, *gdn_dt_bias, *gdn_norm;
  const float *router_w, *router_b, *moe_w_gate, *moe_w_up, *moe_w_down, *final_norm;
  float* out;
  float* xc;
  float* mod;
  bfr* O;
  bfr* P;
  bfr *WinT, *WgT, *WbT, *WoT;
  float* bon;
  int* cnt;
  int* list;
  float* gatew;
  bfr *ACC, *GATES, *HF, *HB, *YS, *WmguT, *WmdT, *ACC2;
  bfr *Gb, *g2T;
};

DEVINL float bf2f(bfr v) { return __uint_as_float(((unsigned)v) << 16); }
DEVINL bfr f2bf(float f) { return __builtin_bit_cast(bfr, (__bf16)f); }
DEVINL unsigned pack2(float a, float b) { f32x2 v = {a, b}; return __builtin_bit_cast(unsigned, __builtin_convertvector(v, bf16x2v)); }
DEVINL float sigm(float x) { return __builtin_amdgcn_rcpf(1.f + __expf(-x)); }
DEVINL float silu(float x) { return x * __builtin_amdgcn_rcpf(1.f + __expf(-x)); }
DEVINL float softplus(float x) { return fmaxf(x, 0.f) + __logf(1.f + __expf(-fabsf(x))); }
DEVINL float dpp_sum16(float v) {
  v += __int_as_float(__builtin_amdgcn_update_dpp(0, __float_as_int(v), 0xB1, 0xF, 0xF, true));
  v += __int_as_float(__builtin_amdgcn_update_dpp(0, __float_as_int(v), 0x4E, 0xF, 0xF, true));
  v += __int_as_float(__builtin_amdgcn_update_dpp(0, __float_as_int(v), 0x141, 0xF, 0xF, true));
  v += __int_as_float(__builtin_amdgcn_update_dpp(0, __float_as_int(v), 0x140, 0xF, 0xF, true));
  return v;
}
DEVINL float dpp_sum8(float v) {
  v += __int_as_float(__builtin_amdgcn_update_dpp(0, __float_as_int(v), 0xB1, 0xF, 0xF, true));
  v += __int_as_float(__builtin_amdgcn_update_dpp(0, __float_as_int(v), 0x4E, 0xF, 0xF, true));
  v += __int_as_float(__builtin_amdgcn_update_dpp(0, __float_as_int(v), 0x141, 0xF, 0xF, true));
  return v;
}
DEVINL float wave_sum(float v) { v = dpp_sum16(v); v += __shfl_xor(v, 16); v += __shfl_xor(v, 32); return v; }
template <int W> DEVINL float group_sum(float v) {
#pragma unroll
  for (int o = W / 2; o > 0; o >>= 1) v += __shfl_xor(v, o);
  return v;
}

#define XB_TMO      128
#define XB_XCNT(j)  (256  + 64 * (j))
#define XB_XSUB(j)  (1280 + 64 * (j))
#define XB_XGEN(j)  (2304 + 64 * (j))
#define XB_TOP      3328
#define XB_TOPGEN   3392
#define XCD_BAR_WORDS 3456
#define XB_SPIN_CAP (1u << 18)

DEVINL unsigned xb_ld(unsigned* p)              { return __hip_atomic_load(p, __ATOMIC_RELAXED, __HIP_MEMORY_SCOPE_AGENT); }
DEVINL unsigned xb_add(unsigned* p, unsigned v) { return __hip_atomic_fetch_add(p, v, __ATOMIC_RELAXED, __HIP_MEMORY_SCOPE_AGENT); }
DEVINL unsigned xb_xcc_id() { return (unsigned)__builtin_amdgcn_s_getreg((3 << 11) | 20) & 0xFu; }
#define XB_SPIN(cond, bar) do { unsigned _sp = 0; while (cond) { __builtin_amdgcn_s_sleep(1); \
    if ((++_sp & 255u) == 0u) { if (xb_ld(&(bar)[XB_TMO])) break; if (_sp > XB_SPIN_CAP) { atomicAdd(&(bar)[XB_TMO], 1u); break; } } } } while (0)

struct XcdBarrier { unsigned* bar; unsigned x; volatile LAS unsigned* st; };

DEVINL XcdBarrier xcd_barrier_post(unsigned* bar, volatile LAS unsigned* st) {
    XcdBarrier b; b.bar = bar; b.x = xb_xcc_id(); b.st = st;
    if (threadIdx.x == 0) (void)xb_add(&bar[XB_XCNT(b.x)], 1u);
    return b;
}
DEVINL void xcd_barrier_complete(unsigned* bar, unsigned x, unsigned& nloc, unsigned& nx) {
    const unsigned G = gridDim.x * gridDim.y * gridDim.z;
    unsigned sum, cnt, mine, sp = 0u;
    for (;;) {
        sum = 0u; cnt = 0u; mine = 0u;
#pragma unroll
        for (unsigned j = 0; j < 16; ++j) { const unsigned c = xb_ld(&bar[XB_XCNT(j)]); sum += c; cnt += (c > 0u) ? 1u : 0u; mine = (j == x) ? c : mine; }
        if (sum == G) break;
        __builtin_amdgcn_s_sleep(1);
        if ((++sp & 255u) == 0u) { if (xb_ld(&bar[XB_TMO])) break; if (sp > XB_SPIN_CAP) { atomicAdd(&bar[XB_TMO], 1u); break; } }
    }
    nloc = mine > 0u ? mine : 1u; nx = cnt > 0u ? cnt : 1u;
}
DEVINL void xcd_barrier(const XcdBarrier& b) {
    asm volatile("s_waitcnt vmcnt(0)" ::: "memory");
    __syncthreads();
    if (threadIdx.x == 0) {
        unsigned* bar = b.bar;
        __builtin_amdgcn_s_waitcnt(0);
        unsigned nloc = b.st[0], nx = b.st[1];
        if (nloc == 0u) { xcd_barrier_complete(bar, b.x, nloc, nx); b.st[0] = nloc; b.st[1] = nx; }
        const unsigned old = xb_add(&bar[XB_XSUB(b.x)], 1u);
        const unsigned gen = old / nloc;
        if (old + 1u == (gen + 1u) * nloc) {
            __builtin_amdgcn_fence(__ATOMIC_RELEASE, "agent");
            asm volatile("s_waitcnt vmcnt(0)" ::: "memory");
            const unsigned og = xb_add(&bar[XB_TOP], 1u);
            const unsigned tg = og / nx;
            if (og + 1u == (tg + 1u) * nx) xb_add(&bar[XB_TOPGEN], 1u);
            else XB_SPIN(xb_ld(&bar[XB_TOPGEN]) == tg, bar);
            __builtin_amdgcn_fence(__ATOMIC_ACQUIRE, "agent");
            xb_add(&bar[XB_XGEN(b.x)], 1u);
            asm volatile("s_waitcnt vmcnt(0)" ::: "memory");
        } else {
            XB_SPIN(xb_ld(&bar[XB_XGEN(b.x)]) == gen, bar);
            __builtin_amdgcn_fence(__ATOMIC_ACQUIRE, "agent");
            asm volatile("s_waitcnt vmcnt(0)" ::: "memory");
        }
    }
    __syncthreads();
}

namespace g8 {
constexpr int BM = 256, BK = 64, HALF = 128, HTB = HALF * BK * 2, NXCD = 8, WGM = 8;
DEVINL int lds_byte(int r, int c) { const int st = (r >> 4) * 2 + (c >> 5), rr = r & 15, cc = c & 31, ob = rr * 64 + cc * 2; return st * 1024 + (ob ^ (((ob >> 9) & 1) << 5)); }
DEVINL void stage_rc(int b, int& R, int& C) { const int st = b / 1024, sb = b % 1024, swz = sb ^ (((sb >> 9) & 1) << 5); R = (st >> 1) * 16 + swz / 64; C = (st & 1) * 32 + (swz % 64) / 2; }
DEVINL int perm32(int rho) { const int n = rho >> 4, i = rho & 15; return 8 * (i >> 2) + 4 * n + (i & 3); }
struct Unit { int pm, pn, e; };
typedef f32x4 Acc[2][2][4][2];

struct TileSched {
  int nM, nN, nwg, G, c;
  DEVINL void init(int nM_, int nN_) { nM = nM_; nN = nN_; nwg = nM * nN; G = gridDim.x; c = blockIdx.x; }
  DEVINL bool next(int i, Unit& u) const {
    const long L = (long)i * G + c; if (L >= nwg) return false;
    int wgid = (int)L; { const int q = nwg / NXCD, r = nwg % NXCD, xcd = wgid % NXCD, off = wgid / NXCD; wgid = (xcd < r ? xcd * (q + 1) : r * (q + 1) + (xcd - r) * q) + off; }
    const int nig = WGM * nN, gid = wgid / nig, fm = gid * WGM, gsz = (nM - fm) < WGM ? (nM - fm) : WGM;
    u.pm = fm + ((wgid % nig) % gsz); u.pn = (wgid % nig) / gsz; u.e = 0; return true;
  }
};
struct MergeSched {
  int nM, G, c;
  DEVINL void init(int nM_) { nM = nM_; G = gridDim.x; c = blockIdx.x; }
  DEVINL bool next(int i, Unit& u) const {
    const int hi = i >> 2;
    if (hi && (nM <= 64 || c >= 32 || i >= 6)) return false;
    const int tile = hi ? (c >> 1) : c, x = tile & 7, idx = tile >> 3;
    u.pm = hi ? 64 + (x >> 1) : x * 8 + (idx >> 2); u.pn = hi ? (x & 1) * 2 + idx : (idx & 3); u.e = hi ? (c & 1) * 2 + (i & 1) : i; return true;
  }
};
struct MoeSched {
  const int* cnt; int npn, G, c, skip;
  DEVINL bool next(int i, Unit& u) const {
    int g = i * G + c - skip; if (g < 0) return false;
    g = (g & ~127) | ((g & 7) << 4) | ((g >> 3) & 15);
    int base = 0;
#pragma unroll 1
    for (int e = 0; e < 16; ++e) { const int n = ((cnt[e] + 255) >> 8) * npn; if (g < base + n) { const int r = g - base; u.e = e; u.pm = r / npn; u.pn = r % npn; return true; } base += n; }
    return false;
  }
};
struct RowAddr {
  int ld; int sel; unsigned estride;
  DEVINL unsigned operator()(const Unit& u, int r) const { return (unsigned)(((sel ? u.pn : u.pm) * 256 + r) * ld) * 2u + (unsigned)u.e * estride; }
};
struct GatherAddr {
  const int* list; const int* cnt; int rowbytes; int shift;
  DEVINL unsigned operator()(const Unit& u, int r) const {
    const int ce = cnt[u.e]; int ei = u.pm * 256 + r; ei = ei < ce ? ei : ce - 1;
    return (unsigned)(list[(size_t)u.e * T + ei] >> shift) * (unsigned)rowbytes;
  }
};

template <class Epi, class Sched, class AA, class AB>
DEVINL void gemm8(LAS unsigned char* lds, const char* Abase, const char* Bbase, int K, const Sched& S, const Epi& E, const AA& aA, const AB& aB) {
  const int tid = threadIdx.x, wid = __builtin_amdgcn_readfirstlane(tid >> 6), lane = tid & 63, wr = wid >> 2, wc = wid & 3, fr = lane & 15, fq = lane >> 4;
  const int nt = K / BK;
  int Rr[2], Cc[2], Rb[2];
#pragma unroll
  for (int i = 0; i < 2; ++i) { stage_rc(tid * 16 + i * 8192, Rr[i], Cc[i]); Rb[i] = Epi::PERM ? ((Rr[i] & ~31) + perm32(Rr[i] & 31)) : Rr[i]; }
  const unsigned ldsw = (unsigned)wid * 1024u;
  const int aoff = lds_byte(wr * 64 + fr, fq * 8), boff = lds_byte(wc * 32 + fr, fq * 8);
#define G8_SA(b, h) (((b) * 2 + (h)) * HTB)
#define G8_SB(b, h) ((4 + (b) * 2 + (h)) * HTB)
#define G8_STAGE(bufoff, base, kb, o) do { \
    __builtin_amdgcn_global_load_lds((const unsigned*)((base) + (o)[0] + (kb)), (LAS unsigned*)(lds + (bufoff) + ldsw), 16, 0, 0); \
    __builtin_amdgcn_global_load_lds((const unsigned*)((base) + (o)[1] + (kb)), (LAS unsigned*)(lds + (bufoff) + ldsw + 8192), 16, 0, 0); } while (0)
#define G8_LDA(dst, b, h) do { _Pragma("unroll") for (int m = 0; m < 4; ++m) _Pragma("unroll") for (int k = 0; k < 2; ++k) dst[m][k] = *(const LAS bf16x8*)(lds + G8_SA(b, h) + aoff + m * 2048 + k * 1024); } while (0)
#define G8_LDB(dst, b, h) do { _Pragma("unroll") for (int n = 0; n < 2; ++n) _Pragma("unroll") for (int k = 0; k < 2; ++k) dst[n][k] = *(const LAS bf16x8*)(lds + G8_SB(b, h) + boff + n * 2048 + k * 1024); } while (0)
#define G8_MMA(ai, bj, At, Bt) do { __builtin_amdgcn_s_setprio(1); _Pragma("unroll") for (int m = 0; m < 4; ++m) _Pragma("unroll") for (int n = 0; n < 2; ++n) _Pragma("unroll") for (int k = 0; k < 2; ++k) \
    acc[ai][bj][m][n] = __builtin_amdgcn_mfma_f32_16x16x32_bf16(Bt[n][k], At[m][k], acc[ai][bj][m][n], 0, 0, 0); __builtin_amdgcn_s_setprio(0); } while (0)
#define G8_WAIT_V(n) asm volatile("s_waitcnt vmcnt(" #n ")" ::: "memory")
#define G8_WAIT_L(n) asm volatile("s_waitcnt lgkmcnt(" #n ")" ::: "memory")
#define G8_BAR __builtin_amdgcn_s_barrier()
#define G8_SCHED __builtin_amdgcn_sched_barrier(0)
  Unit cur, nxt; int ui = 0;
  if (!S.next(0, cur)) return;
  Acc acc;
#pragma unroll
  for (int a = 0; a < 2; ++a)
#pragma unroll
    for (int b = 0; b < 2; ++b)
#pragma unroll
      for (int m = 0; m < 4; ++m)
#pragma unroll
        for (int n = 0; n < 2; ++n) acc[a][b][m][n] = f32x4{0.f, 0.f, 0.f, 0.f};
  bf16x8 At[4][2], B0[2][2], B1[2][2];
  unsigned oAc[2][2], oBc[2][2], oAn[2][2], oBn[2][2];
#pragma unroll
  for (int h = 0; h < 2; ++h)
#pragma unroll
    for (int i = 0; i < 2; ++i) { oAc[h][i] = aA(cur, h * 128 + Rr[i]) + Cc[i] * 2; oBc[h][i] = aB(cur, h * 128 + Rb[i]) + Cc[i] * 2; oAn[h][i] = oAc[h][i]; oBn[h][i] = oBc[h][i]; }
  G8_STAGE(G8_SB(0, 0), Bbase, 0, oBc[0]); G8_STAGE(G8_SA(0, 0), Abase, 0, oAc[0]); G8_STAGE(G8_SB(0, 1), Bbase, 0, oBc[1]); G8_STAGE(G8_SA(0, 1), Abase, 0, oAc[1]);
  if (wr == 1) G8_BAR;
  G8_WAIT_V(4); G8_BAR;
  G8_STAGE(G8_SB(1, 0), Bbase, 128, oBc[0]); G8_STAGE(G8_SA(1, 0), Abase, 128, oAc[0]); G8_STAGE(G8_SB(1, 1), Bbase, 128, oBc[1]);
  G8_WAIT_V(6); G8_BAR;
  for (;;) {
    const bool has_next = S.next(ui + 1, nxt);
    if (has_next) {
#pragma unroll
      for (int h = 0; h < 2; ++h)
#pragma unroll
        for (int i = 0; i < 2; ++i) { oAn[h][i] = aA(nxt, h * 128 + Rr[i]) + Cc[i] * 2; oBn[h][i] = aB(nxt, h * 128 + Rb[i]) + Cc[i] * 2; }
    } else {
#pragma unroll
      for (int h = 0; h < 2; ++h)
#pragma unroll
        for (int i = 0; i < 2; ++i) { oAn[h][i] = oAc[h][i]; oBn[h][i] = oBc[h][i]; }
    }
    for (int t = 0; t < nt; t += 2) {
      const bool last = (t == nt - 2);
      const int k1 = (t + 1) * 128, k2 = last ? 0 : (t + 2) * 128, k3 = k2 + 128;
      unsigned a2[2][2], b2[2][2];
#pragma unroll
      for (int h = 0; h < 2; ++h)
#pragma unroll
        for (int i = 0; i < 2; ++i) { a2[h][i] = last ? oAn[h][i] : oAc[h][i]; b2[h][i] = last ? oBn[h][i] : oBc[h][i]; }
      G8_LDB(B0, 0, 0); G8_SCHED; G8_LDA(At, 0, 0); G8_STAGE(G8_SA(1, 1), Abase, k1, oAc[1]);
      G8_WAIT_L(8); G8_BAR; G8_WAIT_L(0); G8_MMA(0, 0, At, B0); G8_BAR; G8_SCHED;
      G8_LDB(B1, 0, 1); G8_STAGE(G8_SB(0, 0), Bbase, k2, b2[0]);
      G8_BAR; G8_WAIT_L(0); G8_MMA(0, 1, At, B1); G8_BAR;
      G8_LDA(At, 0, 1); G8_STAGE(G8_SA(0, 0), Abase, k2, a2[0]);
      G8_BAR; G8_WAIT_L(0); G8_MMA(1, 0, At, B0); G8_BAR; G8_SCHED;
      G8_STAGE(G8_SB(0, 1), Bbase, k2, b2[1]);
      G8_WAIT_V(6); G8_BAR; G8_MMA(1, 1, At, B1); G8_BAR;
      G8_LDB(B0, 1, 0); G8_SCHED; G8_LDA(At, 1, 0); G8_STAGE(G8_SA(0, 1), Abase, k2, a2[1]);
      G8_WAIT_L(8); G8_BAR; G8_WAIT_L(0); G8_MMA(0, 0, At, B0); G8_BAR; G8_SCHED;
      G8_LDB(B1, 1, 1); G8_STAGE(G8_SB(1, 0), Bbase, k3, b2[0]);
      G8_BAR; G8_WAIT_L(0); G8_MMA(0, 1, At, B1); G8_BAR;
      G8_LDA(At, 1, 1); G8_STAGE(G8_SA(1, 0), Abase, k3, a2[0]);
      G8_BAR; G8_WAIT_L(0); G8_MMA(1, 0, At, B0); G8_BAR; G8_SCHED;
      G8_STAGE(G8_SB(1, 1), Bbase, k3, b2[1]);
      G8_WAIT_V(6); G8_BAR; G8_MMA(1, 1, At, B1); G8_BAR;
    }
    E(acc, cur, wr, wc, fr, fq);
    if (!has_next) break;
#pragma unroll
    for (int a = 0; a < 2; ++a)
#pragma unroll
      for (int b = 0; b < 2; ++b)
#pragma unroll
        for (int m = 0; m < 4; ++m)
#pragma unroll
          for (int n = 0; n < 2; ++n) acc[a][b][m][n] = f32x4{0.f, 0.f, 0.f, 0.f};
    cur = nxt; ++ui;
#pragma unroll
    for (int h = 0; h < 2; ++h)
#pragma unroll
      for (int i = 0; i < 2; ++i) { oAc[h][i] = oAn[h][i]; oBc[h][i] = oBn[h][i]; }
  }
  G8_WAIT_V(0);
  if (wr == 0) G8_BAR;
  G8_BAR;
#undef G8_SA
#undef G8_SB
#undef G8_STAGE
#undef G8_LDA
#undef G8_LDB
#undef G8_MMA
#undef G8_WAIT_V
#undef G8_WAIT_L
#undef G8_BAR
#undef G8_SCHED
}
}

#define CONV_ARGS(x) const float* x##src, bfr* x##dst, int x##N, int x##Kd, int x##kt, int x##nt, int x##drow0
#define CONV_REFS(x) const float*& x##src, bfr*& x##dst, int& x##N, int& x##Kd, int& x##kt, int& x##nt, int& x##drow0
#define CONV_PASS(x) x##src, x##dst, x##N, x##Kd, x##kt, x##nt, x##drow0
DEVINL void conv_load(CONV_ARGS(d_), f32x4& v0, f32x4& v1) {
  const int tid = threadIdx.x, r = tid >> 4, c4 = (tid & 15) * 4;
  (void)d_dst; (void)d_Kd; (void)d_drow0;
  if (d_src) {
    const float* s = d_src + (size_t)(d_kt * 64 + r) * d_N + d_nt * 64 + c4;
    v0 = *(const f32x4*)s; v1 = *(const f32x4*)(s + (size_t)32 * d_N);
  } else { v0 = f32x4{0.f, 0.f, 0.f, 0.f}; v1 = v0; }
}
DEVINL void conv_store(CONV_ARGS(d_), const f32x4& v0, const f32x4& v1, char* sm) {
  float* tile = (float*)sm;
  const int tid = threadIdx.x, r = tid >> 4, c4 = (tid & 15) * 4;
  (void)d_src; (void)d_N; (void)d_nt;
  __syncthreads();
  tile[r * 65 + c4] = v0[0]; tile[r * 65 + c4 + 1] = v0[1]; tile[r * 65 + c4 + 2] = v0[2]; tile[r * 65 + c4 + 3] = v0[3];
  tile[(r + 32) * 65 + c4] = v1[0]; tile[(r + 32) * 65 + c4 + 1] = v1[1]; tile[(r + 32) * 65 + c4 + 2] = v1[2]; tile[(r + 32) * 65 + c4 + 3] = v1[3];
  __syncthreads();
  const int n = tid >> 3, k8 = (tid & 7) * 8;
  float y[8];
#pragma unroll
  for (int j = 0; j < 8; ++j) y[j] = tile[(k8 + j) * 65 + n];
  *(uint4*)(d_dst + (size_t)(d_drow0 + n) * d_Kd + d_kt * 64 + k8) = make_uint4(pack2(y[0], y[1]), pack2(y[2], y[3]), pack2(y[4], y[5]), pack2(y[6], y[7]));
}
constexpr int CONV_L_ITEMS = 1712 + 16 + 1024 + 512 + 256;
DEVINL void conv_layer_desc(const Params& p, int l, int it, CONV_REFS(d_)) {
  if (it < 1712) { d_src = p.w_in + (size_t)l * D * NIN; d_dst = p.WinT; d_N = NIN; d_Kd = D; d_kt = it / 107; d_nt = it % 107; }
  else if (it < 1728) { d_src = nullptr; d_dst = p.WinT; d_N = 0; d_Kd = D; d_kt = it - 1712; d_nt = 107; }
  else if (it < 2752) { const int g = (it - 1728) >> 8, r = (it - 1728) & 255; d_src = p.w_gate + ((size_t)l * 4 + g) * D * D; d_dst = p.WgT + (size_t)g * D * D; d_N = D; d_Kd = D; d_kt = r >> 4; d_nt = r & 15; }
  else if (it < 3264) { const int g = (it - 2752) >> 7, r = (it - 2752) & 127; d_src = p.w_branch + ((size_t)l * 4 + g) * 512 * D; d_dst = p.WbT + (size_t)g * D * 512; d_N = D; d_Kd = 512; d_kt = r >> 4; d_nt = r & 15; }
  else { const int r = it - 3264; d_src = p.w_out + (size_t)l * D * D; d_dst = p.WoT; d_N = D; d_Kd = D; d_kt = r >> 4; d_nt = r & 15; }
  d_drow0 = d_nt * 64;
}
constexpr int CONV_M_ITEMS = 6144;
DEVINL void conv_moe_desc(const Params& p, int l, int it, CONV_REFS(d_)) {
  const int which = it / 2048, r = it % 2048, e = r >> 7, tt = r & 127;
  const size_t eo = ((size_t)l * 16 + e) * (size_t)D * 512;
  if (which < 2) { d_src = (which ? p.moe_w_up : p.moe_w_gate) + eo; d_dst = p.WmguT + (size_t)e * D * D; d_N = 512; d_Kd = D; d_kt = tt >> 3; d_nt = tt & 7; d_drow0 = ((tt & 7) >> 1) * 256 + which * 128 + ((tt & 7) & 1) * 64; }
  else { d_src = p.moe_w_down + eo; d_dst = p.WmdT + (size_t)e * D * 512; d_N = D; d_Kd = 512; d_kt = tt >> 4; d_nt = tt & 15; d_drow0 = (tt & 15) * 64; }
}
template <bool MOE>
DEVINL void convert_range(const Params& p, int l, int start, int end, int stride, char* sm) {
  if (start >= end) return;
  const float* c_src; bfr* c_dst; int c_N, c_Kd, c_kt, c_nt, c_drow0;
  if (MOE) conv_moe_desc(p, l, start, CONV_PASS(c_)); else conv_layer_desc(p, l, start, CONV_PASS(c_));
  f32x4 v0, v1; conv_load(CONV_PASS(c_), v0, v1);
#pragma unroll 1
  for (int it = start; it < end; it += stride) {
    const int itn = (it + stride < end) ? it + stride : it;
    const float* n_src; bfr* n_dst; int n_N, n_Kd, n_kt, n_nt, n_drow0;
    if (MOE) conv_moe_desc(p, l, itn, CONV_PASS(n_)); else conv_layer_desc(p, l, itn, CONV_PASS(n_));
    f32x4 n0, n1; conv_load(CONV_PASS(n_), n0, n1);
    conv_store(CONV_PASS(c_), v0, v1, sm);
    c_src = n_src; c_dst = n_dst; c_N = n_N; c_Kd = n_Kd; c_kt = n_kt; c_nt = n_nt; c_drow0 = n_drow0; v0 = n0; v1 = n1;
  }
}
#undef CONV_ARGS
#undef CONV_REFS
#undef CONV_PASS

DEVINL void adaln_item(const Params& p, int it, char* sm) {
  const int l = it / 96, jb = it % 96, tid = threadIdx.x, c = tid & 63, ks = tid >> 6;
  float* sc = (float*)sm;
  float* red = sc + 5 * 1024;
  __syncthreads();
  for (int i = tid; i < 5 * 1024; i += NTHR) { const int v = i >> 10, k = i & 1023; const float cv = v < 4 ? p.c[v * 1024 + k] : p.c_ctx[k]; sc[i] = silu(cv); }
  __syncthreads();
  const int j = jb * 64 + c;
  float a[5] = {0.f, 0.f, 0.f, 0.f, 0.f};
  const float* w = p.ada_w + (size_t)l * D * 6144 + j;
#pragma unroll 16
  for (int k = ks * 128; k < ks * 128 + 128; ++k) {
    const float wv = w[(size_t)k * 6144];
#pragma unroll
    for (int v = 0; v < 5; ++v) a[v] += sc[v * 1024 + k] * wv;
  }
#pragma unroll
  for (int v = 0; v < 5; ++v) red[(ks * 5 + v) * 64 + c] = a[v];
  __syncthreads();
  if (tid < 320) {
    const int v = tid >> 6;
    float sum = 0.f;
#pragma unroll
    for (int q = 0; q < 8; ++q) sum += red[(q * 5 + v) * 64 + c];
    p.mod[((size_t)l * 5 + v) * 6144 + j] = sum + p.ada_b[l * 6144 + j];
  }
}
DEVINL void phase_prologue(const Params& p, char* sm) {
  if (blockIdx.x < 192) adaln_item(p, blockIdx.x, sm);
  convert_range<false>(p, 0, blockIdx.x, 1728, gridDim.x, sm);
}

DEVINL int canon_row(int L, int R) {
  if (L & 1) { const int b = R >> 12, s = R & 4095; return (b << 12) | ((s & 63) << 6) | (s >> 6); }
  return R;
}
template <int L>
DEVINL void phase_norm1(const Params& p) {
  const int lane = threadIdx.x & 63, wave = threadIdx.x >> 6;
  for (int R = blockIdx.x * 8 + wave; R < T; R += gridDim.x * 8) {
    const bool lat = R < TL;
    const int cr = lat ? canon_row(L, R) : R;
    const int vv = lat ? (R >> 12) : 4;
    float* xp = lat ? p.out + (size_t)cr * D : p.xc + (size_t)(R - TL) * D;
    const float* src = lat ? p.x + (size_t)cr * D : p.ctx + (size_t)(R - TL) * D;
    float4 xq[4]; uint2 y0q[4], y1q[4]; float4 m5q[4];
#pragma unroll
    for (int q = 0; q < 4; ++q) {
      const int j = q * 256 + lane * 4;
      if (L == 0) xq[q] = *(const float4*)(src + j);
      else {
        xq[q] = *(const float4*)(xp + j);
        m5q[q] = *(const float4*)(p.mod + ((size_t)(L - 1) * 5 + vv) * 6144 + 5 * 1024 + j);
        y0q[q] = *(const uint2*)(p.YS + (size_t)cr * D + j); y1q[q] = *(const uint2*)(p.YS + (size_t)T * D + (size_t)cr * D + j);
      }
    }
    float v[16]; float ss = 0.f;
#pragma unroll
    for (int q = 0; q < 4; ++q) {
      const int j = q * 256 + lane * 4;
      float4 xv = xq[q];
      if (L != 0) {
        const float4 m5 = m5q[q]; const uint2 y0 = y0q[q], y1 = y1q[q];
        xv.x += m5.x * (bf2f(y0.x & 0xFFFF) + bf2f(y1.x & 0xFFFF)); xv.y += m5.y * (bf2f(y0.x >> 16) + bf2f(y1.x >> 16));
        xv.z += m5.z * (bf2f(y0.y & 0xFFFF) + bf2f(y1.y & 0xFFFF)); xv.w += m5.w * (bf2f(y0.y >> 16) + bf2f(y1.y >> 16));
      }
      *(float4*)(xp + j) = xv;
      v[q * 4] = xv.x; v[q * 4 + 1] = xv.y; v[q * 4 + 2] = xv.z; v[q * 4 + 3] = xv.w;
      ss += xv.x * xv.x + xv.y * xv.y + xv.z * xv.z + xv.w * xv.w;
    }
    ss = wave_sum(ss);
    const float rs = rsqrtf(ss * (1.f / 1024.f) + EPS);
    const float* md = p.mod + ((size_t)L * 5 + vv) * 6144;
    float4 nwq[4], shq[4], sclq[4];
#pragma unroll
    for (int q = 0; q < 4; ++q) { const int j = q * 256 + lane * 4; nwq[q] = *(const float4*)(p.norm_mix + L * D + j); shq[q] = *(const float4*)(md + j); sclq[q] = *(const float4*)(md + 1024 + j); }
#pragma unroll
    for (int q = 0; q < 4; ++q) {
      const int j = q * 256 + lane * 4;
      const float4 nw = nwq[q], sh = shq[q], scl = sclq[q];
      const float h0 = v[q * 4] * rs * nw.x * (1.f + scl.x) + sh.x, h1 = v[q * 4 + 1] * rs * nw.y * (1.f + scl.y) + sh.y;
      const float h2 = v[q * 4 + 2] * rs * nw.z * (1.f + scl.z) + sh.z, h3 = v[q * 4 + 3] * rs * nw.w * (1.f + scl.w) + sh.w;
      *(uint2*)(p.O + (size_t)R * OLD + 2048 + j) = make_uint2(pack2(h0, h1), pack2(h2, h3));
    }
  }
}

DEVINL void chunk_of_step(int step, int b, int d, int& rb, int& len, int& c) {
  const int seg = step >= 4, cc = seg ? step - 4 : step, nch = seg ? 64 : 4;
  c = d ? nch - 1 - cc : cc; len = seg ? SEQ : CTXL; rb = seg ? b * SEQ : TL + b * CTXL;
}
template <int KS>
DEVINL f32x4 mma16(const bfr* A, int lda, const bfr* Bt, int ldb, f32x4 acc) {
  const int lane = threadIdx.x & 63;
  const bfr* ap = A + (lane & 15) * lda + (lane >> 4) * 8;
  const bfr* bp = Bt + (lane & 15) * ldb + (lane >> 4) * 8;
#pragma unroll
  for (int ks = 0; ks < KS; ++ks) acc = __builtin_amdgcn_mfma_f32_16x16x32_bf16(*(const bf16x8*)(ap + 32 * ks), *(const bf16x8*)(bp + 32 * ks), acc, 0, 0, 0);
  return acc;
}
DEVINL void unpack8(const uint4 v, float (&o)[8]) {
  o[0] = __uint_as_float(v.x << 16); o[1] = __uint_as_float(v.x & 0xFFFF0000u); o[2] = __uint_as_float(v.y << 16); o[3] = __uint_as_float(v.y & 0xFFFF0000u);
  o[4] = __uint_as_float(v.z << 16); o[5] = __uint_as_float(v.z & 0xFFFF0000u); o[6] = __uint_as_float(v.w << 16); o[7] = __uint_as_float(v.w & 0xFFFF0000u);
}
DEVINL void unpack4(const uint2 v, float (&o)[4]) {
  o[0] = __uint_as_float(v.x << 16); o[1] = __uint_as_float(v.x & 0xFFFF0000u); o[2] = __uint_as_float(v.y << 16); o[3] = __uint_as_float(v.y & 0xFFFF0000u);
}


template <int W8>
DEVINL void prep_item(const Params& p, int b, int col0, const float* t0g, const float* t1g, const float* t2g, const float* bg, bool shiftmode, int act, bool norm, float nscale, char* sm) {
  constexpr int W = W8 * 8, RS = 256, NV = (RS + 1) * W8, NPF = (NV + NTHR - 1) / NTHR, G = W8 / 8;
  const int tid = threadIdx.x;
  bfr* RAWP = (bfr*)sm;
  float* PT = (float*)(RAWP + (RS + 2) * W);
  __syncthreads();
  for (int c = tid; c < W; c += NTHR) {
    if (shiftmode) { const float mu = t0g[c]; PT[c] = 0.5f * mu; PT[W + c] = 1.f - mu; PT[2 * W + c] = 0.5f * mu; PT[3 * W + c] = 0.f; }
    else { PT[c] = t0g[c]; PT[W + c] = t1g[c]; PT[2 * W + c] = t2g[c]; PT[3 * W + c] = bg ? bg[c] : 0.f; }
  }
  uint4 pf[NPF];
  auto prefetch = [&](int step) {
    const int seg = step >= 1, cc = seg ? step - 1 : 0, len = seg ? SEQ : CTXL, rb = seg ? b * SEQ : TL + b * CTXL;
#pragma unroll
    for (int q = 0; q < NPF; ++q) {
      const int idx = tid + NTHR * q;
      uint4 v = make_uint4(0, 0, 0, 0);
      if (idx < NV) { const int r = idx / W8, g = idx % W8, t = cc * RS + r; if (t < len) v = *(const uint4*)(p.P + (size_t)(rb + t) * NINP + col0 + g * 8); }
      pf[q] = v;
    }
  };
  prefetch(0);
#pragma unroll 1
  for (int step = 0; step < 17; ++step) {
    const int seg = step >= 1, cc = seg ? step - 1 : 0, rb = seg ? b * SEQ : TL + b * CTXL;
    __syncthreads();
    if (tid < W8) *(uint4*)(RAWP + tid * 8) = (cc == 0) ? make_uint4(0, 0, 0, 0) : *(const uint4*)(RAWP + RS * W + tid * 8);
    __syncthreads();
#pragma unroll
    for (int q = 0; q < NPF; ++q) { const int idx = tid + NTHR * q; if (idx < NV) *(uint4*)(RAWP + (1 + idx / W8) * W + (idx % W8) * 8) = pf[q]; }
    __syncthreads();
    if (step + 1 < 17) prefetch(step + 1);
#pragma unroll 1
    for (int rep = 0; rep < 4; ++rep) {
      const int i = rep * 64 + (tid >> 3);
      float ssq = 0.f; float y[G][8];
#pragma unroll
      for (int gq = 0; gq < G; ++gq) {
        const int cbase = ((tid & 7) * G + gq) * 8;
        float x0[8], x1[8], x2[8];
        unpack8(*(const uint4*)(RAWP + i * W + cbase), x0); unpack8(*(const uint4*)(RAWP + (i + 1) * W + cbase), x1); unpack8(*(const uint4*)(RAWP + (i + 2) * W + cbase), x2);
#pragma unroll
        for (int e = 0; e < 8; ++e) {
          float v = PT[cbase + e] * x0[e] + PT[W + cbase + e] * x1[e] + PT[2 * W + cbase + e] * x2[e] + PT[3 * W + cbase + e];
          if (act == 1) v = silu(v); else if (act == 2) v = 1.f - 2.f * __builtin_amdgcn_rcpf(1.f + __expf(2.f * v)); else if (act == 3) v = sigm(v);
          y[gq][e] = v; ssq += v * v;
        }
      }
      float sc = 1.f;
      if (norm) { ssq = dpp_sum8(ssq); sc = __builtin_amdgcn_rsqf(ssq + EPS) * nscale; }
#pragma unroll
      for (int gq = 0; gq < G; ++gq) {
        const int cbase = ((tid & 7) * G + gq) * 8;
        *(uint4*)(p.P + (size_t)(rb + cc * RS + i) * NINP + col0 + cbase) =
            make_uint4(pack2(y[gq][0] * sc, y[gq][1] * sc), pack2(y[gq][2] * sc, y[gq][3] * sc), pack2(y[gq][4] * sc, y[gq][5] * sc), pack2(y[gq][6] * sc, y[gq][7] * sc));
      }
    }
  }
}
template <int L>
DEVINL void phase_prep(const Params& p, char* sm) {
  const int it = blockIdx.x;
  if (it >= 232) {
    for (int idx = (it - 232) * NTHR + threadIdx.x; idx < 512 * 256; idx += 24 * NTHR) { const int c = idx >> 8, k = idx & 255; p.g2T[idx] = k < 128 ? f2bf(p.rwkv_g2[((size_t)L * 128 + k) * 512 + c]) : (bfr)0; }
    return;
  }
  if (it < 32) {
    const int b = it >> 3, r = it & 7, isk = r >> 2, h = r & 3, ch = isk * 512 + h * 128;
    const float* cw = p.gdn_conv_w + (size_t)L * 3 * 1536 + ch;
    prep_item<16>(p, b, C_GDN + ch, cw, cw + 1536, cw + 3072, nullptr, false, 1, true, isk ? 1.f : 0.08838834764831845f, sm);
    return;
  }
  const int j = it - 32, b = j / 50, r = j % 50;
  if (r < 12) {
    const int ch = r * 64; const float* cw = p.ssm_conv_w + (size_t)L * 3 * 768 + ch;
    prep_item<8>(p, b, C_SSM + 512 + ch, cw, cw + 768, cw + 1536, p.ssm_conv_b + L * 768 + ch, false, 1, false, 1.f, sm);
  } else if (r < 20) {
    const int ch = 1024 + (r - 12) * 64; const float* cw = p.gdn_conv_w + (size_t)L * 3 * 1536 + ch;
    prep_item<8>(p, b, C_GDN + ch, cw, cw + 1536, cw + 3072, nullptr, false, 1, false, 1.f, sm);
  } else {
    const int ch = (r - 20) * 64; const float* mu = p.rwkv_mu + L * 1920 + ch;
    const int act = (ch >= 1536 && ch < 1664) ? 2 : (ch >= 1792 ? 3 : 0);
    prep_item<8>(p, b, C_RWKV + ch, mu, mu, mu, nullptr, true, act, false, 1.f, sm);
  }
}

DEVINL int rwkv_colbase(int g, int h, int d) { return g == 0 ? h * 64 : g == 1 ? 512 + h * 64 : g == 2 ? 1024 + h * 64 : g == 3 ? 1536 + d * 64 : 1664 + d * 64; }
DEVINL f32x4 bmm16(const float* A, int lda, const float* B, int ldb, f32x4 acc) {
  const int lane = threadIdx.x & 63;
#pragma unroll
  for (int s2 = 0; s2 < 4; ++s2) {
    const float a = A[(lane & 15) * lda + 4 * s2 + (lane >> 4)], b = B[(4 * s2 + (lane >> 4)) * ldb + (lane & 15)];
    acc = __builtin_amdgcn_mfma_f32_16x16x4f32(a, b, acc, 0, 0, 0);
  }
  asm volatile("" ::: "memory");
  return acc;
}
DEVINL void chunk32_of_step(int step, int b, int d, int& rb, int& c) {
  const int seg = step >= 8, cc = seg ? step - 8 : step, nch = seg ? 128 : 8;
  c = d ? nch - 1 - cc : cc; rb = seg ? b * SEQ : TL + b * CTXL;
}
DEVINL void rwkv3_prefetch(const Params& p, uint4& pfA, uint4& pfB, uint4 (&fw)[2], int step, int b, int d, int h) {
  int rb, c; chunk32_of_step(step, b, d, rb, c);
  const int tid = threadIdx.x, lane = tid & 63, ti = (tid >> 7) & 1, mat = (tid >> 6) & 1;
  const bfr* base = p.P + (size_t)(rb + c * 32) * NINP + C_RWKV;
  { const int r = tid >> 4, g = tid & 15; pfA = *(const uint4*)(base + (size_t)r * NINP + (g < 8 ? rwkv_colbase(0, h, d) + g * 8 : rwkv_colbase(1, h, d) + (g - 8) * 8)); }
  if (tid < 256) { const int r = tid >> 3, g = tid & 7; pfB = *(const uint4*)(base + (size_t)r * NINP + rwkv_colbase(2, h, d) + g * 8); }
  {
    const int i = ti * 16 + (lane & 15), r = d ? 31 - i : i;
    const bfr* rowp = base + (size_t)r * NINP + (lane >> 4) * 8;
    const int cb = mat ? rwkv_colbase(4, h, d) : rwkv_colbase(3, h, d);
    fw[0] = *(const uint4*)(rowp + cb); fw[1] = *(const uint4*)(rowp + cb + 32);
  }
}
template <int L>
DEVINL void scan_rwkv3(const Params& p, int item, char* sm) {
  const int d = item & 1, h = (item >> 1) & 7, b = item >> 4;
  const int tid = threadIdx.x, lane = tid & 63, wave = __builtin_amdgcn_readfirstlane(tid >> 6);
  constexpr int LK = 72, LJ = 40, LFS = 36, NCH = 136;
  bfr* w2T = (bfr*)sm; bfr* a2T = w2T + 64 * LK; bfr* RK = a2T + 64 * LK; bfr* BR = RK + 32 * 128; bfr* KR = BR + 32 * LK;
  float* Gf = (float*)(KR + 32 * LK); float* LWf = Gf + 2048; float* ARf = LWf + 2048;
  bfr* KH = (bfr*)(ARf + 2048); bfr* RH = KH + 32 * LK; bfr* BC = RH + 32 * LK; bfr* KC = BC + 32 * LK;
  bfr* BTt = KC + 32 * LK; bfr* KTt = BTt + 64 * LJ; bfr* VT0 = KTt + 64 * LJ; bfr* VT1 = VT0 + 64 * LJ;
  float* Lf = (float*)(VT1 + 64 * LJ); float* Tf = Lf + 32 * LFS;
  bfr* Tm = (bfr*)(Tf + 32 * LFS); bfr* Aak = Tm + 32 * LJ; bfr* Arb = Aak + 32 * LJ; bfr* Ark = Arb + 32 * LJ;
  bfr* ZT = Ark + 32 * LJ; bfr* UT = ZT + 64 * LJ; bfr* S0b = UT + 64 * LJ; bfr* OST = S0b + 64 * LK; bfr* VR = OST + 32 * LK;
  float* GC0 = (float*)(VR + 32 * LK); float* GC1 = GC0 + 64; float* TMPX = GC1 + 64; float* BONL = TMPX + 256;
  for (int i = tid; i < 4096; i += NTHR) {
    const int r = i >> 6, c = i & 63;
    w2T[c * LK + r] = f2bf(p.rwkv_w2[((size_t)(L * 2 + d) * 64 + r) * 512 + h * 64 + c]);
    a2T[c * LK + r] = f2bf(p.rwkv_a2[((size_t)(L * 2 + d) * 64 + r) * 512 + h * 64 + c]);
  }
  for (int i = tid; i < 64 * LK; i += NTHR) S0b[i] = 0;
  const int c4 = (tid & 15) * 4;
  const float4 a0v = *(const float4*)(p.rwkv_a0 + (L * 2 + d) * 512 + h * 64 + c4);
  const float4 kkv = *(const float4*)(p.rwkv_k_k + L * 512 + h * 64 + c4), kav = *(const float4*)(p.rwkv_k_a + L * 512 + h * 64 + c4), rkv = *(const float4*)(p.rwkv_r_k + L * 512 + h * 64 + c4);
  const int lr_mat = wave & 1, lr_ti = (wave >> 1) & 1, lr_tj = (wave >> 2) * 2;
  const float w0c0 = p.rwkv_w0[(L * 2 + d) * 512 + h * 64 + lr_tj * 16 + (lane & 15)], w0c1 = p.rwkv_w0[(L * 2 + d) * 512 + h * 64 + lr_tj * 16 + 16 + (lane & 15)];
  f32x4 Sm[4];
#pragma unroll
  for (int u = 0; u < 4; ++u) Sm[u] = f32x4{0.f, 0.f, 0.f, 0.f};
  uint4 pfA, pfB = make_uint4(0, 0, 0, 0), fw[2];
  const int tv = wave & 3;
  f32x4 p1[2], p2[2];
#define RW3_STAGE_LOWRANK() do { \
    { const int r_ = tid >> 4, g_ = tid & 15, i_ = d ? 31 - r_ : r_; *(uint4*)(RK + i_ * 128 + g_ * 8) = pfA; } \
    if (tid < 256) { const int r_ = tid >> 3, g_ = tid & 7, i_ = d ? 31 - r_ : r_; *(uint4*)(VR + i_ * LK + g_ * 8) = pfB; } \
    { const bfr* bm_ = (lr_mat ? a2T : w2T) + (lr_tj * 16 + (lane & 15)) * LK + (lane >> 4) * 8; \
      _Pragma("unroll") for (int q_ = 0; q_ < 2; ++q_) { \
        f32x4 cw_ = f32x4{0.f, 0.f, 0.f, 0.f}; \
        _Pragma("unroll") for (int ks_ = 0; ks_ < 2; ++ks_) \
          cw_ = __builtin_amdgcn_mfma_f32_16x16x32_bf16(__builtin_bit_cast(bf16x8, fw[ks_]), *(const bf16x8*)(bm_ + q_ * 16 * LK + 32 * ks_), cw_, 0, 0, 0); \
        _Pragma("unroll") for (int r_ = 0; r_ < 4; ++r_) { const int i_ = lr_ti * 16 + (lane >> 4) * 4 + r_, cc_ = (lr_tj + q_) * 16 + (lane & 15); \
          if (lr_mat) ARf[i_ * 64 + cc_] = cw_[r_]; else LWf[i_ * 64 + cc_] = -0.6065306597f * sigm(cw_[r_] + (q_ ? w0c1 : w0c0)); } } } } while (0)
#define RW3_VT(VTn, tl) do { const int v_ = (tl) & 63, iq_ = ((tl) >> 6) * 8; unsigned w_[4]; \
    _Pragma("unroll") for (int e_ = 0; e_ < 4; ++e_) w_[e_] = (unsigned)VR[(iq_ + 2 * e_) * LK + v_] | ((unsigned)VR[(iq_ + 2 * e_ + 1) * LK + v_] << 16); \
    *(uint4*)((VTn) + v_ * LJ + iq_) = make_uint4(w_[0], w_[1], w_[2], w_[3]); } while (0)
#define RW3_CUMSUM_TILE(GCn, id_) do { const int ti_ = (id_) >> 2, tj_ = (id_) & 3; \
      f32x4 gacc_ = f32x4{0.f, 0.f, 0.f, 0.f}; \
      _Pragma("unroll") for (int kb_ = 0; kb_ < 2; ++kb_) { if (kb_ <= ti_) { \
        _Pragma("unroll") for (int s4_ = 0; s4_ < 4; ++s4_) { const int kk2_ = 4 * s4_ + (lane >> 4); \
          const float av_ = (kb_ < ti_ || kk2_ <= (lane & 15)) ? 1.f : 0.f; const float bv_ = LWf[(kb_ * 16 + kk2_) * 64 + tj_ * 16 + (lane & 15)]; \
          gacc_ = __builtin_amdgcn_mfma_f32_16x16x4f32(av_, bv_, gacc_, 0, 0, 0); } } } \
      _Pragma("unroll") for (int r_ = 0; r_ < 4; ++r_) Gf[(ti_ * 16 + (lane >> 4) * 4 + r_) * 64 + tj_ * 16 + (lane & 15)] = gacc_[r_]; \
      if (ti_ == 1 && (lane >> 4) == 3) (GCn)[tj_ * 16 + (lane & 15)] = gacc_[3]; } while (0)
  rwkv3_prefetch(p, pfA, pfB, fw, 0, b, d, h);
  __syncthreads();
  RW3_STAGE_LOWRANK();
  rwkv3_prefetch(p, pfA, pfB, fw, 1, b, d, h);
  __syncthreads();
  RW3_CUMSUM_TILE(GC0, wave);
  if (wave >= 4) RW3_VT(VT0, tid - 256);
  __syncthreads();
  {
    int rb0, c0; chunk32_of_step(0, b, d, rb0, c0);
#define EW_I (tid >> 4)
#define EW_GC GC0
#define EW_RB rb0
#define EW_C c0
    {
      const int i = EW_I, t = d ? 31 - i : i;
      float rr[4], kk_[4];
      unpack4(*(const uint2*)(RK + i * 128 + c4), rr); unpack4(*(const uint2*)(RK + i * 128 + 64 + c4), kk_);
      const float4 g4 = *(const float4*)&Gf[i * 64 + c4], l4 = *(const float4*)&LWf[i * 64 + c4], ar4 = *(const float4*)&ARf[i * 64 + c4], gc4 = *(const float4*)&EW_GC[c4];
      const float gA[4] = {g4.x, g4.y, g4.z, g4.w}, lA[4] = {l4.x, l4.y, l4.z, l4.w}, arA[4] = {ar4.x, ar4.y, ar4.z, ar4.w}, gcA[4] = {gc4.x, gc4.y, gc4.z, gc4.w};
      const float a0A[4] = {a0v.x, a0v.y, a0v.z, a0v.w}, kkA[4] = {kkv.x, kkv.y, kkv.z, kkv.w}, kaA[4] = {kav.x, kav.y, kav.z, kav.w}, rkA[4] = {rkv.x, rkv.y, rkv.z, rkv.w};
      float a_[4], kraw[4], kd_[4]; float ss = 0.f;
#pragma unroll
      for (int e = 0; e < 4; ++e) { a_[e] = sigm(arA[e] + a0A[e]); kraw[e] = kk_[e] * kkA[e]; ss += kraw[e] * kraw[e]; kd_[e] = kk_[e] * (1.f + (a_[e] - 1.f) * kaA[e]); }
      ss = dpp_sum16(ss);
      const float rn = __builtin_amdgcn_rsqf(ss + EPS);
      float khv[4], rhv[4], bcv[4], kcv[4], btv[4], ktv[4]; float sb = 0.f;
#pragma unroll
      for (int e = 0; e < 4; ++e) {
        const float kn = kraw[e] * rn, bb = kn * a_[e];
        const float eI = __expf(gA[e]), eIm1 = __expf(gA[e] - lA[e]), eInv = __expf(-gA[e]), eC = __expf(gcA[e] - gA[e]);
        khv[e] = kn * eIm1; rhv[e] = rr[e] * eI; bcv[e] = bb * eInv; kcv[e] = kd_[e] * eInv;
        btv[e] = bb * eC; ktv[e] = kd_[e] * eC;
        sb += rr[e] * kd_[e] * rkA[e];
      }
      sb = dpp_sum16(sb);
      *(uint2*)(KH + i * LK + c4) = make_uint2(pack2(khv[0], khv[1]), pack2(khv[2], khv[3]));
      *(uint2*)(RH + i * LK + c4) = make_uint2(pack2(rhv[0], rhv[1]), pack2(rhv[2], rhv[3]));
      *(uint2*)(BC + i * LK + c4) = make_uint2(pack2(bcv[0], bcv[1]), pack2(bcv[2], bcv[3]));
      *(uint2*)(KC + i * LK + c4) = make_uint2(pack2(kcv[0], kcv[1]), pack2(kcv[2], kcv[3]));
      *(uint2*)(BR + i * LK + c4) = make_uint2(pack2(btv[0], btv[1]), pack2(btv[2], btv[3]));
      *(uint2*)(KR + i * LK + c4) = make_uint2(pack2(ktv[0], ktv[1]), pack2(ktv[2], ktv[3]));
      if ((tid & 15) == 0) p.bon[((size_t)d * T + EW_RB + EW_C * 32 + t) * 8 + h] = sb;
    }
#undef EW_I
#undef EW_GC
#undef EW_RB
#undef EW_C
  }
  __syncthreads();
#pragma unroll 1
  for (int step = 0; step < NCH; ++step) {
    int rb, c; chunk32_of_step(step, b, d, rb, c);
    bfr* VTc = (step & 1) ? VT1 : VT0; bfr* VTn = (step & 1) ? VT0 : VT1;
    float* GCc = (step & 1) ? GC1 : GC0; float* GCn = (step & 1) ? GC0 : GC1;
    const bool more = step + 1 < NCH;
    __builtin_amdgcn_s_waitcnt(0x0F70);
    if (more) RW3_STAGE_LOWRANK();
    if (step > 0 && lr_mat) {
      int rbp, cp; chunk32_of_step(step - 1, b, d, rbp, cp);
      const int tl = (wave >> 1) * 64 + lane, i = tl >> 3, c8 = (tl & 7) * 8, t = d ? 31 - i : i;
      *(uint4*)(p.O + (size_t)(rbp + cp * 32 + t) * OLD + d * 2048 + 2 * 512 + h * 64 + c8) = *(const uint4*)(OST + i * LK + c8);
      if (tl < 32) p.bon[((size_t)d * T + rb + c * 32 + tl) * 8 + h] = BONL[tl];
    }
    if (step + 2 < NCH) rwkv3_prefetch(p, pfA, pfB, fw, step + 2, b, d, h);
    __syncthreads();
    if (wave == 0) {
#pragma unroll
      for (int q = 0; q < 3; ++q) {
        const int ta = q >> 1 | (q & 1), tb = q >> 1;
        const f32x4 a = mma16<2>(KH + ta * 16 * LK, LK, BC + tb * 16 * LK, LK, f32x4{0.f, 0.f, 0.f, 0.f});
#pragma unroll
        for (int r = 0; r < 4; ++r) { const int t = ta * 16 + (lane >> 4) * 4 + r, j = tb * 16 + (lane & 15); Lf[t * LFS + j] = (j < t) ? a[r] : 0.f; }
      }
      asm volatile("s_waitcnt lgkmcnt(0)" ::: "memory");
      if (lane < 32) {
        const int blk = lane >> 4, cc = lane & 15;
        float x[16];
#pragma unroll
        for (int i = 0; i < 16; ++i) x[i] = (i == cc) ? 1.f : 0.f;
#pragma unroll
        for (int i = 1; i < 16; ++i) {
          const float* lr = Lf + (16 * blk + i) * LFS + 16 * blk;
#pragma unroll
          for (int j4 = 0; j4 < (i + 3) / 4; ++j4) {
            const float4 l4 = *(const float4*)(lr + 4 * j4);
            const float la[4] = {l4.x, l4.y, l4.z, l4.w};
#pragma unroll
            for (int e = 0; e < 4; ++e) if (4 * j4 + e < i) x[i] -= la[e] * x[4 * j4 + e];
          }
          asm volatile("" ::: "memory");
        }
#pragma unroll
        for (int i = 0; i < 16; ++i) Tf[(16 * blk + i) * LFS + 16 * blk + cc] = x[i];
      }
      asm volatile("s_waitcnt lgkmcnt(0)" ::: "memory");
      {
        const f32x4 xa = bmm16(Lf + 16 * LFS, LFS, Tf, LFS, f32x4{0.f, 0.f, 0.f, 0.f});
#pragma unroll
        for (int r = 0; r < 4; ++r) TMPX[((lane >> 4) * 4 + r) * 16 + (lane & 15)] = xa[r];
        asm volatile("s_waitcnt lgkmcnt(0)" ::: "memory");
        const f32x4 ta2 = bmm16(Tf + 16 * LFS + 16, LFS, TMPX, 16, f32x4{0.f, 0.f, 0.f, 0.f});
#pragma unroll
        for (int r = 0; r < 4; ++r) Tf[(16 + (lane >> 4) * 4 + r) * LFS + (lane & 15)] = -ta2[r];
      }
      asm volatile("s_waitcnt lgkmcnt(0)" ::: "memory");
#pragma unroll
      for (int q = 0; q < 4; ++q) {
        const int idx = lane + 64 * q, i = idx >> 3, j4 = (idx & 7) * 4;
        float tvv[4];
#pragma unroll
        for (int e = 0; e < 4; ++e) tvv[e] = ((j4 >> 4) <= (i >> 4)) ? Tf[i * LFS + j4 + e] : 0.f;
        *(uint2*)(Tm + i * LJ + j4) = make_uint2(pack2(tvv[0], tvv[1]), pack2(tvv[2], tvv[3]));
      }
    } else if (wave < 4) {
#pragma unroll
      for (int u = 0; u < 4; ++u) {
        const int id = (wave - 1) * 4 + u, prod = 1 + (id >> 2), ta = (id >> 1) & 1, tb = id & 1;
        f32x4 a = f32x4{0.f, 0.f, 0.f, 0.f};
        const bfr* Aop = (prod == 2) ? BC : KC; const bfr* Bop = (prod == 1) ? KH : RH;
        if (tb <= ta) a = mma16<2>(Aop + tb * 16 * LK, LK, Bop + ta * 16 * LK, LK, a);
        const int t = ta * 16 + (lane & 15), j0 = tb * 16 + (lane >> 4) * 4;
        float v4[4];
#pragma unroll
        for (int r = 0; r < 4; ++r) { const int j = j0 + r; v4[r] = ((prod == 1) ? (j < t) : (j <= t)) ? a[r] : 0.f; }
        bfr* Dst = (prod == 1) ? Aak : (prod == 2 ? Arb : Ark);
        *(uint2*)(Dst + t * LJ + j0) = make_uint2(pack2(v4[0], v4[1]), pack2(v4[2], v4[3]));
      }
    } else {
      {
        const int tl = tid - 256, k = tl & 63, iq = (tl >> 6) * 8;
        unsigned bw[4], kw[4];
#pragma unroll
        for (int e = 0; e < 4; ++e) {
          bw[e] = (unsigned)BR[(iq + 2 * e) * LK + k] | ((unsigned)BR[(iq + 2 * e + 1) * LK + k] << 16);
          kw[e] = (unsigned)KR[(iq + 2 * e) * LK + k] | ((unsigned)KR[(iq + 2 * e + 1) * LK + k] << 16);
        }
        *(uint4*)(BTt + k * LJ + iq) = make_uint4(bw[0], bw[1], bw[2], bw[3]);
        *(uint4*)(KTt + k * LJ + iq) = make_uint4(kw[0], kw[1], kw[2], kw[3]);
      }
#pragma unroll
      for (int ti = 0; ti < 2; ++ti) {
        p1[ti] = mma16<2>(KH + ti * 16 * LK, LK, S0b + tv * 16 * LK, LK, f32x4{0.f, 0.f, 0.f, 0.f});
        p2[ti] = mma16<2>(RH + ti * 16 * LK, LK, S0b + tv * 16 * LK, LK, f32x4{0.f, 0.f, 0.f, 0.f});
      }
    }
    if (more) {
      if (wave >= 1 && wave < 4) { RW3_CUMSUM_TILE(GCn, wave - 1); RW3_CUMSUM_TILE(GCn, wave + 2); if (wave < 3) RW3_CUMSUM_TILE(GCn, wave + 5); }
      if (wave >= 4) RW3_VT(VTn, tid - 256);
    }
    __syncthreads();
    if (wave >= 4) {
      const int vrow = (tv * 16 + (lane & 15)) * LJ + (lane >> 4) * 4;
#pragma unroll
      for (int ti = 0; ti < 2; ++ti) {
        const f32x4 z = mma16<1>(Aak + ti * 16 * LJ, LJ, VTc + tv * 16 * LJ, LJ, p1[ti]);
        *(uint2*)(ZT + vrow + ti * 16) = make_uint2(pack2(-z[0], -z[1]), pack2(-z[2], -z[3]));
      }
#pragma unroll
      for (int ti = 0; ti < 2; ++ti) {
        const f32x4 uu = mma16<1>(Tm + ti * 16 * LJ, LJ, ZT + tv * 16 * LJ, LJ, f32x4{0.f, 0.f, 0.f, 0.f});
        *(uint2*)(UT + vrow + ti * 16) = make_uint2(pack2(uu[0], uu[1]), pack2(uu[2], uu[3]));
      }
#pragma unroll
      for (int ti = 0; ti < 2; ++ti) {
        f32x4 o = mma16<1>(Arb + ti * 16 * LJ, LJ, UT + tv * 16 * LJ, LJ, p2[ti]);
        o = mma16<1>(Ark + ti * 16 * LJ, LJ, VTc + tv * 16 * LJ, LJ, o);
#pragma unroll
        for (int r = 0; r < 4; ++r) OST[(ti * 16 + (lane >> 4) * 4 + r) * LK + tv * 16 + (lane & 15)] = f2bf(o[r]);
      }
#pragma unroll
      for (int sk = 0; sk < 4; ++sk) {
        const float gcx = __expf(GCc[sk * 16 + (lane & 15)]);
        f32x4 sn = Sm[sk] * gcx;
        sn = mma16<1>(UT + tv * 16 * LJ, LJ, BTt + sk * 16 * LJ, LJ, sn);
        sn = mma16<1>(VTc + tv * 16 * LJ, LJ, KTt + sk * 16 * LJ, LJ, sn);
        Sm[sk] = sn;
#pragma unroll
        for (int r = 0; r < 4; ++r) S0b[(tv * 16 + (lane >> 4) * 4 + r) * LK + sk * 16 + (lane & 15)] = f2bf(sn[r]);
      }
    }
    if (wave < 4 && more) {
      int rbn, cn; chunk32_of_step(step + 1, b, d, rbn, cn);
#pragma unroll 1
      for (int pass = 0; pass < 2; ++pass) {
#define EW_I ((tid >> 4) + 16 * pass)
#define EW_GC GCn
#define EW_RB rbn
#define EW_C cn
    {
      const int i = EW_I, t = d ? 31 - i : i;
      float rr[4], kk_[4];
      unpack4(*(const uint2*)(RK + i * 128 + c4), rr); unpack4(*(const uint2*)(RK + i * 128 + 64 + c4), kk_);
      const float4 g4 = *(const float4*)&Gf[i * 64 + c4], l4 = *(const float4*)&LWf[i * 64 + c4], ar4 = *(const float4*)&ARf[i * 64 + c4], gc4 = *(const float4*)&EW_GC[c4];
      const float gA[4] = {g4.x, g4.y, g4.z, g4.w}, lA[4] = {l4.x, l4.y, l4.z, l4.w}, arA[4] = {ar4.x, ar4.y, ar4.z, ar4.w}, gcA[4] = {gc4.x, gc4.y, gc4.z, gc4.w};
      const float a0A[4] = {a0v.x, a0v.y, a0v.z, a0v.w}, kkA[4] = {kkv.x, kkv.y, kkv.z, kkv.w}, kaA[4] = {kav.x, kav.y, kav.z, kav.w}, rkA[4] = {rkv.x, rkv.y, rkv.z, rkv.w};
      float a_[4], kraw[4], kd_[4]; float ss = 0.f;
#pragma unroll
      for (int e = 0; e < 4; ++e) { a_[e] = sigm(arA[e] + a0A[e]); kraw[e] = kk_[e] * kkA[e]; ss += kraw[e] * kraw[e]; kd_[e] = kk_[e] * (1.f + (a_[e] - 1.f) * kaA[e]); }
      ss = dpp_sum16(ss);
      const float rn = __builtin_amdgcn_rsqf(ss + EPS);
      float khv[4], rhv[4], bcv[4], kcv[4], btv[4], ktv[4]; float sb = 0.f;
#pragma unroll
      for (int e = 0; e < 4; ++e) {
        const float kn = kraw[e] * rn, bb = kn * a_[e];
        const float eI = __expf(gA[e]), eIm1 = __expf(gA[e] - lA[e]), eInv = __expf(-gA[e]), eC = __expf(gcA[e] - gA[e]);
        khv[e] = kn * eIm1; rhv[e] = rr[e] * eI; bcv[e] = bb * eInv; kcv[e] = kd_[e] * eInv;
        btv[e] = bb * eC; ktv[e] = kd_[e] * eC;
        sb += rr[e] * kd_[e] * rkA[e];
      }
      sb = dpp_sum16(sb);
      *(uint2*)(KH + i * LK + c4) = make_uint2(pack2(khv[0], khv[1]), pack2(khv[2], khv[3]));
      *(uint2*)(RH + i * LK + c4) = make_uint2(pack2(rhv[0], rhv[1]), pack2(rhv[2], rhv[3]));
      *(uint2*)(BC + i * LK + c4) = make_uint2(pack2(bcv[0], bcv[1]), pack2(bcv[2], bcv[3]));
      *(uint2*)(KC + i * LK + c4) = make_uint2(pack2(kcv[0], kcv[1]), pack2(kcv[2], kcv[3]));
      *(uint2*)(BR + i * LK + c4) = make_uint2(pack2(btv[0], btv[1]), pack2(btv[2], btv[3]));
      *(uint2*)(KR + i * LK + c4) = make_uint2(pack2(ktv[0], ktv[1]), pack2(ktv[2], ktv[3]));
      if ((tid & 15) == 0) BONL[t] = sb;
    }
#undef EW_I
#undef EW_GC
#undef EW_RB
#undef EW_C
      }
    }
    __syncthreads();
  }
  if (tid < 256) {
    int rb, c; chunk32_of_step(NCH - 1, b, d, rb, c);
    const int i = tid >> 3, c8 = (tid & 7) * 8, t = d ? 31 - i : i;
    *(uint4*)(p.O + (size_t)(rb + c * 32 + t) * OLD + d * 2048 + 2 * 512 + h * 64 + c8) = *(const uint4*)(OST + i * LK + c8);
  }
#undef RW3_STAGE_LOWRANK
#undef RW3_CUMSUM_TILE
#undef RW3_VT
}

DEVINL void ssm_prefetch(const Params& p, uint4& pf0, uint4& pf1, uint4& pf2, float& dtraw, int step, int b, int d, int h) {
  int rb, len, c; chunk_of_step(step, b, d, rb, len, c);
  const int tid = threadIdx.x, r = tid >> 3, g8 = (tid & 7) * 8, gq = h >> 2;
  const bfr* base = p.P + (size_t)(rb + c * 64 + r) * NINP + C_SSM + 512 + g8;
  pf0 = *(const uint4*)(base + h * 64); pf1 = *(const uint4*)(base + 512 + gq * 64); pf2 = *(const uint4*)(base + 640 + gq * 64);
  if (tid < 64) { const int t = c * 64 + (d ? 63 - tid : tid); dtraw = bf2f(p.P[(size_t)(rb + t) * NINP + C_SSM + 1280 + d * 8 + h]); }
}
template <int L>
DEVINL void scan_ssm2(const Params& p, int item, char* sm) {
  const int d = item & 1, h = (item >> 1) & 7, b = item >> 4;
  const int tid = threadIdx.x, lane = tid & 63, wave = tid >> 6;
  constexpr int LB = 72;
  bfr* Qm = (bfr*)sm; bfr* Qg = Qm + 64 * LB; bfr* Km = Qg + 64 * LB; bfr* K2T = Km + 64 * LB; bfr* VT = K2T + 64 * LB; bfr* SCm = VT + 64 * LB; bfr* ST = SCm + 64 * LB; bfr* OST = ST + 64 * LB;
  float* gsv = (float*)(OST + 64 * LB); float* dtv = gsv + 64;
  for (int i = tid; i < 64 * LB; i += NTHR) ST[i] = 0;
  const float dtb = p.ssm_dt_bias[L * 16 + d * 8 + h], Aneg = -__expf(p.ssm_a_log[L * 16 + d * 8 + h]);
  f32x4 Sm[2] = {f32x4{0.f, 0.f, 0.f, 0.f}, f32x4{0.f, 0.f, 0.f, 0.f}};
  uint4 pf0, pf1, pf2; float dtraw = 0.f;
  ssm_prefetch(p, pf0, pf1, pf2, dtraw, 0, b, d, h);
#pragma unroll 1
  for (int step = 0; step < 68; ++step) {
    int rb, len, c; chunk_of_step(step, b, d, rb, len, c);
    __syncthreads();
    if (tid < 64) {
      const float dt = softplus(dtraw + dtb);
      float la = dt * Aneg;
#pragma unroll
      for (int o = 1; o < 64; o <<= 1) { const float n = __shfl_up(la, o); if (tid >= o) la += n; }
      gsv[tid] = la; dtv[tid] = dt;
    }
    __syncthreads();
    const float g63 = gsv[63];
    {
      const int r = tid >> 3, g = tid & 7, i = d ? 63 - r : r;
      float y[8];
      unpack8(pf0, y);
#pragma unroll
      for (int e = 0; e < 8; ++e) VT[(g * 8 + e) * LB + i] = f2bf(y[e]);
      unpack8(pf1, y);
      const float dt = dtv[i], e2 = __expf(g63 - gsv[i]);
#pragma unroll
      for (int e = 0; e < 8; ++e) y[e] *= dt;
      *(uint4*)(Km + i * LB + g * 8) = make_uint4(pack2(y[0], y[1]), pack2(y[2], y[3]), pack2(y[4], y[5]), pack2(y[6], y[7]));
#pragma unroll
      for (int e = 0; e < 8; ++e) K2T[(g * 8 + e) * LB + i] = f2bf(y[e] * e2);
      unpack8(pf2, y);
      const float eg = __expf(gsv[i]);
      *(uint4*)(Qm + i * LB + g * 8) = pf2;
      *(uint4*)(Qg + i * LB + g * 8) = make_uint4(pack2(y[0] * eg, y[1] * eg), pack2(y[2] * eg, y[3] * eg), pack2(y[4] * eg, y[5] * eg), pack2(y[6] * eg, y[7] * eg));
    }
    __syncthreads();
    if (step + 1 < 68) ssm_prefetch(p, pf0, pf1, pf2, dtraw, step + 1, b, d, h);
#pragma unroll
    for (int u = 0; u < 2; ++u) {
      const int id = 2 * wave + u, ti = id >> 2, tj = id & 3;
      f32x4 a = f32x4{0.f, 0.f, 0.f, 0.f};
      if (tj <= ti) a = mma16<2>(Qm + ti * 16 * LB, LB, Km + tj * 16 * LB, LB, a);
#pragma unroll
      for (int r = 0; r < 4; ++r) {
        const int i = ti * 16 + (lane >> 4) * 4 + r, j = tj * 16 + (lane & 15);
        SCm[i * LB + j] = (j <= i) ? f2bf(a[r] * __expf(gsv[i] - gsv[j])) : (bfr)0;
      }
    }
    __syncthreads();
    const float sd = __expf(g63);
#pragma unroll
    for (int u = 0; u < 2; ++u) {
      const int id = 2 * wave + u, ti = id >> 2, tp = id & 3;
      f32x4 o = mma16<2>(SCm + ti * 16 * LB, LB, VT + tp * 16 * LB, LB, f32x4{0.f, 0.f, 0.f, 0.f});
      o = mma16<2>(Qg + ti * 16 * LB, LB, ST + tp * 16 * LB, LB, o);
#pragma unroll
      for (int r = 0; r < 4; ++r) OST[(ti * 16 + (lane >> 4) * 4 + r) * LB + tp * 16 + (lane & 15)] = f2bf(o[r]);
      Sm[u] = mma16<2>(K2T + ti * 16 * LB, LB, VT + tp * 16 * LB, LB, Sm[u] * sd);
    }
    __syncthreads();
#pragma unroll
    for (int u = 0; u < 2; ++u) {
      const int id = 2 * wave + u, tn = id >> 2, tp = id & 3;
      *(uint2*)(ST + (tp * 16 + (lane & 15)) * LB + tn * 16 + (lane >> 4) * 4) = make_uint2(pack2(Sm[u][0], Sm[u][1]), pack2(Sm[u][2], Sm[u][3]));
    }
    {
      const int i = tid >> 3, c8 = (tid & 7) * 8, t = d ? 63 - i : i;
      *(uint4*)(p.O + (size_t)(rb + c * 64 + t) * OLD + d * 2048 + 0 * 512 + h * 64 + c8) = *(const uint4*)(OST + i * LB + c8);
    }
  }
}

DEVINL void gla_prefetch(const Params& p, uint4 (&pf)[5], int step, int b, int d, int h) {
  int rb, len, c; chunk_of_step(step, b, d, rb, len, c);
#pragma unroll
  for (int q = 0; q < 5; ++q) {
    const int idx = threadIdx.x + NTHR * q;
    uint4 v = make_uint4(0, 0, 0, 0);
    if (idx < 64 * 34) {
      const int r = idx / 34, qq = idx % 34;
      const int col = qq < 8 ? h * 64 + qq * 8 : (qq < 16 ? 256 + h * 64 + (qq - 8) * 8 : (qq < 32 ? 512 + h * 128 + (qq - 16) * 8 : 1536 + d * 16 + (qq - 32) * 8));
      v = *(const uint4*)(p.P + (size_t)(rb + c * 64 + r) * NINP + C_GLA + col);
    }
    pf[q] = v;
  }
}
template <int L>
DEVINL void scan_gla2(const Params& p, int item, char* sm) {
  const int d = item & 1, h = (item >> 1) & 3, b = item >> 3;
  const int tid = threadIdx.x, lane = tid & 63, wave = tid >> 6;
  constexpr int LB = 72, LO = 136, LR = 272;
  bfr* Qg = (bfr*)sm; bfr* Kn = Qg + 64 * LB; bfr* K2T = Kn + 64 * LB; bfr* SCm = K2T + 64 * LB; bfr* VT = SCm + 64 * LB; bfr* ST = VT + 128 * LB; bfr* OST = ST + 128 * LB;
  bfr* RAWG = OST + 64 * LO;
  float* SEG = (float*)(RAWG + 64 * LR);
  float* sdec = SEG + 512;
  for (int i = tid; i < 128 * LB; i += NTHR) ST[i] = 0;
  float w2r[16];
  const int kch = tid & 63;
#pragma unroll
  for (int r = 0; r < 16; ++r) w2r[r] = p.gla_w2[((size_t)(L * 2 + d) * 16 + r) * 256 + h * 64 + kch];
  const float bk = p.gla_b[(L * 2 + d) * 256 + h * 64 + kch];
  f32x4 Sm[4];
#pragma unroll
  for (int u = 0; u < 4; ++u) Sm[u] = f32x4{0.f, 0.f, 0.f, 0.f};
  uint4 pf[5];
  gla_prefetch(p, pf, 0, b, d, h);
#pragma unroll 1
  for (int step = 0; step < 68; ++step) {
    int rb, len, c; chunk_of_step(step, b, d, rb, len, c);
    __syncthreads();
#pragma unroll
    for (int q = 0; q < 5; ++q) { const int idx = tid + NTHR * q; if (idx < 64 * 34) *(uint4*)(RAWG + (idx / 34) * LR + (idx % 34) * 8) = pf[q]; }
    __syncthreads();
    if (step + 1 < 68) gla_prefetch(p, pf, step + 1, b, d, h);
    float gl[8];
    {
      float run = 0.f;
#pragma unroll
      for (int q = 0; q < 8; ++q) {
        const int i = 8 * wave + q, t = d ? 63 - i : i;
        float gr[8]; float lg = bk;
        unpack8(*(const uint4*)(RAWG + t * LR + 256), gr);
#pragma unroll
        for (int r = 0; r < 8; ++r) lg += gr[r] * w2r[r];
        unpack8(*(const uint4*)(RAWG + t * LR + 264), gr);
#pragma unroll
        for (int r = 0; r < 8; ++r) lg += gr[r] * w2r[8 + r];
        run += -softplus(-lg) * (1.f / 16.f);
        gl[q] = run;
      }
      SEG[wave * 64 + kch] = run;
    }
    __syncthreads();
    {
      float pre = 0.f, tot = 0.f;
#pragma unroll
      for (int w = 0; w < 8; ++w) { const float sv = SEG[w * 64 + kch]; tot += sv; if (w < wave) pre += sv; }
      float k2v[8];
#pragma unroll
      for (int q = 0; q < 8; ++q) {
        const int i = 8 * wave + q, t = d ? 63 - i : i;
        const float gg = gl[q] + pre;
        const float qv = bf2f(RAWG[t * LR + kch]), kv = bf2f(RAWG[t * LR + 64 + kch]);
        Qg[i * LB + kch] = f2bf(qv * 0.125f * __expf(gg)); Kn[i * LB + kch] = f2bf(kv * __expf(-gg)); k2v[q] = kv * __expf(tot - gg);
      }
      *(uint4*)(K2T + kch * LB + 8 * wave) = make_uint4(pack2(k2v[0], k2v[1]), pack2(k2v[2], k2v[3]), pack2(k2v[4], k2v[5]), pack2(k2v[6], k2v[7]));
      if (wave == 0) sdec[kch] = __expf(tot);
      const int pp = tid & 127, i0 = (tid >> 7) * 16;
      float vv[16];
#pragma unroll
      for (int q = 0; q < 16; ++q) { const int i = i0 + q, t = d ? 63 - i : i; vv[q] = bf2f(RAWG[t * LR + 128 + pp]); }
      *(uint4*)(VT + pp * LB + i0) = make_uint4(pack2(vv[0], vv[1]), pack2(vv[2], vv[3]), pack2(vv[4], vv[5]), pack2(vv[6], vv[7]));
      *(uint4*)(VT + pp * LB + i0 + 8) = make_uint4(pack2(vv[8], vv[9]), pack2(vv[10], vv[11]), pack2(vv[12], vv[13]), pack2(vv[14], vv[15]));
    }
    __syncthreads();
#pragma unroll
    for (int u = 0; u < 2; ++u) {
      const int id = 2 * wave + u, ti = id >> 2, tj = id & 3;
      f32x4 a = f32x4{0.f, 0.f, 0.f, 0.f};
      if (tj <= ti) a = mma16<2>(Qg + ti * 16 * LB, LB, Kn + tj * 16 * LB, LB, a);
#pragma unroll
      for (int r = 0; r < 4; ++r) {
        const int i = ti * 16 + (lane >> 4) * 4 + r, j = tj * 16 + (lane & 15);
        SCm[i * LB + j] = (j <= i) ? f2bf(a[r]) : (bfr)0;
      }
    }
    __syncthreads();
#pragma unroll
    for (int u = 0; u < 4; ++u) {
      const int id = 4 * wave + u, ti = id >> 3, tp = id & 7;
      f32x4 o = mma16<2>(SCm + ti * 16 * LB, LB, VT + tp * 16 * LB, LB, f32x4{0.f, 0.f, 0.f, 0.f});
      o = mma16<2>(Qg + ti * 16 * LB, LB, ST + tp * 16 * LB, LB, o);
#pragma unroll
      for (int r = 0; r < 4; ++r) OST[(ti * 16 + (lane >> 4) * 4 + r) * LO + tp * 16 + (lane & 15)] = f2bf(o[r]);
      f32x4 sdv;
#pragma unroll
      for (int r = 0; r < 4; ++r) sdv[r] = sdec[ti * 16 + (lane >> 4) * 4 + r];
      Sm[u] = mma16<2>(K2T + ti * 16 * LB, LB, VT + tp * 16 * LB, LB, Sm[u] * sdv);
    }
    __syncthreads();
#pragma unroll
    for (int u = 0; u < 4; ++u) {
      const int id = 4 * wave + u, tk = id >> 3, tp = id & 7;
      *(uint2*)(ST + (tp * 16 + (lane & 15)) * LB + tk * 16 + (lane >> 4) * 4) = make_uint2(pack2(Sm[u][0], Sm[u][1]), pack2(Sm[u][2], Sm[u][3]));
    }
    {
      const int i = tid >> 3, t = d ? 63 - i : i;
#pragma unroll
      for (int q = 0; q < 2; ++q) {
        const int c8 = (tid & 7) * 8 + q * 64;
        *(uint4*)(p.O + (size_t)(rb + c * 64 + t) * OLD + d * 2048 + 1 * 512 + h * 128 + c8) = *(const uint4*)(OST + i * LO + c8);
      }
    }
  }
}


DEVINL void gdn_prefetch(const Params& p, uint4& pf0, uint4& pf1, uint4& pf2, uint4& pf3, uint4& pf4, bfr& araw, bfr& braw, int step, int b, int d, int h, int vh) {
  int rb, len, c; chunk_of_step(step, b, d, rb, len, c);
  const int tid = threadIdx.x;
  const bfr* base = p.P + (size_t)(rb + c * 64) * NINP + C_GDN;
  { const int r = tid >> 4, g = tid & 15;
    pf0 = *(const uint4*)(base + (size_t)r * NINP + h * 128 + g * 8); pf1 = *(const uint4*)(base + (size_t)(r + 32) * NINP + h * 128 + g * 8);
    pf2 = *(const uint4*)(base + (size_t)r * NINP + 512 + h * 128 + g * 8); pf3 = *(const uint4*)(base + (size_t)(r + 32) * NINP + 512 + h * 128 + g * 8); }
  { const int r = tid >> 3, g = tid & 7; pf4 = *(const uint4*)(base + (size_t)r * NINP + 1024 + h * 128 + vh * 64 + g * 8); }
  if (tid >= 64 && tid < 128) {
    const int tl = tid - 64, t = c * 64 + (d ? 63 - tl : tl);
    const bfr* pr = p.P + (size_t)(rb + t) * NINP + C_GDN;
    araw = pr[2048 + d * 4 + h]; braw = pr[2056 + d * 4 + h];
  }
}
template <int L>
DEVINL void scan_gdn2(const Params& p, int item, char* sm) {
  const int vh = item & 1, d = (item >> 1) & 1, h = (item >> 2) & 3, b = item >> 4;
  const int tid = threadIdx.x, lane = tid & 63, wave = __builtin_amdgcn_readfirstlane(tid >> 6);
  constexpr int LQ = 136, LB = 72, LF = 68;
  bfr* QN = (bfr*)sm; bfr* KN = QN + 64 * LQ; bfr* U0 = KN + 64 * LQ; bfr* KdT = U0 + 64 * LB; bfr* Tm = KdT + 128 * LB; bfr* ATm = Tm + 64 * LB; bfr* ST = ATm + 64 * LB;
  float* SMALL = (float*)(ST + 64 * LQ);
  float* TMPX = SMALL + 512;
  bfr* ZT = (bfr*)(TMPX + 6 * 256);
  char* REG = (char*)(ZT + 64 * LB);
  float* Lf = (float*)REG; float* Tf = Lf + 64 * LF;
  bfr* VnT = (bfr*)REG; bfr* OST = VnT + 64 * LB;
  for (int i = tid; i < 64 * LQ; i += NTHR) ST[i] = 0;
  const float Aneg = -__expf(p.gdn_a_log[L * 8 + d * 4 + h]), dtb = p.gdn_dt_bias[L * 8 + d * 4 + h];
  f32x4 Sm[4];
#pragma unroll
  for (int u = 0; u < 4; ++u) Sm[u] = f32x4{0.f, 0.f, 0.f, 0.f};
  uint4 pf0, pf1, pf2, pf3, pf4; bfr araw = 0, braw = 0;
  gdn_prefetch(p, pf0, pf1, pf2, pf3, pf4, araw, braw, 0, b, d, h, vh);
#define GDN_GBETA(DST) do { \
    float g_ = Aneg * softplus(bf2f(araw) + dtb); const float beta_ = sigm(bf2f(braw)); \
    _Pragma("unroll") for (int o_ = 1; o_ < 64; o_ <<= 1) { const float n_ = __shfl_up(g_, o_); if (lane >= o_) g_ += n_; } \
    const float g63_ = __shfl(g_, 63); \
    (DST)[lane] = g_; (DST)[64 + lane] = beta_; (DST)[128 + lane] = __expf(g63_ - g_); (DST)[192 + lane] = __expf(g_); } while (0)
  if (wave == 1) GDN_GBETA(SMALL);
  __syncthreads();
#pragma unroll 1
  for (int step = 0; step < 68; ++step) {
    int rb, len, c; chunk_of_step(step, b, d, rb, len, c);
    float* Gs = SMALL + (step & 1) * 256; float* Bts = Gs + 64; float* EK = Bts + 64; float* EG = EK + 64;
    float* SMn = SMALL + ((step + 1) & 1) * 256;
    __builtin_amdgcn_s_waitcnt(0x0F70);
    {
      const int r = tid >> 4, g = tid & 15, i0 = d ? 63 - r : r, i1 = d ? 31 - r : r + 32;
      *(uint4*)(QN + i0 * LQ + g * 8) = pf0; *(uint4*)(QN + i1 * LQ + g * 8) = pf1;
      *(uint4*)(KN + i0 * LQ + g * 8) = pf2; *(uint4*)(KN + i1 * LQ + g * 8) = pf3;
    }
    {
      const int r = tid >> 3, g = tid & 7, i = d ? 63 - r : r;
      float y[8]; unpack8(pf4, y);
      const float bt = Bts[i];
      *(uint4*)(U0 + i * LB + g * 8) = make_uint4(pack2(y[0] * bt, y[1] * bt), pack2(y[2] * bt, y[3] * bt), pack2(y[4] * bt, y[5] * bt), pack2(y[6] * bt, y[7] * bt));
    }
    if (step > 0) {
      int rbp, lenp, cp; chunk_of_step(step - 1, b, d, rbp, lenp, cp);
      const int i = tid >> 3, c8 = (tid & 7) * 8, t = d ? 63 - i : i;
      *(uint4*)(p.O + (size_t)(rbp + cp * 64 + t) * OLD + d * 2048 + 3 * 512 + h * 128 + vh * 64 + c8) = *(const uint4*)(OST + i * LB + c8);
    }
    if (step + 1 < 68) gdn_prefetch(p, pf0, pf1, pf2, pf3, pf4, araw, braw, step + 1, b, d, h, vh);
    __syncthreads();
    {
      const int k = tid & 127, jq = (tid >> 7) * 16;
      float v[16];
#pragma unroll
      for (int q = 0; q < 16; ++q) v[q] = bf2f(KN[(jq + q) * LQ + k]) * EK[jq + q];
      *(uint4*)(KdT + k * LB + jq) = make_uint4(pack2(v[0], v[1]), pack2(v[2], v[3]), pack2(v[4], v[5]), pack2(v[6], v[7]));
      *(uint4*)(KdT + k * LB + jq + 8) = make_uint4(pack2(v[8], v[9]), pack2(v[10], v[11]), pack2(v[12], v[13]), pack2(v[14], v[15]));
    }
#pragma unroll 1
    for (int u = 0; u < 4; ++u) {
      const int id = 4 * wave + u;
      if (id < 16) {
        const int ti = id >> 2, tj = id & 3;
        if (tj <= ti) {
          const f32x4 a = mma16<4>(KN + ti * 16 * LQ, LQ, KN + tj * 16 * LQ, LQ, f32x4{0.f, 0.f, 0.f, 0.f});
#pragma unroll
          for (int r = 0; r < 4; ++r) {
            const int i = ti * 16 + (lane >> 4) * 4 + r, j = tj * 16 + (lane & 15);
            Lf[i * LF + j] = (j < i) ? a[r] * __expf(Gs[i] - Gs[j]) * Bts[i] : 0.f;
          }
        }
      } else {
        const int ti = (id - 16) >> 2, tj = (id - 16) & 3;
        f32x4 a = f32x4{0.f, 0.f, 0.f, 0.f};
        if (tj <= ti) a = mma16<4>(KN + tj * 16 * LQ, LQ, QN + ti * 16 * LQ, LQ, a);
        const int i = ti * 16 + (lane & 15), j0 = tj * 16 + (lane >> 4) * 4;
        float v4[4];
#pragma unroll
        for (int r = 0; r < 4; ++r) { const int j = j0 + r; v4[r] = (j <= i) ? a[r] * __expf(Gs[i] - Gs[j]) : 0.f; }
        *(uint2*)(ATm + i * LB + j0) = make_uint2(pack2(v4[0], v4[1]), pack2(v4[2], v4[3]));
      }
    }
    __syncthreads();
    f32x4 o1[4];
    if (wave == 1) { if (step + 1 < 68) GDN_GBETA(SMn); }
    else if (wave >= 4) {
#pragma unroll
      for (int u = 0; u < 4; ++u) {
        const int id = 4 * (wave - 4) + u, ti = id >> 2, tv = id & 3;
        const f32x4 y = mma16<4>(KN + ti * 16 * LQ, LQ, ST + tv * 16 * LQ, LQ, f32x4{0.f, 0.f, 0.f, 0.f});
        f32x4 q1 = mma16<4>(QN + ti * 16 * LQ, LQ, ST + tv * 16 * LQ, LQ, f32x4{0.f, 0.f, 0.f, 0.f});
        const int i0 = ti * 16 + (lane >> 4) * 4, v = tv * 16 + (lane & 15);
        float z[4];
#pragma unroll
        for (int r = 0; r < 4; ++r) { const int i = i0 + r; const float eg = EG[i]; z[r] = bf2f(U0[i * LB + v]) - Bts[i] * eg * y[r]; q1[r] *= eg; }
        o1[u] = q1;
        *(uint2*)(ZT + v * LB + i0) = make_uint2(pack2(z[0], z[1]), pack2(z[2], z[3]));
        asm volatile("" ::: "memory");
      }
    }
    if (wave == 0) {
      const int blk = lane >> 4, cc = lane & 15;
      float x[16];
#pragma unroll
      for (int i = 0; i < 16; ++i) x[i] = (i == cc) ? 1.f : 0.f;
#pragma unroll
      for (int i = 1; i < 16; ++i) {
        const float* lr = Lf + (16 * blk + i) * LF + 16 * blk;
#pragma unroll
        for (int j4 = 0; j4 < (i + 3) / 4; ++j4) {
          const float4 l4 = *(const float4*)(lr + 4 * j4);
          const float la[4] = {l4.x, l4.y, l4.z, l4.w};
#pragma unroll
          for (int e = 0; e < 4; ++e) if (4 * j4 + e < i) x[i] -= la[e] * x[4 * j4 + e];
        }
        asm volatile("" ::: "memory");
      }
#pragma unroll
      for (int i = 0; i < 16; ++i) Tf[(16 * blk + i) * LF + 16 * blk + cc] = x[i];
    }
    __syncthreads();
    if (wave < 3) {
      const int bi = wave + 1, bj = wave;
      f32x4 xa = bmm16(Lf + 16 * bi * LF + 16 * bj, LF, Tf + 16 * bj * LF + 16 * bj, LF, f32x4{0.f, 0.f, 0.f, 0.f});
      float* X = TMPX + wave * 256;
#pragma unroll
      for (int r = 0; r < 4; ++r) X[((lane >> 4) * 4 + r) * 16 + (lane & 15)] = xa[r];
      asm volatile("s_waitcnt lgkmcnt(0)" ::: "memory");
      const f32x4 ta = bmm16(Tf + 16 * bi * LF + 16 * bi, LF, X, 16, f32x4{0.f, 0.f, 0.f, 0.f});
#pragma unroll
      for (int r = 0; r < 4; ++r) Tf[(16 * bi + (lane >> 4) * 4 + r) * LF + 16 * bj + (lane & 15)] = -ta[r];
    }
    __syncthreads();
    if (wave < 2) {
      const int bi = wave + 2, bj = wave;
      f32x4 xa = bmm16(Lf + 16 * bi * LF + 16 * bj, LF, Tf + 16 * bj * LF + 16 * bj, LF, f32x4{0.f, 0.f, 0.f, 0.f});
      xa = bmm16(Lf + 16 * bi * LF + 16 * (bj + 1), LF, Tf + 16 * (bj + 1) * LF + 16 * bj, LF, xa);
      float* X = TMPX + (3 + wave) * 256;
#pragma unroll
      for (int r = 0; r < 4; ++r) X[((lane >> 4) * 4 + r) * 16 + (lane & 15)] = xa[r];
      asm volatile("s_waitcnt lgkmcnt(0)" ::: "memory");
      const f32x4 ta = bmm16(Tf + 16 * bi * LF + 16 * bi, LF, X, 16, f32x4{0.f, 0.f, 0.f, 0.f});
#pragma unroll
      for (int r = 0; r < 4; ++r) Tf[(16 * bi + (lane >> 4) * 4 + r) * LF + 16 * bj + (lane & 15)] = -ta[r];
    }
    __syncthreads();
    if (wave == 0) {
      f32x4 xa = bmm16(Lf + 48 * LF, LF, Tf, LF, f32x4{0.f, 0.f, 0.f, 0.f});
      xa = bmm16(Lf + 48 * LF + 16, LF, Tf + 16 * LF, LF, xa);
      xa = bmm16(Lf + 48 * LF + 32, LF, Tf + 32 * LF, LF, xa);
      float* X = TMPX + 5 * 256;
#pragma unroll
      for (int r = 0; r < 4; ++r) X[((lane >> 4) * 4 + r) * 16 + (lane & 15)] = xa[r];
      asm volatile("s_waitcnt lgkmcnt(0)" ::: "memory");
      const f32x4 ta = bmm16(Tf + 48 * LF + 48, LF, X, 16, f32x4{0.f, 0.f, 0.f, 0.f});
#pragma unroll
      for (int r = 0; r < 4; ++r) Tf[(48 + (lane >> 4) * 4 + r) * LF + (lane & 15)] = -ta[r];
    }
    __syncthreads();
    for (int idx = tid; idx < 64 * 16; idx += NTHR) {
      const int i = idx >> 4, j4 = (idx & 15) * 4;
      float tv[4];
#pragma unroll
      for (int e = 0; e < 4; ++e) tv[e] = ((j4 >> 4) <= (i >> 4)) ? Tf[i * LF + j4 + e] : 0.f;
      *(uint2*)(Tm + i * LB + j4) = make_uint2(pack2(tv[0], tv[1]), pack2(tv[2], tv[3]));
    }
    __syncthreads();
#pragma unroll
    for (int u = 0; u < 2; ++u) {
      const int id = 2 * wave + u, ti = id >> 2, tv = id & 3;
      const f32x4 vn = mma16<2>(Tm + ti * 16 * LB, LB, ZT + tv * 16 * LB, LB, f32x4{0.f, 0.f, 0.f, 0.f});
      *(uint2*)(VnT + (tv * 16 + (lane & 15)) * LB + ti * 16 + (lane >> 4) * 4) = make_uint2(pack2(vn[0], vn[1]), pack2(vn[2], vn[3]));
    }
    __syncthreads();
    {
      const float gl = __expf(Gs[63]);
      if (wave >= 4) {
#pragma unroll
        for (int u = 0; u < 4; ++u) {
          const int id = 4 * (wave - 4) + u, ti = id >> 2, tv = id & 3;
          const f32x4 o = mma16<2>(ATm + ti * 16 * LB, LB, VnT + tv * 16 * LB, LB, o1[u]);
#pragma unroll
          for (int r = 0; r < 4; ++r) OST[(ti * 16 + (lane >> 4) * 4 + r) * LB + tv * 16 + (lane & 15)] = f2bf(o[r]);
        }
      }
#pragma unroll
      for (int u = 0; u < 4; ++u) {
        const int id = 4 * wave + u, tk = id >> 2, tv = id & 3;
        Sm[u] = mma16<2>(KdT + tk * 16 * LB, LB, VnT + tv * 16 * LB, LB, Sm[u] * gl);
        *(uint2*)(ST + (tv * 16 + (lane & 15)) * LQ + tk * 16 + (lane >> 4) * 4) = make_uint2(pack2(Sm[u][0], Sm[u][1]), pack2(Sm[u][2], Sm[u][3]));
        asm volatile("" ::: "memory");
      }
    }
    __syncthreads();
  }
  {
    int rb, len, c; chunk_of_step(67, b, d, rb, len, c);
    const int i = tid >> 3, c8 = (tid & 7) * 8, t = d ? 63 - i : i;
    *(uint4*)(p.O + (size_t)(rb + c * 64 + t) * OLD + d * 2048 + 3 * 512 + h * 128 + vh * 64 + c8) = *(const uint4*)(OST + i * LB + c8);
  }
#undef GDN_GBETA
}

template <int L> DEVINL void phase_gproj(const Params& p, char* sm, int c);
template <int L>
DEVINL void phase_scans(const Params& p, char* sm) {
  const int it = blockIdx.x;
  if (it < 64) scan_rwkv3<L>(p, it, sm);
  else if (it < 128) scan_gdn2<L>(p, it - 64, sm);
  else if (it < 192) scan_ssm2<L>(p, it - 128, sm);
  else if (it < 224) scan_gla2<L>(p, it - 192, sm);
  else {
    phase_gproj<L>(p, sm, it - 224);
  }
}

template <int L>
DEVINL void phase_post2(const Params& p) {
  const int lane = threadIdx.x & 63, wave = threadIdx.x >> 6;
  const int nrows = (L == 1) ? TL : T;
  const int c8 = lane * 8;
  float pw_ssm[8], pw_gla[8], pw_lnw[8], pw_lnb[8], pw_gdn[8];
#pragma unroll
  for (int e = 0; e < 8; ++e) {
    pw_ssm[e] = p.ssm_norm[L * 512 + c8 + e]; pw_gla[e] = p.gla_norm[L * 128 + ((c8 + e) & 127)]; pw_lnw[e] = p.rwkv_ln_w[L * 512 + c8 + e];
    pw_lnb[e] = p.rwkv_ln_b[L * 512 + c8 + e]; pw_gdn[e] = p.gdn_norm[L * 128 + ((c8 + e) & 127)];
  }
  const float dssm = p.ssm_d[L * 8 + (lane >> 3)];
  for (int R = blockIdx.x * 8 + wave; R < nrows; R += gridDim.x * 8) {
    const bool lat = R < TL; const int vvb = lat ? (R >> 12) : 4;
    bfr* orow = p.O + (size_t)R * OLD; const bfr* prow = p.P + (size_t)R * NINP;
    uint4 of_[4], ob_[4];
#pragma unroll
    for (int m = 0; m < 4; ++m) { of_[m] = *(const uint4*)(orow + m * 512 + c8); ob_[m] = *(const uint4*)(orow + 2048 + m * 512 + c8); }
    const uint4 pxh = *(const uint4*)(prow + C_SSM + 512 + c8), pz = *(const uint4*)(prow + C_SSM + c8), prg = *(const uint4*)(prow + C_GLA + 1024 + c8);
    const uint4 pv = *(const uint4*)(prow + C_RWKV + 1024 + c8), pzg = *(const uint4*)(prow + C_GDN + 1536 + c8), pgg = *(const uint4*)(p.Gb + (size_t)R * 512 + c8);
    const int cr = lat ? canon_row(L, R) : R;
    const float* xp = lat ? p.out + (size_t)cr * D : p.xc + (size_t)(R - TL) * D;
    float4 xv[4];
#pragma unroll
    for (int q = 0; q < 4; ++q) xv[q] = *(const float4*)(xp + q * 256 + lane * 4);
    const float bsum = p.bon[((size_t)0 * T + R) * 8 + (lane >> 3)] + p.bon[((size_t)1 * T + R) * 8 + (lane >> 3)];
    float a[8], b[8], t1[8], t2[8];
    float y0[8]; float ss0 = 0.f;
    unpack8(of_[0], a); unpack8(ob_[0], b); unpack8(pxh, t1); unpack8(pz, t2);
#pragma unroll
    for (int e = 0; e < 8; ++e) { y0[e] = (a[e] + b[e] + dssm * t1[e]) * silu(t2[e]); ss0 += y0[e] * y0[e]; }
    ss0 = dpp_sum16(ss0); ss0 += __shfl_xor(ss0, 16);
    float y1[8]; float ss1 = 0.f;
    unpack8(of_[1], a); unpack8(ob_[1], b); unpack8(prg, t1);
#pragma unroll
    for (int e = 0; e < 8; ++e) { y1[e] = a[e] + b[e]; ss1 += y1[e] * y1[e]; }
    ss1 = dpp_sum16(ss1);
    const float r1 = __builtin_amdgcn_rsqf(ss1 * (1.f / 128.f) + EPS);
#pragma unroll
    for (int e = 0; e < 8; ++e) y1[e] = y1[e] * r1 * pw_gla[e] * silu(t1[e]);
    float y2[8]; float s2 = 0.f;
    unpack8(of_[2], a); unpack8(ob_[2], b); unpack8(pv, t1); unpack8(pgg, t2);
#pragma unroll
    for (int e = 0; e < 8; ++e) { y2[e] = a[e] + b[e]; s2 += y2[e]; }
    const float mu = dpp_sum8(s2) * (1.f / 64.f);
    float v2 = 0.f;
#pragma unroll
    for (int e = 0; e < 8; ++e) { y2[e] -= mu; v2 += y2[e] * y2[e]; }
    const float r2 = __builtin_amdgcn_rsqf(dpp_sum8(v2) * (1.f / 64.f) + 64e-5f);
#pragma unroll
    for (int e = 0; e < 8; ++e) y2[e] = (y2[e] * r2 * pw_lnw[e] + pw_lnb[e] + bsum * t1[e]) * t2[e];
    float y3[8]; float ss3 = 0.f;
    unpack8(of_[3], a); unpack8(ob_[3], b); unpack8(pzg, t1);
#pragma unroll
    for (int e = 0; e < 8; ++e) { y3[e] = a[e] + b[e]; ss3 += y3[e] * y3[e]; }
    ss3 = dpp_sum16(ss3);
    const float r3 = __builtin_amdgcn_rsqf(ss3 * (1.f / 128.f) + EPS);
#pragma unroll
    for (int e = 0; e < 8; ++e) y3[e] = y3[e] * r3 * pw_gdn[e] * silu(t1[e]);
    const float r0 = __builtin_amdgcn_rsqf(ss0 * (1.f / 256.f) + EPS);
#pragma unroll
    for (int e = 0; e < 8; ++e) y0[e] = y0[e] * r0 * pw_ssm[e];
    float xs = 0.f;
#pragma unroll
    for (int q = 0; q < 4; ++q) xs += xv[q].x * xv[q].x + xv[q].y * xv[q].y + xv[q].z * xv[q].z + xv[q].w * xv[q].w;
    xs = wave_sum(xs);
    const float rs = __builtin_amdgcn_rsqf(xs * (1.f / 1024.f) + EPS);
    const float* md = p.mod + ((size_t)L * 5 + vvb) * 6144;
    *(uint4*)(orow + 0 * 512 + c8) = make_uint4(pack2(y0[0], y0[1]), pack2(y0[2], y0[3]), pack2(y0[4], y0[5]), pack2(y0[6], y0[7]));
    *(uint4*)(orow + 1 * 512 + c8) = make_uint4(pack2(y1[0], y1[1]), pack2(y1[2], y1[3]), pack2(y1[4], y1[5]), pack2(y1[6], y1[7]));
    *(uint4*)(orow + 2 * 512 + c8) = make_uint4(pack2(y2[0], y2[1]), pack2(y2[2], y2[3]), pack2(y2[4], y2[5]), pack2(y2[6], y2[7]));
    *(uint4*)(orow + 3 * 512 + c8) = make_uint4(pack2(y3[0], y3[1]), pack2(y3[2], y3[3]), pack2(y3[4], y3[5]), pack2(y3[6], y3[7]));
#pragma unroll
    for (int q = 0; q < 4; ++q) {
      const int j = q * 256 + lane * 4;
      const float4 nw = *(const float4*)(p.norm_mix + L * D + j), sh = *(const float4*)(md + j), scl = *(const float4*)(md + 1024 + j);
      const float h0 = xv[q].x * rs * nw.x * (1.f + scl.x) + sh.x, h1 = xv[q].y * rs * nw.y * (1.f + scl.y) + sh.y;
      const float h2 = xv[q].z * rs * nw.z * (1.f + scl.z) + sh.z, h3 = xv[q].w * rs * nw.w * (1.f + scl.w) + sh.w;
      *(uint2*)(orow + 2048 + j) = make_uint2(pack2(h0, h1), pack2(h2, h3));
    }
  }
}

template <int L>
DEVINL void phase_route(const Params& p, char* sm) {
  const int tid = threadIdx.x, lane = tid & 63, wave = tid >> 6;
  float* rw = (float*)sm;
  int* lcnt = (int*)(rw + 16 * 1024);
  int* lbase = lcnt + 16; unsigned* tokinfo = (unsigned*)(lbase + 16);
  __syncthreads();
  for (int i = tid; i < 1024 * 16; i += NTHR) rw[(i & 15) * 1024 + (i >> 4)] = p.router_w[i];
  if (tid < 16) lcnt[tid] = 0;
  __syncthreads();
  const int ntok = (L == 1) ? TL : T;
  int iter = 0;
  for (int tk = blockIdx.x * 8 + wave; tk < ntok; tk += gridDim.x * 8, ++iter) {
    const bool lat = tk < TL;
    const int vv = lat ? (tk >> 12) : 4;
    const float* xp = lat ? p.out + (size_t)tk * D : p.xc + (size_t)(tk - TL) * D;
    float ss = 0.f;
#pragma unroll
    for (int q = 0; q < 4; ++q) {
      const float4 xv = *(const float4*)(xp + q * 256 + lane * 4);
      ss += xv.x * xv.x + xv.y * xv.y + xv.z * xv.z + xv.w * xv.w;
    }
    ss = wave_sum(ss);
    const float rs = rsqrtf(ss * (1.f / 1024.f) + EPS);
    const float* md = p.mod + ((size_t)L * 5 + vv) * 6144;
    float lg[16];
#pragma unroll
    for (int e = 0; e < 16; ++e) lg[e] = 0.f;
#pragma unroll 1
    for (int q = 0; q < 4; ++q) {
      const int j = q * 256 + lane * 4;
      const float4 xv = *(const float4*)(xp + j);
      const float4 nw = *(const float4*)(p.norm_ffn + L * D + j), sh = *(const float4*)(md + 3 * 1024 + j), scl = *(const float4*)(md + 4 * 1024 + j);
      float hv[4];
      hv[0] = xv.x * rs * nw.x * (1.f + scl.x) + sh.x; hv[1] = xv.y * rs * nw.y * (1.f + scl.y) + sh.y;
      hv[2] = xv.z * rs * nw.z * (1.f + scl.z) + sh.z; hv[3] = xv.w * rs * nw.w * (1.f + scl.w) + sh.w;
      uint2 o; o.x = (unsigned)f2bf(hv[0]) | ((unsigned)f2bf(hv[1]) << 16); o.y = (unsigned)f2bf(hv[2]) | ((unsigned)f2bf(hv[3]) << 16);
      *(uint2*)(p.HF + (size_t)tk * D + j) = o;
#pragma unroll
      for (int e = 0; e < 16; ++e) {
        const float4 r4 = *(const float4*)&rw[e * 1024 + j];
        lg[e] += hv[0] * r4.x + hv[1] * r4.y + hv[2] * r4.z + hv[3] * r4.w;
      }
    }
    {
      float sel = 0.f;
#pragma unroll
      for (int e = 0; e < 16; ++e) { const float rsum = dpp_sum16(lg[e]); sel = ((lane & 15) == e) ? rsum : sel; }
      sel += __shfl_xor(sel, 16); sel += __shfl_xor(sel, 32);
#pragma unroll
      for (int e = 0; e < 16; ++e) lg[e] = __int_as_float(__builtin_amdgcn_readlane(__float_as_int(sel), e));
    }
    if (lane == 0) {
      float sc[16], sel[16];
#pragma unroll
      for (int e = 0; e < 16; ++e) { sc[e] = sigm(lg[e]); sel[e] = sc[e] + p.router_b[e]; }
      int bg = 0; float bgs = -1e30f;
#pragma unroll
      for (int g = 0; g < 4; ++g) {
        float m1 = -1e30f, m2 = -1e30f;
#pragma unroll
        for (int u = 0; u < 4; ++u) { const float s = sel[g * 4 + u]; if (s > m1) { m2 = m1; m1 = s; } else if (s > m2) m2 = s; }
        const float gs = m1 + m2;
        if (gs > bgs) { bgs = gs; bg = g; }
      }
      int i1 = 0, i2 = 0; float m1 = -1e30f, m2 = -1e30f;
#pragma unroll
      for (int u = 0; u < 4; ++u) {
        float s = 0.f, c2 = 0.f;
#pragma unroll
        for (int g = 0; g < 4; ++g) if (g == bg) { s = sel[g * 4 + u]; }
        (void)c2;
        if (s > m1) { m2 = m1; i2 = i1; m1 = s; i1 = u; } else if (s > m2) { m2 = s; i2 = u; }
      }
      const int e1 = bg * 4 + i1, e2 = bg * 4 + i2;
      float s1 = 0.f, s2 = 0.f;
#pragma unroll
      for (int e = 0; e < 16; ++e) { if (e == e1) s1 = sc[e]; if (e == e2) s2 = sc[e]; }
      const float inv = 1.f / (s1 + s2);
      const int r1 = atomicAdd(&lcnt[e1], 1), r2 = atomicAdd(&lcnt[e2], 1);
      tokinfo[wave * 16 + iter] = (unsigned)e1 | ((unsigned)e2 << 4) | ((unsigned)r1 << 8) | ((unsigned)r2 << 16);
      p.gatew[tk * 2] = s1 * inv; p.gatew[tk * 2 + 1] = s2 * inv;
    }
  }
  __syncthreads();
  if (tid < 16) lbase[tid] = atomicAdd(&p.cnt[L * 16 + tid], lcnt[tid]);
  __syncthreads();
  if (lane < 16) {
    const int tk = blockIdx.x * 8 + wave + lane * gridDim.x * 8;
    if (tk < ntok) {
      const unsigned ti = tokinfo[wave * 16 + lane];
      const int e1 = ti & 15, e2 = (ti >> 4) & 15, r1 = (ti >> 8) & 255, r2 = (ti >> 16) & 255;
      p.list[(size_t)e1 * T + lbase[e1] + r1] = tk * 2; p.list[(size_t)e2 * T + lbase[e2] + r2] = tk * 2 + 1;
    }
  }
}

namespace g8 {
DEVINL uint4 pack8(const f32x4& a, const f32x4& b) { return make_uint4(pack2(a[0], a[1]), pack2(a[2], a[3]), pack2(b[0], b[1]), pack2(b[2], b[3])); }
struct EpiP {
  static constexpr bool PERM = true;
  bfr* C; int ldc; int act;
  DEVINL void operator()(const Acc& acc, const Unit& u, int wr, int wc, int fr, int fq) const {
    const int row0 = u.pm * 256 + wr * 64 + fr, col0 = u.pn * 256 + wc * 32 + 8 * fq;
#pragma unroll
    for (int ai = 0; ai < 2; ++ai)
#pragma unroll
      for (int m = 0; m < 4; ++m) {
        bfr* rowp = C + (size_t)(row0 + ai * 128 + m * 16) * ldc + col0;
#pragma unroll
        for (int bj = 0; bj < 2; ++bj) {
          f32x4 v0 = acc[ai][bj][m][0], v1 = acc[ai][bj][m][1];
          if (act) {
#pragma unroll
            for (int j = 0; j < 4; ++j) { v0[j] = sigm(v0[j]); v1[j] = sigm(v1[j]); }
          }
          *(uint4*)(rowp + bj * 128) = pack8(v0, v1);
        }
      }
  }
};
struct EpiBranch {
  static constexpr bool PERM = true;
  bfr* ACC; const bfr* GATES; bfr* ACC2;
  DEVINL void operator()(const Acc& acc, const Unit& u, int wr, int wc, int fr, int fq) const {
    const int row0 = u.pm * 256 + wr * 64 + fr, col0 = u.pn * 256 + wc * 32 + 8 * fq;
    const bool alt = u.pm >= 64 && u.e >= 2, first = alt ? (u.e == 2) : (u.e == 0);
    bfr* const dstb = alt ? ACC2 - (size_t)TL * 1024 : ACC;
#pragma unroll
    for (int ai = 0; ai < 2; ++ai) {
      uint4 gq[4][2], pq[4][2];
#pragma unroll
      for (int m = 0; m < 4; ++m)
#pragma unroll
        for (int bj = 0; bj < 2; ++bj) {
          const size_t row = (size_t)(row0 + ai * 128 + m * 16); const int col = col0 + bj * 128;
          gq[m][bj] = *(const uint4*)(GATES + row * 4096 + u.e * 1024 + col);
          pq[m][bj] = first ? make_uint4(0, 0, 0, 0) : *(const uint4*)(dstb + row * 1024 + col);
        }
#pragma unroll
      for (int m = 0; m < 4; ++m)
#pragma unroll
        for (int bj = 0; bj < 2; ++bj) {
          const size_t row = (size_t)(row0 + ai * 128 + m * 16); const int col = col0 + bj * 128;
          float gt[8], pv[8];
          unpack8(gq[m][bj], gt); unpack8(pq[m][bj], pv);
          f32x4 v0, v1;
#pragma unroll
          for (int j = 0; j < 4; ++j) { v0[j] = pv[j] + gt[j] * acc[ai][bj][m][0][j]; v1[j] = pv[4 + j] + gt[4 + j] * acc[ai][bj][m][1][j]; }
          *(uint4*)(dstb + row * 1024 + col) = pack8(v0, v1);
        }
    }
  }
};
struct EpiOut {
  static constexpr bool PERM = false;
  float* xlat; float* xctx; const float* mod; int layer;
  DEVINL void operator()(const Acc& acc, const Unit& u, int wr, int wc, int fr, int fq) const {
    const int row0 = u.pm * 256 + wr * 64 + fr, col0 = u.pn * 256 + wc * 32 + 4 * fq;
#pragma unroll
    for (int ai = 0; ai < 2; ++ai) {
      float4 xq[4][2][2];
      float* xpp[4];
      const float* m2p = nullptr;
#pragma unroll
      for (int m = 0; m < 4; ++m) {
        const int R = row0 + ai * 128 + m * 16;
        const bool lat = R < TL;
        xpp[m] = lat ? xlat + (size_t)canon_row(layer, R) * D : xctx + (size_t)(R - TL) * D;
        if (m == 0) m2p = mod + ((size_t)layer * 5 + (lat ? (R >> 12) : 4)) * 6144 + 2 * 1024;
#pragma unroll
        for (int bj = 0; bj < 2; ++bj)
#pragma unroll
          for (int n = 0; n < 2; ++n) xq[m][bj][n] = *(const float4*)(xpp[m] + col0 + bj * 128 + n * 16);
      }
      float4 mq[2][2];
#pragma unroll
      for (int bj = 0; bj < 2; ++bj)
#pragma unroll
        for (int n = 0; n < 2; ++n) mq[bj][n] = *(const float4*)(m2p + col0 + bj * 128 + n * 16);
#pragma unroll
      for (int m = 0; m < 4; ++m)
#pragma unroll
        for (int bj = 0; bj < 2; ++bj)
#pragma unroll
          for (int n = 0; n < 2; ++n) {
            float4 xv = xq[m][bj][n]; const float4 mv = mq[bj][n]; const f32x4 a = acc[ai][bj][m][n];
            xv.x += mv.x * a[0]; xv.y += mv.y * a[1]; xv.z += mv.z * a[2]; xv.w += mv.w * a[3];
            *(float4*)(xpp[m] + col0 + bj * 128 + n * 16) = xv;
          }
    }
  }
};
struct EpiMoeUp {
  static constexpr bool PERM = true;
  bfr* HB; const int* list; const int* cnt;
  DEVINL void operator()(const Acc& acc, const Unit& u, int wr, int wc, int fr, int fq) const {
    const int ce = cnt[u.e];
#pragma unroll
    for (int ai = 0; ai < 2; ++ai) {
      int en[4];
#pragma unroll
      for (int m = 0; m < 4; ++m) { const int ei = u.pm * 256 + ai * 128 + wr * 64 + m * 16 + fr; en[m] = ei < ce ? list[(size_t)u.e * T + ei] : -1; }
#pragma unroll
      for (int m = 0; m < 4; ++m) {
        if (en[m] >= 0) {
          f32x4 v0, v1;
#pragma unroll
          for (int j = 0; j < 4; ++j) { v0[j] = silu(acc[ai][0][m][0][j]) * acc[ai][1][m][0][j]; v1[j] = silu(acc[ai][0][m][1][j]) * acc[ai][1][m][1][j]; }
          *(uint4*)(HB + (size_t)en[m] * 512 + u.pn * 128 + wc * 32 + 8 * fq) = pack8(v0, v1);
        }
      }
    }
  }
};
struct EpiMoeDown {
  static constexpr bool PERM = true;
  bfr* YS; const int* list; const int* cnt; const float* gatew;
  DEVINL void operator()(const Acc& acc, const Unit& u, int wr, int wc, int fr, int fq) const {
    const int ce = cnt[u.e];
#pragma unroll
    for (int ai = 0; ai < 2; ++ai) {
      int en[4]; float gw[4];
#pragma unroll
      for (int m = 0; m < 4; ++m) { const int ei = u.pm * 256 + ai * 128 + wr * 64 + m * 16 + fr; en[m] = ei < ce ? list[(size_t)u.e * T + ei] : -1; }
#pragma unroll
      for (int m = 0; m < 4; ++m) gw[m] = en[m] >= 0 ? gatew[en[m]] : 0.f;
#pragma unroll
      for (int m = 0; m < 4; ++m) {
        if (en[m] >= 0) {
          bfr* yp = YS + (size_t)(en[m] & 1) * T * D + (size_t)(en[m] >> 1) * D + u.pn * 256 + wc * 32 + 8 * fq;
#pragma unroll
          for (int bj = 0; bj < 2; ++bj) *(uint4*)(yp + bj * 128) = pack8(acc[ai][bj][m][0] * gw[m], acc[ai][bj][m][1] * gw[m]);
        }
      }
    }
  }
};
}

template <int L>
DEVINL void phase_gproj(const Params& p, char* sm, int c) {
  g8::TileSched S; S.init(L == 1 ? 64 : 68, 2); S.G = 32; S.c = c;
  g8::EpiP E{p.Gb, 512, 0};
  g8::RowAddr aA{NINP, 0, 0u}, aB{256, 1, 0u};
  g8::gemm8((LAS unsigned char*)sm, (const char*)(p.P + C_RWKV + 1792), (const char*)p.g2T, 256, S, E, aA, aB);
}
template <int L>
DEVINL void phase_gemm_in8(const Params& p, char* sm) {
  g8::TileSched S; S.init(T / 256, NINP / 256);
  g8::EpiP E{p.P, NINP, 0};
  g8::RowAddr aA{OLD, 0, 0u}, aB{D, 1, 0u};
  g8::gemm8(( LAS unsigned char*)sm, (const char*)(p.O + 2048), (const char*)p.WinT, D, S, E, aA, aB);
  if (L == 0 && blockIdx.x >= 44) {
    __syncthreads();
    convert_range<false>(p, 0, 1728 + blockIdx.x - 44, CONV_L_ITEMS, gridDim.x - 44, sm);
  }
}
template <int L>
DEVINL void phase_gates8(const Params& p, char* sm) {
  g8::TileSched S; S.init(L == 1 ? 64 : 68, 16);
  g8::EpiP E{p.GATES, 4096, 1};
  g8::RowAddr aA{OLD, 0, 0u}, aB{D, 1, 0u};
  g8::gemm8((LAS unsigned char*)sm, (const char*)(p.O + 2048), (const char*)p.WgT, D, S, E, aA, aB);
  __syncthreads();
  if (L == 1) convert_range<true>(p, L, blockIdx.x, 2048, gridDim.x, sm);
}
template <int L>
DEVINL void phase_branch8(const Params& p, char* sm) {
  g8::MergeSched S; S.init(L == 1 ? 64 : 68);
  g8::EpiBranch E{p.ACC, p.GATES, p.ACC2};
  g8::RowAddr aA{OLD, 0, 512u * 2u}, aB{512, 1, (unsigned)(D * 512 * 2)};
  g8::gemm8((LAS unsigned char*)sm, (const char*)p.O, (const char*)p.WbT, 512, S, E, aA, aB);
  __syncthreads();
  if (L == 1) convert_range<true>(p, L, 2048 + blockIdx.x, 4096, gridDim.x, sm);
  else if (blockIdx.x >= 32) convert_range<true>(p, L, blockIdx.x - 32, CONV_M_ITEMS, gridDim.x - 32, sm);
}
struct OutSched0 {
  int n, pmA, pnA, pmB, pnB, eB;
  DEVINL void init() {
    const int c = blockIdx.x; const bool ctx = c >= 240;
    const int t0 = ctx ? c - 240 : c, t1 = 240 + c;
    pmA = ctx ? 64 + (t0 >> 2) : (t0 & 7) * 8 + (t0 >> 5); pnA = ctx ? (t0 & 3) : ((t0 >> 3) & 3);
    pmB = ctx ? pmA : (t1 & 7) * 8 + (t1 >> 5); pnB = ctx ? pnA : ((t1 >> 3) & 3); eB = ctx ? 1 : 0;
    n = (ctx || c < 16) ? 2 : 1;
  }
  DEVINL bool next(int i, g8::Unit& u) const { if (i >= n) return false; u.pm = i ? pmB : pmA; u.pn = i ? pnB : pnA; u.e = i ? eB : 0; return true; }
};
template <int L>
DEVINL void phase_out8(const Params& p, char* sm) {
  g8::EpiOut E{p.out, p.xc, p.mod, L};
  if (L == 0) {
    OutSched0 S; S.init();
    g8::RowAddr aA{D, 0, (unsigned)((const char*)p.ACC2 - (const char*)p.ACC) - (unsigned)TL * 1024u * 2u}, aB{D, 1, 0u};
    g8::gemm8((LAS unsigned char*)sm, (const char*)p.ACC, (const char*)p.WoT, D, S, E, aA, aB);
    __syncthreads();
    if (blockIdx.x >= 16 && blockIdx.x < 240) convert_range<false>(p, 1, blockIdx.x - 16, 3264, 224, sm);
  } else {
    g8::TileSched S; S.init(64, 4);
    g8::RowAddr aA{D, 0, 0u}, aB{D, 1, 0u};
    g8::gemm8((LAS unsigned char*)sm, (const char*)p.ACC, (const char*)p.WoT, D, S, E, aA, aB);
    __syncthreads();
  }
}
template <int L>
DEVINL void phase_moe_up8(const Params& p, char* sm) {
  const int* cnt = p.cnt + L * 16;
  g8::MoeSched S{cnt, 4, (int)gridDim.x, (int)blockIdx.x, 0};
  g8::EpiMoeUp E{p.HB, p.list, cnt};
  g8::GatherAddr aA{p.list, cnt, D * 2, 1};
  g8::RowAddr aB{D, 1, (unsigned)(D * D * 2)};
  g8::gemm8((LAS unsigned char*)sm, (const char*)p.HF, (const char*)p.WmguT, D, S, E, aA, aB);
  {
    int U = 0;
#pragma unroll 1
    for (int e = 0; e < 16; ++e) U += ((cnt[e] + 255) >> 8) * 4;
    const int G = gridDim.x, r = U % G, nl = G - r, c = blockIdx.x;
    int rank = 0;
#pragma unroll 1
    for (int cc = 0; cc < c; ++cc) rank += (((cc & ~127) | ((cc & 7) << 4) | ((cc >> 3) & 15)) >= r) ? 1 : 0;
    const bool light = (((c & ~127) | ((c & 7) << 4) | ((c >> 3) & 15)) >= r);
    const int first = (nl >= 64) ? (light ? rank : -1) : c, stride = (nl >= 64) ? nl : G;
    __syncthreads();
    if (first >= 0) {
      if (L == 0) convert_range<false>(p, 1, 3264 + first, CONV_L_ITEMS, stride, sm);
      else convert_range<true>(p, L, 4096 + first, CONV_M_ITEMS, stride, sm);
    }
  }
}
template <int L>
DEVINL void phase_moe_down8(const Params& p, char* sm) {
  const int* cnt = p.cnt + L * 16;
  g8::MoeSched S{cnt, 4, (int)gridDim.x, (int)blockIdx.x, 0};
  g8::EpiMoeDown E{p.YS, p.list, cnt, p.gatew};
  g8::GatherAddr aA{p.list, cnt, 512 * 2, 0};
  g8::RowAddr aB{512, 1, (unsigned)(D * 512 * 2)};
  g8::gemm8((LAS unsigned char*)sm, (const char*)p.HB, (const char*)p.WmdT, 512, S, E, aA, aB);
}

DEVINL void phase_final(const Params& p) {
  const int lane = threadIdx.x & 63, wave = threadIdx.x >> 6;
  for (int tk = blockIdx.x * 8 + wave; tk < TL; tk += gridDim.x * 8) {
    float* xp = p.out + (size_t)tk * D;
    const int vv = tk >> 12;
    float v[16]; float ss = 0.f;
#pragma unroll
    for (int q = 0; q < 4; ++q) {
      const int j = q * 256 + lane * 4;
      float4 xv = *(const float4*)(xp + j);
      const float4 m5 = *(const float4*)(p.mod + ((size_t)1 * 5 + vv) * 6144 + 5 * 1024 + j);
      const uint2 y0 = *(const uint2*)(p.YS + (size_t)tk * D + j), y1 = *(const uint2*)(p.YS + (size_t)T * D + (size_t)tk * D + j);
      xv.x += m5.x * (bf2f(y0.x & 0xFFFF) + bf2f(y1.x & 0xFFFF)); xv.y += m5.y * (bf2f(y0.x >> 16) + bf2f(y1.x >> 16));
      xv.z += m5.z * (bf2f(y0.y & 0xFFFF) + bf2f(y1.y & 0xFFFF)); xv.w += m5.w * (bf2f(y0.y >> 16) + bf2f(y1.y >> 16));
      v[q * 4] = xv.x; v[q * 4 + 1] = xv.y; v[q * 4 + 2] = xv.z; v[q * 4 + 3] = xv.w;
      ss += xv.x * xv.x + xv.y * xv.y + xv.z * xv.z + xv.w * xv.w;
    }
    ss = wave_sum(ss);
    const float rs = rsqrtf(ss * (1.f / 1024.f) + EPS);
#pragma unroll
    for (int q = 0; q < 4; ++q) {
      const int j = q * 256 + lane * 4;
      const float4 fw = *(const float4*)(p.final_norm + j);
      *(float4*)(xp + j) = make_float4(v[q * 4] * rs * fw.x, v[q * 4 + 1] * rs * fw.y, v[q * 4 + 2] * rs * fw.z, v[q * 4 + 3] * rs * fw.w);
    }
  }
}

constexpr int NPHASE = 24;

template <int L>
DEVINL void layer_phases(const Params& p, const XcdBarrier& bar, char* sm, int ph0, int ph1) {
  constexpr int B0 = 1 + 11 * L;
#define PH(id, call) { if (ph0 <= (id) && (id) < ph1) { call; } if (ph0 <= (id) && (id) + 1 < ph1) xcd_barrier(bar); }
  PH(B0 + 0, phase_norm1<L>(p))
  PH(B0 + 1, phase_gemm_in8<L>(p, sm))
  PH(B0 + 2, phase_prep<L>(p, sm))
  PH(B0 + 3, phase_scans<L>(p, sm))
  PH(B0 + 4, phase_post2<L>(p))
  PH(B0 + 5, phase_gates8<L>(p, sm))
  PH(B0 + 6, phase_branch8<L>(p, sm))
  PH(B0 + 7, phase_out8<L>(p, sm))
  PH(B0 + 8, phase_route<L>(p, sm))
  PH(B0 + 9, phase_moe_up8<L>(p, sm))
  PH(B0 + 10, phase_moe_down8<L>(p, sm))
}

__global__ void __launch_bounds__(NTHR, 2) mega(Params p, unsigned* barw, int ph0, int ph1) {
  extern __shared__ __attribute__((aligned(16))) char smem[];
  if (threadIdx.x == 0) *(uint4*)smem = make_uint4(0u, 0u, 0u, 0u);
  __syncthreads();
  XcdBarrier bar = xcd_barrier_post(barw, (volatile LAS unsigned*)smem);
  char* sm = smem + 16;
  PH(0, phase_prologue(p, sm))
  layer_phases<0>(p, bar, sm, ph0, ph1);
  layer_phases<1>(p, bar, sm, ph0, ph1);
  if (ph0 <= 23 && 23 < ph1) phase_final(p);
}

}

extern "C" void kernel_launch(void* const* d_in, const int* in_sizes, int n_in, void* d_out, int out_size, void* d_ws, size_t ws_size, hipStream_t stream) {
  (void)in_sizes; (void)n_in; (void)out_size;
  static int inited = 0;
  if (!inited) {
    if (hipFuncSetAttribute((const void*)mega, hipFuncAttributeMaxDynamicSharedMemorySize, LDS_BYTES) != hipSuccess) fprintf(stderr, "hipFuncSetAttribute failed\n");
    int per_cu = 0;
    if (hipOccupancyMaxActiveBlocksPerMultiprocessor(&per_cu, (const void*)mega, NTHR, LDS_BYTES) != hipSuccess || per_cu < 1) fprintf(stderr, "occupancy query: %d\n", per_cu);
    inited = 1;
  }
  Params p{};
  const float** f = (const float**)&p;
  for (int i = 0; i < 42; ++i) f[i] = (const float*)d_in[i];
  p.out = (float*)d_out;
  char* w = (char*)d_ws;
  size_t off = 0;
  auto take = [&](size_t bytes) { char* r = w + off; off += (bytes + 255) & ~(size_t)255; return r; };
  unsigned* barw = (unsigned*)take(65536);
  p.cnt = (int*)(barw + 4 * XCD_BAR_WORDS);
  p.xc = (float*)take((size_t)TC * D * 4);
  p.mod = (float*)take((size_t)2 * 5 * 6144 * 4);
  p.bon = (float*)take((size_t)2 * T * 8 * 4);
  p.list = (int*)take((size_t)16 * T * 4);
  p.gatew = (float*)take((size_t)2 * T * 4);
  p.WinT = (bfr*)take((size_t)NINP * D * 2);
  p.WgT = (bfr*)take((size_t)4 * D * D * 2);
  p.WbT = (bfr*)take((size_t)4 * D * 512 * 2);
  p.WoT = (bfr*)take((size_t)D * D * 2);
  p.Gb = (bfr*)take((size_t)T * 512 * 2);
  p.g2T = (bfr*)take((size_t)512 * 256 * 2);
  p.O = (bfr*)take((size_t)T * OLD * 2);
  p.P = (bfr*)take((size_t)T * NINP * 2);
  {
    bfr* q = p.P;
    p.ACC = q; q += (size_t)T * D;
    p.GATES = q;
    p.HF = q; q += (size_t)T * D;
    p.HB = q; q += (size_t)2 * T * 512;
    p.YS = q; q += (size_t)2 * T * D;
    p.WmguT = q; q += (size_t)16 * D * D;
    p.WmdT = q; q += (size_t)16 * D * 512;
    p.ACC2 = q; q += (size_t)TC * D;
  }
  if (off > ws_size) { fprintf(stderr, "workspace too small: need %zu have %zu\n", off, ws_size); return; }
  hipMemsetAsync(barw, 0, 65536, stream);
#if MK_SINGLE
  hipLaunchKernelGGL(mega, dim3(256), dim3(NTHR), LDS_BYTES, stream, p, barw, 0, NPHASE);
#else
  for (int ph = 0; ph < NPHASE; ++ph) hipLaunchKernelGGL(mega, dim3(256), dim3(NTHR), LDS_BYTES, stream, p, barw, ph, ph + 1);
#endif
}
```
